# Optimizing an MI355X kernel written in HIP

```python
import functools
import jax, jax.numpy as jnp
from jax import lax
import numpy as np

D_MODEL = 1024
BATCH = 4
SEQ = 4096
DEPTH = 2

HEAD_DIM = 64
N_MOBA_HEADS = 8
N_FOX_HEADS = 8
N_ATTN_HEADS = N_MOBA_HEADS + N_FOX_HEADS
ATTN_WIDTH = N_ATTN_HEADS * HEAD_DIM
ROPE_DIMS = HEAD_DIM // 4
ROPE_THETA = 500000.0
MOBA_BLOCK = 256
MOBA_TOPK = 3
MOBA_QCHUNK = 64
FOX_QBLOCK = 128
FOX_BIAS_MEAN = 2.0
D_RNN = 1280
N_RNN_BLOCKS = 10
RNN_BLOCK_W = D_RNN // N_RNN_BLOCKS
CONV_WIDTH = 4
RG_C = 8.0
D_FF = 2816
N_EXPERTS = 8
TOP_K = 2
D_EXPERT = 3584
MOE_BLOCK = 256
N_EVEN_LAYERS = (DEPTH + 1) // 2
N_ODD_LAYERS = DEPTH // 2
NORM_EPS = 1e-6

kernel_name = "hybrid_moba_fox_rglru_moe"


def rms_norm(x, g):
    xf = x.astype(jnp.float32)
    y = xf * lax.rsqrt(jnp.mean(xf * xf, axis=-1, keepdims=True) + NORM_EPS)
    return (y * g.astype(jnp.float32)).astype(x.dtype)


def apply_partial_rope(x, pos):
    half = ROPE_DIMS // 2
    inv_freq = jnp.power(ROPE_THETA, -jnp.arange(half, dtype=jnp.float32) / half)
    ang = pos.astype(jnp.float32)[:, None] * inv_freq[None, :]
    cos, sin = jnp.cos(ang), jnp.sin(ang)
    x1 = x[..., :half].astype(jnp.float32)
    x2 = x[..., half:ROPE_DIMS].astype(jnp.float32)
    rot = jnp.concatenate([x1 * cos - x2 * sin, x2 * cos + x1 * sin], axis=-1).astype(x.dtype)
    return jnp.concatenate([rot, x[..., ROPE_DIMS:]], axis=-1)


def moba_attention(q, k, v):
    b, h, s, dh = q.shape
    n_blk = -(-s // MOBA_BLOCK)
    s_pad = n_blk * MOBA_BLOCK
    pad = ((0, 0), (0, 0), (0, s_pad - s), (0, 0))
    q, k, v = (jnp.pad(t, pad) for t in (q, k, v))
    k_blocks = k.reshape(b, h, n_blk, MOBA_BLOCK, dh)
    v_blocks = v.reshape(b, h, n_blk, MOBA_BLOCK, dh)
    k_mean = jnp.mean(k_blocks.astype(jnp.float32), axis=3)
    q_block_id = jnp.arange(s_pad) // MOBA_BLOCK
    gate = jnp.einsum('bhsd,bhnd->bhsn', q.astype(jnp.float32), k_mean)
    fully_past = jnp.arange(n_blk)[None, :] < q_block_id[:, None]
    gate = jnp.where(fully_past, gate, -jnp.inf)
    k_sel = min(MOBA_TOPK, n_blk)
    _, sel = lax.top_k(gate, k_sel)
    n_chunks = s_pad // MOBA_QCHUNK
    q_chunks = q.reshape(b, h, n_chunks, MOBA_QCHUNK, dh).transpose(2, 0, 1, 3, 4)
    sel_chunks = sel.reshape(b, h, n_chunks, MOBA_QCHUNK, k_sel).transpose(2, 0, 1, 3, 4)
    scale = HEAD_DIM ** -0.5
    gather = jax.vmap(jax.vmap(lambda blocks, idx: blocks[idx]))

    def one_chunk(args):
        ci, q_c, sel_c = args
        q_start = ci * MOBA_QCHUNK
        blk = q_start // MOBA_BLOCK
        k_own = lax.dynamic_index_in_dim(k_blocks, blk, axis=2, keepdims=False)
        v_own = lax.dynamic_index_in_dim(v_blocks, blk, axis=2, keepdims=False)
        q_pos = q_start + jnp.arange(MOBA_QCHUNK)
        k_pos = blk * MOBA_BLOCK + jnp.arange(MOBA_BLOCK)
        s_own = jnp.einsum('bhqd,bhkd->bhqk', q_c, k_own, preferred_element_type=jnp.float32) * scale
        s_own = jnp.where(k_pos[None, :] <= q_pos[:, None], s_own, -jnp.inf)
        k_g = gather(k_blocks, sel_c)
        v_g = gather(v_blocks, sel_c)
        s_sel = jnp.einsum('bhqd,bhqnkd->bhqnk', q_c, k_g, preferred_element_type=jnp.float32) * scale
        s_sel = jnp.where((sel_c < blk)[..., None], s_sel, -jnp.inf)
        scores = jnp.concatenate([s_own, s_sel.reshape(b, h, MOBA_QCHUNK, k_sel * MOBA_BLOCK)], axis=-1)
        p = jax.nn.softmax(scores, axis=-1).astype(v.dtype)
        p_own = p[..., :MOBA_BLOCK]
        p_sel = p[..., MOBA_BLOCK:].reshape(b, h, MOBA_QCHUNK, k_sel, MOBA_BLOCK)
        return (jnp.einsum('bhqk,bhkd->bhqd', p_own, v_own)
                + jnp.einsum('bhqnk,bhqnkd->bhqd', p_sel, v_g))

    out = lax.map(one_chunk, (jnp.arange(n_chunks), q_chunks, sel_chunks))
    out = out.transpose(1, 2, 0, 3, 4).reshape(b, h, s_pad, dh)
    return out[:, :, :s]


def forgetting_attention(q, k, v, log_f):
    b, h, s, dh = q.shape
    cum = jnp.cumsum(log_f, axis=-1)
    n_qb = s // FOX_QBLOCK
    q_blocks = q.reshape(b, h, n_qb, FOX_QBLOCK, dh).transpose(2, 0, 1, 3, 4)
    cum_blocks = cum.reshape(b, h, n_qb, FOX_QBLOCK).transpose(2, 0, 1, 3)
    k_pos = jnp.arange(s)
    scale = HEAD_DIM ** -0.5

    def one_block(args):
        bi, q_b, cum_q = args
        q_pos = bi * FOX_QBLOCK + jnp.arange(FOX_QBLOCK)
        scores = jnp.einsum('bhqd,bhkd->bhqk', q_b, k, preferred_element_type=jnp.float32) * scale
        scores = scores + cum_q[..., :, None] - cum[:, :, None, :]
        scores = jnp.where(k_pos[None, :] <= q_pos[:, None], scores, -jnp.inf)
        p = jax.nn.softmax(scores, axis=-1).astype(v.dtype)
        return jnp.einsum('bhqk,bhkd->bhqd', p, v)

    out = lax.map(one_block, (jnp.arange(n_qb), q_blocks, cum_blocks))
    return out.transpose(1, 2, 0, 3, 4).reshape(b, h, s, dh)


def hybrid_attention_mixer(h, w_in, b_f, w_out):
    b, s, _ = h.shape
    proj = h @ w_in

    def to_heads(t):
        return t.reshape(b, s, N_ATTN_HEADS, HEAD_DIM).transpose(0, 2, 1, 3)

    q = to_heads(proj[..., :ATTN_WIDTH])
    k = to_heads(proj[..., ATTN_WIDTH:2 * ATTN_WIDTH])
    v = to_heads(proj[..., 2 * ATTN_WIDTH:3 * ATTN_WIDTH])
    f_logit = proj[..., 3 * ATTN_WIDTH:] + b_f
    pos = jnp.arange(s)
    q_m = apply_partial_rope(q[:, :N_MOBA_HEADS], pos)
    k_m = apply_partial_rope(k[:, :N_MOBA_HEADS], pos)
    o_moba = moba_attention(q_m, k_m, v[:, :N_MOBA_HEADS])
    log_f = jax.nn.log_sigmoid(f_logit.astype(jnp.float32)).transpose(0, 2, 1)
    o_fox = forgetting_attention(q[:, N_MOBA_HEADS:], k[:, N_MOBA_HEADS:], v[:, N_MOBA_HEADS:], log_f)
    o = jnp.concatenate([o_moba, o_fox], axis=1).transpose(0, 2, 1, 3).reshape(b, s, ATTN_WIDTH)
    return o @ w_out


def _linear_recurrence_combine(left, right):
    a_l, b_l = left
    a_r, b_r = right
    return a_l * a_r, a_r * b_l + b_r


def rglru_mixer(h, w_in, conv_w, conv_b, w_a, b_a, w_x, b_x, lam, w_out):
    b, s, _ = h.shape
    proj = h @ w_in
    gate_branch, u = proj[..., :D_RNN], proj[..., D_RNN:]
    u_pad = jnp.pad(u, ((0, 0), (CONV_WIDTH - 1, 0), (0, 0)))
    conv = conv_b
    for j in range(CONV_WIDTH):
        conv = conv + u_pad[:, j:j + s] * conv_w[j]
    ub = conv.reshape(b, s, N_RNN_BLOCKS, RNN_BLOCK_W)
    r = jax.nn.sigmoid(jnp.einsum('bsnc,ncd->bsnd', ub, w_a).reshape(b, s, D_RNN) + b_a)
    i = jax.nn.sigmoid(jnp.einsum('bsnc,ncd->bsnd', ub, w_x).reshape(b, s, D_RNN) + b_x)
    log_a = (-RG_C * r.astype(jnp.float32)) * jax.nn.softplus(-lam.astype(jnp.float32))
    a = jnp.exp(log_a)
    mult = jnp.sqrt(-jnp.expm1(2.0 * log_a))
    xin = mult * (i * conv).astype(jnp.float32)
    _, hs = lax.associative_scan(_linear_recurrence_combine, (a, xin), axis=1)
    y = jax.nn.gelu(gate_branch) * hs.astype(h.dtype)
    return y @ w_out


def swiglu(h, w_gate, w_up, w_down):
    return (jax.nn.silu(h @ w_gate) * (h @ w_up)) @ w_down


def moe_swiglu(h, w_router, b_router, w_gate, w_up, w_down):
    b, s, d = h.shape
    n_tok = b * s
    xt = h.reshape(n_tok, d)
    logits = (xt @ w_router).astype(jnp.float32) + b_router.astype(jnp.float32)
    top_logit, top_idx = lax.top_k(logits, TOP_K)
    gates = jax.nn.softmax(top_logit, axis=-1)
    n_asg = n_tok * TOP_K
    exp_flat = top_idx.reshape(-1).astype(jnp.int32)
    tok_flat = jnp.repeat(jnp.arange(n_tok, dtype=jnp.int32), TOP_K)
    gate_flat = gates.reshape(-1)
    order = jnp.argsort(exp_flat)
    exp_sorted = exp_flat[order]
    counts = jnp.zeros((N_EXPERTS,), jnp.int32).at[exp_flat].add(1)
    padded = ((counts + MOE_BLOCK - 1) // MOE_BLOCK) * MOE_BLOCK
    starts = jnp.cumsum(counts) - counts
    pends = jnp.cumsum(padded)
    pstarts = pends - padded
    dest = pstarts[exp_sorted] + (jnp.arange(n_asg, dtype=jnp.int32) - starts[exp_sorted])
    n_blocks = -(-n_asg // MOE_BLOCK) + N_EXPERTS
    cap = n_blocks * MOE_BLOCK
    slot_tok = jnp.zeros((cap,), jnp.int32).at[dest].set(tok_flat[order])
    slot_gate = jnp.zeros((cap,), gates.dtype).at[dest].set(gate_flat[order])
    block_starts = jnp.arange(n_blocks, dtype=jnp.int32) * MOE_BLOCK
    block_exp = jnp.minimum(jnp.searchsorted(pends, block_starts, side='right'), N_EXPERTS - 1)

    def one_block(args):
        tok, e = args
        xb = xt[tok]
        return (jax.nn.silu(xb @ w_gate[e]) * (xb @ w_up[e])) @ w_down[e]

    y_slots = lax.map(one_block, (slot_tok.reshape(n_blocks, MOE_BLOCK), block_exp))
    y_slots = y_slots.reshape(cap, d) * slot_gate[:, None].astype(y_slots.dtype)
    y = jax.ops.segment_sum(y_slots, slot_tok, num_segments=n_tok)
    return y.reshape(b, s, d)


def modulated_sublayer(x, fn, shift, scale, gate, g_pre, g_post):
    h = rms_norm(x, g_pre) * (1.0 + scale[:, None, :]) + shift[:, None, :]
    y = rms_norm(fn(h), g_post)
    return x + gate[:, None, :] * y


def setup_inputs(seed: int = 0) -> dict:
    key = jax.random.key(seed)
    ks = jax.random.split(key, 25)
    f32 = jnp.float32
    ne, no = N_EVEN_LAYERS, N_ODD_LAYERS

    def normal(k, shape, fan_in, gain=1.0):
        return jax.random.normal(k, shape, f32) * (gain * fan_in ** -0.5)

    def small(k, shape, s=0.02):
        return s * jax.random.normal(k, shape, f32)

    x = jax.random.normal(ks[0], (BATCH, SEQ, D_MODEL), f32)
    c = jax.random.normal(ks[1], (BATCH, D_MODEL), f32)
    w_ada = normal(ks[2], (DEPTH, D_MODEL, 6 * D_MODEL), D_MODEL, 0.5)
    b_ada = small(ks[3], (DEPTH, 6 * D_MODEL))
    norm_g = 1.0 + 0.05 * jax.random.normal(ks[4], (DEPTH, 4, D_MODEL), f32)
    attn_w_in = normal(ks[5], (ne, D_MODEL, 3 * ATTN_WIDTH + N_FOX_HEADS), D_MODEL)
    fox_b_f = FOX_BIAS_MEAN + 0.5 * jax.random.normal(ks[6], (ne, N_FOX_HEADS), f32)
    attn_w_out = normal(ks[7], (ne, ATTN_WIDTH, D_MODEL), ATTN_WIDTH)
    ffn_w_gate = normal(ks[8], (ne, D_MODEL, D_FF), D_MODEL)
    ffn_w_up = normal(ks[9], (ne, D_MODEL, D_FF), D_MODEL)
    ffn_w_down = normal(ks[10], (ne, D_FF, D_MODEL), D_FF)
    lru_w_in = normal(ks[11], (no, D_MODEL, 2 * D_RNN), D_MODEL)
    lru_conv_w = normal(ks[12], (no, CONV_WIDTH, D_RNN), CONV_WIDTH)
    lru_conv_b = small(ks[13], (no, D_RNN))
    lru_w_a = normal(ks[14], (no, N_RNN_BLOCKS, RNN_BLOCK_W, RNN_BLOCK_W), RNN_BLOCK_W)
    lru_b_a = small(ks[15], (no, D_RNN))
    lru_w_x = normal(ks[16], (no, N_RNN_BLOCKS, RNN_BLOCK_W, RNN_BLOCK_W), RNN_BLOCK_W)
    lru_b_x = small(ks[17], (no, D_RNN))
    a_pow = jax.random.uniform(ks[18], (no, D_RNN), f32, minval=0.9, maxval=0.999)
    a_base = a_pow ** (1.0 / RG_C)
    lru_lambda = jnp.log(a_base) - jnp.log1p(-a_base)
    lru_w_out = normal(ks[19], (no, D_RNN, D_MODEL), D_RNN)
    moe_w_router = normal(ks[20], (no, D_MODEL, N_EXPERTS), D_MODEL)
    moe_b_router = small(ks[21], (no, N_EXPERTS), 0.01)
    moe_w_gate = normal(ks[22], (no, N_EXPERTS, D_MODEL, D_EXPERT), D_MODEL)
    moe_w_up = normal(ks[23], (no, N_EXPERTS, D_MODEL, D_EXPERT), D_MODEL)
    moe_w_down = normal(ks[24], (no, N_EXPERTS, D_EXPERT, D_MODEL), D_EXPERT)
    return {"x": x, "c": c, "w_ada": w_ada, "b_ada": b_ada, "norm_g": norm_g,
            "attn_w_in": attn_w_in, "fox_b_f": fox_b_f, "attn_w_out": attn_w_out,
            "ffn_w_gate": ffn_w_gate, "ffn_w_up": ffn_w_up, "ffn_w_down": ffn_w_down,
            "lru_w_in": lru_w_in, "lru_conv_w": lru_conv_w, "lru_conv_b": lru_conv_b,
            "lru_w_a": lru_w_a, "lru_b_a": lru_b_a, "lru_w_x": lru_w_x, "lru_b_x": lru_b_x,
            "lru_lambda": lru_lambda, "lru_w_out": lru_w_out,
            "moe_w_router": moe_w_router, "moe_b_router": moe_b_router,
            "moe_w_gate": moe_w_gate, "moe_w_up": moe_w_up, "moe_w_down": moe_w_down}


def reference(x, c, w_ada, b_ada, norm_g, attn_w_in, fox_b_f, attn_w_out,
              ffn_w_gate, ffn_w_up, ffn_w_down, lru_w_in, lru_conv_w, lru_conv_b,
              lru_w_a, lru_b_a, lru_w_x, lru_b_x, lru_lambda, lru_w_out,
              moe_w_router, moe_b_router, moe_w_gate, moe_w_up, moe_w_down):
    cond = jax.nn.silu(c)
    for layer in range(DEPTH):
        i = layer // 2
        mod = cond @ w_ada[layer] + b_ada[layer]
        sh_m, sc_m, g_m, sh_f, sc_f, g_f = jnp.split(mod, 6, axis=-1)
        if layer % 2 == 0:
            mixer = functools.partial(hybrid_attention_mixer, w_in=attn_w_in[i], b_f=fox_b_f[i],
                                      w_out=attn_w_out[i])
            ffn = functools.partial(swiglu, w_gate=ffn_w_gate[i], w_up=ffn_w_up[i], w_down=ffn_w_down[i])
        else:
            mixer = functools.partial(rglru_mixer, w_in=lru_w_in[i], conv_w=lru_conv_w[i],
                                      conv_b=lru_conv_b[i], w_a=lru_w_a[i], b_a=lru_b_a[i],
                                      w_x=lru_w_x[i], b_x=lru_b_x[i], lam=lru_lambda[i],
                                      w_out=lru_w_out[i])
            ffn = functools.partial(moe_swiglu, w_router=moe_w_router[i], b_router=moe_b_router[i],
                                    w_gate=moe_w_gate[i], w_up=moe_w_up[i], w_down=moe_w_down[i])
        x = modulated_sublayer(x, mixer, sh_m, sc_m, g_m, norm_g[layer, 0], norm_g[layer, 1])
        x = modulated_sublayer(x, ffn, sh_f, sc_f, g_f, norm_g[layer, 2], norm_g[layer, 3])
    return x
```

```cpp
#include <hip/hip_runtime.h>
#include <cstdint>
#include <cstdio>
#include <cmath>

typedef unsigned short u16;
typedef float f32x4 __attribute__((ext_vector_type(4)));
typedef unsigned u32x4 __attribute__((ext_vector_type(4)));
typedef unsigned u32x2 __attribute__((ext_vector_type(2)));

constexpr int D = 1024, NB = 4, S = 4096, M = NB * S;
constexpr int NIN = 3080;
constexpr int DFF = 2816, DRNN = 1280, NE = 8, DEXP = 3584;
constexpr int MODW = 6 * D;
constexpr float EPS = 1e-6f;
constexpr float LOG2E = 1.4426950408889634f;
constexpr float C2 = 0.125f * LOG2E;

__device__ __forceinline__ u16 f2bf(float f) { unsigned u = __float_as_uint(f); return (u16)((u + 0x7fffu + ((u >> 16) & 1u)) >> 16); }
__device__ __forceinline__ float bf2f(u16 h) { return __uint_as_float(((unsigned)h) << 16); }
__device__ __forceinline__ unsigned pk2(float lo, float hi) { return (unsigned)f2bf(lo) | ((unsigned)f2bf(hi) << 16); }
__device__ __forceinline__ unsigned pk4_fp8(float a, float b, float c, float d) {
    a = __builtin_amdgcn_fmed3f(a, -448.f, 448.f); b = __builtin_amdgcn_fmed3f(b, -448.f, 448.f); c = __builtin_amdgcn_fmed3f(c, -448.f, 448.f); d = __builtin_amdgcn_fmed3f(d, -448.f, 448.f);
    unsigned w = 0u; w = __builtin_amdgcn_cvt_pk_fp8_f32(a, b, w, false); w = __builtin_amdgcn_cvt_pk_fp8_f32(c, d, w, true); return w; }
__device__ __forceinline__ float wave_sum(float v) {
#pragma unroll
    for (int o = 1; o < 64; o <<= 1) v += __shfl_xor(v, o);
    return v;
}
__device__ __forceinline__ float sigmoidf_(float x) { return 1.f / (1.f + __expf(-x)); }

struct RowP {
    const float* xres; const float* y; const float* g_post; const float* gate; float* xout;
    const float* g_pre; const float* sc; const float* sh; u16* hout;
    const float* wex; const float* bex;
    float* logf; int* cnt; int* list_tw; float* list_g; unsigned char* h8;
    int y_mode; int extra; int wex_ld; int wex_off;
};
__device__ __forceinline__ void row_pass(const RowP& p, int blk, int nblk, __attribute__((address_space(3))) float* wl) {
    const int lane = threadIdx.x & 63, wave = threadIdx.x >> 6, nw = blockDim.x >> 6;
    if (p.extra) {
        for (int idx = threadIdx.x; idx < 8 * D; idx += blockDim.x) { const int k = idx >> 3, o = idx & 7; wl[o * D + k] = p.wex[(size_t)k * p.wex_ld + p.wex_off + o]; }
        __syncthreads();
    }
    for (int m = blk * nw + wave; m < M; m += nblk * nw) {
        const int b = m / S, t = m % S;
        f32x4 xv[4];
#pragma unroll
        for (int j = 0; j < 4; ++j) xv[j] = __builtin_nontemporal_load((const f32x4*)(p.xres + (size_t)m * D + 256 * j + 4 * lane));
        if (p.y_mode) {
            f32x4 yv[4]; float ss = 0.f;
#pragma unroll
            for (int j = 0; j < 4; ++j) {
                if (p.y_mode == 1) { const u32x2 p0 = __builtin_nontemporal_load((const u32x2*)((const u16*)p.y + (size_t)m * D + 256 * j + 4 * lane));
                    yv[j] = (f32x4){__uint_as_float(p0.x << 16), __uint_as_float(p0.x & 0xffff0000u), __uint_as_float(p0.y << 16), __uint_as_float(p0.y & 0xffff0000u)}; }
                else { const u16* yb = (const u16*)p.y + (size_t)m * 2 * D + 256 * j + 4 * lane; const u32x2 p0 = __builtin_nontemporal_load((const u32x2*)yb), p1 = __builtin_nontemporal_load((const u32x2*)(yb + D));
                    yv[j] = (f32x4){__uint_as_float(p0.x << 16) + __uint_as_float(p1.x << 16), __uint_as_float(p0.x & 0xffff0000u) + __uint_as_float(p1.x & 0xffff0000u),
                                    __uint_as_float(p0.y << 16) + __uint_as_float(p1.y << 16), __uint_as_float(p0.y & 0xffff0000u) + __uint_as_float(p1.y & 0xffff0000u)}; }
                ss += yv[j].x * yv[j].x + yv[j].y * yv[j].y + yv[j].z * yv[j].z + yv[j].w * yv[j].w;
            }
            const float rstd = rsqrtf(wave_sum(ss) * (1.f / D) + EPS);
#pragma unroll
            for (int j = 0; j < 4; ++j) {
                const f32x4 g = *(const f32x4*)(p.g_post + 256 * j + 4 * lane), ga = *(const f32x4*)(p.gate + (size_t)b * MODW + 256 * j + 4 * lane);
                xv[j] = xv[j] + ga * (yv[j] * rstd * g);
            }
        }
        if (p.xout) {
#pragma unroll
            for (int j = 0; j < 4; ++j) __builtin_nontemporal_store(xv[j], (f32x4*)(p.xout + (size_t)m * D + 256 * j + 4 * lane));
        }
        if (p.g_pre) {
            float ss = 0.f;
#pragma unroll
            for (int j = 0; j < 4; ++j) ss += xv[j].x * xv[j].x + xv[j].y * xv[j].y + xv[j].z * xv[j].z + xv[j].w * xv[j].w;
            const float rstd = rsqrtf(wave_sum(ss) * (1.f / D) + EPS);
            f32x4 hv[4];
#pragma unroll
            for (int j = 0; j < 4; ++j) {
                const f32x4 g = *(const f32x4*)(p.g_pre + 256 * j + 4 * lane), s1 = *(const f32x4*)(p.sc + (size_t)b * MODW + 256 * j + 4 * lane), s0 = *(const f32x4*)(p.sh + (size_t)b * MODW + 256 * j + 4 * lane);
                hv[j] = xv[j] * rstd * g * (s1 + 1.0f) + s0;
                if (p.h8) __builtin_nontemporal_store(pk4_fp8(hv[j].x, hv[j].y, hv[j].z, hv[j].w), (unsigned*)(p.h8 + (size_t)m * D + 256 * j + 4 * lane));
                else { u32x2 w; w.x = pk2(hv[j].x, hv[j].y); w.y = pk2(hv[j].z, hv[j].w); __builtin_nontemporal_store(w, (u32x2*)(p.hout + (size_t)m * D + 256 * j + 4 * lane)); }
            }
            if (p.extra) {
                float dt[8];
#pragma unroll
                for (int o = 0; o < 8; ++o) dt[o] = 0.f;
#pragma unroll
                for (int j = 0; j < 4; ++j)
#pragma unroll
                    for (int o = 0; o < 8; ++o) { const f32x4 w4 = *(const __attribute__((address_space(3))) f32x4*)(wl + o * D + 256 * j + 4 * lane);
                        dt[o] += hv[j][0] * w4[0] + hv[j][1] * w4[1] + hv[j][2] * w4[2] + hv[j][3] * w4[3]; }
#pragma unroll
                for (int o = 0; o < 8; ++o) dt[o] = wave_sum(dt[o]) + p.bex[o];
                if (p.extra == 1) {
                    if (lane < 8) {
                        float xl = dt[0];
#pragma unroll
                        for (int o = 1; o < 8; ++o) xl = (lane == o) ? dt[o] : xl;
                        const float ls = xl > 0.f ? -log1pf(__expf(-xl)) : xl - log1pf(__expf(xl));
                        p.logf[((size_t)b * 8 + lane) * S + t] = ls;
                    }
                } else if (lane == 0) {
                    float v1 = -INFINITY, v2 = -INFINITY; int i1 = 0, i2 = 0;
#pragma unroll
                    for (int o = 0; o < 8; ++o) { const float g = dt[o]; if (g > v1) { v2 = v1; i2 = i1; v1 = g; i1 = o; } else if (g > v2) { v2 = g; i2 = o; } }
                    const float g1 = 1.f / (1.f + __expf(v2 - v1)), g2 = 1.f - g1;
                    int pos = atomicAdd(p.cnt + i1, 1); p.list_tw[i1 * M + pos] = m * 2; p.list_g[i1 * M + pos] = g1;
                    pos = atomicAdd(p.cnt + i2, 1); p.list_tw[i2 * M + pos] = m * 2 + 1; p.list_g[i2 * M + pos] = g2;
                }
            }
        }
    }
}
__device__ __forceinline__ float gelu_tanh(float x) { return 0.5f * x * (1.f + tanhf(0.7978845608028654f * (x + 0.044715f * x * x * x))); }
namespace pg8 {
#define PG8_LAS __attribute__((address_space(3)))
typedef unsigned short bf16_t;
typedef short bf16x8 __attribute__((ext_vector_type(8)));
typedef int i32x4_t __attribute__((ext_vector_type(4)));
constexpr int BM = 256, BK = 64, HALF = 128, HTB = HALF * BK * 2  , STAGE_BYTES = 8 * HTB, NXCD = 8, WGM = 8;

__host__ __device__ __forceinline__ int lds_byte(int r, int c) { const int st = (r >> 4) * 2 + (c >> 5), rr = r & 15, cc = c & 31, ob = rr * 64 + cc * 2; return st * 1024 + (ob ^ (((ob >> 9) & 1) << 5)); }
__host__ __device__ __forceinline__ void stage_rc(int b, int& R, int& C) { const int st = b / 1024, sb = b % 1024, swz = sb ^ (((sb >> 9) & 1) << 5); R = (st >> 1) * 16 + swz / 64; C = (st & 1) * 32 + (swz % 64) / 2; }
__host__ __device__ __forceinline__ int perm32(int rho) { const int n = rho >> 4, i = rho & 15; return 8 * (i >> 2) + 4 * n + (i & 3); }

struct Unit { int pm, pn; const char* A; const char* B; int e, rt; };

struct DenseOrder {
    int nM, nN, nwg, G, c; const char* A; const char* Bt; unsigned tstepA, tstepB, cstepA;
    __device__ void init(const void* A_, int lda, const void* Bt_, int M, int N, int K, int G_, int c_) { nM = M / BM; nN = N / BM; nwg = nM * nN; G = G_; c = c_; A = (const char*)A_; Bt = (const char*)Bt_; tstepA = (unsigned)BM * lda * 2; tstepB = (unsigned)BM * K * 2; cstepA = 0; }
    __device__ bool next(int i, Unit& u) const {
        const long L = (long)i * G + c; if (L >= nwg) return false;
        int wgid = (int)L; { const int q = nwg / NXCD, r = nwg % NXCD, xcd = wgid % NXCD, off = wgid / NXCD; wgid = (xcd < r ? xcd * (q + 1) : r * (q + 1) + (xcd - r) * q) + off; }
        const int nig = WGM * nN, gid = wgid / nig, fm = gid * WGM, gsz = (nM - fm) < WGM ? (nM - fm) : WGM;
        u.pm = fm + ((wgid % nig) % gsz); u.pn = (wgid % nig) / gsz; u.A = A + (size_t)u.pm * tstepA + (size_t)u.pn * cstepA; u.B = Bt + (size_t)u.pn * tstepB; u.e = 0; u.rt = 0; return true;
    }
    __device__ __forceinline__ unsigned grow(const Unit&, int) const { return 0u; }
};
struct MoeOrder {
    int tp[9]; int cnt[8]; int nN, G, c, total; const char* A; const char* Bt; size_t estrideB, tstepB, tstepA; const int* ltw; int K2; int gather;
    __device__ void init(const int* cntp, const void* A_, const void* Bt_, size_t estrideB_, int N, int K, int G_, int c_, const int* ltw_, int gather_) {
        int s = 0;
        for (int e = 0; e < 8; ++e) { cnt[e] = __builtin_amdgcn_readfirstlane(cntp[e]); tp[e] = s; s += (cnt[e] + 255) >> 8; }
        tp[8] = s; nN = N / BM; total = s * nN; G = G_; c = c_; A = (const char*)A_; Bt = (const char*)Bt_; estrideB = estrideB_; tstepB = (size_t)BM * K * 2; tstepA = (size_t)BM * K * 2; ltw = ltw_; K2 = K * 2; gather = gather_;
    }
    __device__ bool next(int i, Unit& u) const {
        const long L = (long)i * G + c; if (L >= total) return false;
        const int tg = (int)(L / nN); u.pn = (int)(L % nN); u.pm = tg;
        int e = 0, tpe = 0;
#pragma unroll
        for (int j = 1; j < 8; ++j) if (tg >= tp[j]) { e = j; tpe = tp[j]; }
        u.e = e; u.rt = tg - tpe;
        u.A = gather ? A : A + (size_t)tg * tstepA; u.B = Bt + (size_t)e * estrideB + (size_t)u.pn * tstepB; return true;
    }
    __device__ __forceinline__ int nvalid(const Unit& u) const { int n = 0;
#pragma unroll
        for (int j = 0; j < 8; ++j) n = (u.e == j) ? cnt[j] : n;
        n -= u.rt * 256; return n > 256 ? 256 : n; }
    __device__ __forceinline__ unsigned grow(const Unit& u, int rr) const {
        const int nv = nvalid(u); int tok = 0;
        if (rr < nv) tok = ltw[(size_t)u.e * 16384 + u.rt * 256 + rr] >> 1;
        return (unsigned)tok * (unsigned)K2;
    }
};

__device__ __forceinline__ unsigned cvt_pk_bf16(float lo, float hi) { unsigned r; asm volatile("v_cvt_pk_bf16_f32 %0, %1, %2" : "=v"(r) : "v"(lo), "v"(hi)); return r; }

template <class Epi, class Sched, bool GATHER, bool ALIGN_EPI, bool FP8 = false>
__device__ __forceinline__ void gemm_phase(PG8_LAS unsigned char* lds, const int K, const int lda, const Sched& S, const Epi& E) {
    const int tid = threadIdx.x, wid = __builtin_amdgcn_readfirstlane(tid >> 6), lane = tid & 63, wr = wid >> 2, wc = wid & 3, fr = lane & 15, fq = lane >> 4;
    const int nt = K / BK;
    unsigned voffA[2], voffB[2]; int RA[2], CA[2];
#pragma unroll
    for (int i = 0; i < 2; ++i) { int R, C; stage_rc(tid * 16 + i * 8192, R, C); const int Rb = Epi::PERM ? ((R & ~31) + perm32(R & 31)) : R;
        RA[i] = R; CA[i] = C; voffA[i] = (unsigned)(R * lda + C) * 2u; voffB[i] = (unsigned)(Rb * K + C) * 2u; }
    const size_t kstep = (size_t)(BK * 2);
    const size_t hstepB = (size_t)HALF * K * 2;
    const size_t hstepA = GATHER ? 0 : (size_t)HALF * lda * 2;
    const unsigned ldsw = (unsigned)wid * 1024u;
    const unsigned ldsa = (unsigned)__builtin_amdgcn_readfirstlane((int)((unsigned)(size_t)lds + ldsw));
    const int aoff = lds_byte(wr * 64 + fr, fq * 8), boff = lds_byte(wc * 32 + fr, fq * 8);
#define PG8_SA(b, h) (((b) * 2 + (h)) * HTB)
#define PG8_SB(b, h) ((4 + (b) * 2 + (h)) * HTB)
#define PG8_STAGE(bufoff, gbase, voff) do { _Pragma("unroll") for (int _i = 0; _i < 2; ++_i) { unsigned _keep; \
        asm volatile("s_mov_b32 %0, m0\n\ts_mov_b32 m0, %3\n\ts_nop 0\n\tglobal_load_lds_dwordx4 %1, %2\n\ts_mov_b32 m0, %0" : "=&s"(_keep) : "v"((voff)[_i]), "s"((const char*)(gbase)), "s"(ldsa + (unsigned)(bufoff) + (unsigned)(_i * 8192)) : "memory"); } } while (0)
#define PG8_LDA(dst, b, h) do { _Pragma("unroll") for (int m = 0; m < 4; ++m) _Pragma("unroll") for (int k = 0; k < 2; ++k) dst[m][k] = *(const PG8_LAS bf16x8*)(lds + PG8_SA(b, h) + aoff + m * 2048 + k * 1024); } while (0)
#define PG8_LDB(dst, b, h) do { _Pragma("unroll") for (int n = 0; n < 2; ++n) _Pragma("unroll") for (int k = 0; k < 2; ++k) dst[n][k] = *(const PG8_LAS bf16x8*)(lds + PG8_SB(b, h) + boff + n * 2048 + k * 1024); } while (0)
#define PG8_CAT(X) __builtin_shufflevector(__builtin_bit_cast(i32x4_t, (X)[0]), __builtin_bit_cast(i32x4_t, (X)[1]), 0, 1, 2, 3, 4, 5, 6, 7)
#define PG8_MMA(ai, bj, At, Bt) do { __builtin_amdgcn_s_setprio(1); _Pragma("unroll") for (int m = 0; m < 4; ++m) _Pragma("unroll") for (int n = 0; n < 2; ++n) { \
        if constexpr (FP8) asm volatile("v_mfma_scale_f32_16x16x128_f8f6f4 %0, %1, %2, %0, %3, %3 op_sel_hi:[0,0,0]" : "+v"(acc[ai][bj][m][n]) : "v"(PG8_CAT(Bt[n])), "v"(PG8_CAT(At[m])), "v"(0x7f7f7f7f));   \
        else { _Pragma("unroll") for (int k = 0; k < 2; ++k) acc[ai][bj][m][n] = __builtin_amdgcn_mfma_f32_16x16x32_bf16(Bt[n][k], At[m][k], acc[ai][bj][m][n], 0, 0, 0); } } \
        __builtin_amdgcn_s_setprio(0); } while (0)
#define PG8_WAIT_V(n) asm volatile("s_waitcnt vmcnt(" #n ")" ::: "memory")
#define PG8_WAIT_L(n) asm volatile("s_waitcnt lgkmcnt(" #n ")" ::: "memory")
#define PG8_BAR __builtin_amdgcn_s_barrier()
#define PG8_SCHED __builtin_amdgcn_sched_barrier(0)
    Unit cur, nxt; int ui = 0;
    if (!S.next(0, cur)) return;
    unsigned gc[2][2], gn[2][2];
#pragma unroll
    for (int h = 0; h < 2; ++h)
#pragma unroll
        for (int i = 0; i < 2; ++i) { gc[h][i] = GATHER ? S.grow(cur, h * HALF + RA[i]) + (unsigned)CA[i] * 2u : voffA[i]; gn[h][i] = gc[h][i]; }
    f32x4 acc[2][2][4][2];
#pragma unroll
    for (int a = 0; a < 2; ++a)
#pragma unroll
        for (int b = 0; b < 2; ++b)
#pragma unroll
            for (int m = 0; m < 4; ++m)
#pragma unroll
                for (int n = 0; n < 2; ++n) acc[a][b][m][n] = (f32x4){0.f, 0.f, 0.f, 0.f};
    bf16x8 At[4][2], B0[2][2], B1[2][2];
    const char* cA = cur.A; const char* cB = cur.B;
    PG8_STAGE(PG8_SB(0, 0), cB, voffB); PG8_STAGE(PG8_SB(0, 1), cB + hstepB, voffB); PG8_STAGE(PG8_SA(0, 0), cA, gc[0]); PG8_STAGE(PG8_SA(0, 1), cA + hstepA, gc[1]);
    if (wr == 1) PG8_BAR;
    PG8_WAIT_V(2); PG8_BAR;
    PG8_STAGE(PG8_SB(1, 0), cB + kstep, voffB); PG8_STAGE(PG8_SA(1, 0), cA + kstep, gc[0]); PG8_STAGE(PG8_SB(1, 1), cB + hstepB + kstep, voffB);
    PG8_WAIT_V(6); PG8_BAR;
    for (;;) {
        const bool has_next = S.next(ui + 1, nxt);
        const char* nA = has_next ? nxt.A : cA; const char* nB = has_next ? nxt.B : cB;
        if (GATHER) {
#pragma unroll
            for (int h = 0; h < 2; ++h)
#pragma unroll
                for (int i = 0; i < 2; ++i) gn[h][i] = has_next ? S.grow(nxt, h * HALF + RA[i]) + (unsigned)CA[i] * 2u : gc[h][i];
        }
        for (int t = 0; t < nt; t += 2) {
            const bool last = (t == nt - 2);
            const char* a1 = cA + (size_t)(t + 1) * kstep;
            const char* a2 = last ? nA : cA + (size_t)(t + 2) * kstep; const char* b2 = last ? nB : cB + (size_t)(t + 2) * kstep;
            const char* a3 = a2 + kstep; const char* b3 = b2 + kstep;
            unsigned g2[2][2];
#pragma unroll
            for (int h = 0; h < 2; ++h)
#pragma unroll
                for (int i = 0; i < 2; ++i) g2[h][i] = (GATHER && last) ? gn[h][i] : gc[h][i];
            PG8_LDB(B0, 0, 0); PG8_LDB(B1, 0, 1); PG8_SCHED; PG8_LDA(At, 0, 0); PG8_STAGE(PG8_SA(1, 1), a1 + hstepA, gc[1]);
            PG8_WAIT_V(8); PG8_WAIT_L(0); PG8_BAR; PG8_MMA(0, 0, At, B0); PG8_MMA(0, 1, At, B1); PG8_BAR; PG8_SCHED;
            PG8_LDA(At, 0, 1); PG8_STAGE(PG8_SB(0, 0), b2, voffB); PG8_STAGE(PG8_SB(0, 1), b2 + hstepB, voffB); PG8_STAGE(PG8_SA(0, 0), a2, g2[0]);
            PG8_WAIT_V(8); PG8_WAIT_L(0); PG8_BAR; PG8_MMA(1, 0, At, B0); PG8_MMA(1, 1, At, B1); PG8_BAR; PG8_SCHED;
            PG8_LDB(B0, 1, 0); PG8_LDB(B1, 1, 1); PG8_SCHED; PG8_LDA(At, 1, 0); PG8_STAGE(PG8_SA(0, 1), a2 + hstepA, g2[1]);
            PG8_WAIT_V(8); PG8_WAIT_L(0); PG8_BAR; PG8_MMA(0, 0, At, B0); PG8_MMA(0, 1, At, B1); PG8_BAR; PG8_SCHED;
            PG8_LDA(At, 1, 1); PG8_STAGE(PG8_SB(1, 0), b3, voffB); PG8_STAGE(PG8_SB(1, 1), b3 + hstepB, voffB); PG8_STAGE(PG8_SA(1, 0), a3, g2[0]);
            PG8_WAIT_V(8); PG8_WAIT_L(0); PG8_BAR; PG8_MMA(1, 0, At, B0); PG8_MMA(1, 1, At, B1); PG8_BAR; PG8_SCHED;
        }
        if constexpr (ALIGN_EPI) { if (wr == 0) PG8_BAR; }
        if constexpr (FP8) asm volatile("s_nop 15\n\ts_nop 7" ::: "memory");
        E(acc, cur, S, wr, wc, fr, fq);
        if (!has_next) break;
#pragma unroll
        for (int a = 0; a < 2; ++a)
#pragma unroll
            for (int b = 0; b < 2; ++b)
#pragma unroll
                for (int m = 0; m < 4; ++m)
#pragma unroll
                    for (int n = 0; n < 2; ++n) acc[a][b][m][n] = (f32x4){0.f, 0.f, 0.f, 0.f};
        cur = nxt; cA = nA; cB = nB; ++ui;
#pragma unroll
        for (int h = 0; h < 2; ++h)
#pragma unroll
            for (int i = 0; i < 2; ++i) gc[h][i] = gn[h][i];
        if constexpr (ALIGN_EPI) { if (wr == 1) PG8_BAR; }
    }
    PG8_WAIT_V(0);
    if constexpr (!ALIGN_EPI) { if (wr == 0) PG8_BAR; }
    PG8_BAR;
#undef PG8_SA
#undef PG8_SB
#undef PG8_STAGE
#undef PG8_LDA
#undef PG8_LDB
#undef PG8_MMA
#undef PG8_CAT
#undef PG8_WAIT_V
#undef PG8_WAIT_L
#undef PG8_BAR
#undef PG8_SCHED
}
}
namespace pg8 {
struct EpiF32 {
    static constexpr bool PERM = false;
    float* C; int ldc;
    template <class Sched> __device__ __forceinline__ void operator()(const f32x4 (&acc)[2][2][4][2], const Unit& u, const Sched&, int wr, int wc, int fr, int fq) const {
        const int row0 = u.pm * BM + wr * 64 + fr, col0 = u.pn * BM + wc * 32 + 4 * fq;
#pragma unroll
        for (int ai = 0; ai < 2; ++ai)
#pragma unroll
            for (int m = 0; m < 4; ++m) { float* rowp = C + (size_t)(row0 + ai * HALF + m * 16) * ldc + col0;
#pragma unroll
                for (int bj = 0; bj < 2; ++bj)
#pragma unroll
                    for (int n = 0; n < 2; ++n) *(f32x4*)(rowp + bj * HALF + n * 16) = acc[ai][bj][m][n]; }
    }
};
struct EpiBf16 {
    static constexpr bool PERM = true;
    u16* O; int ldc;
    template <class Sched> __device__ __forceinline__ void operator()(const f32x4 (&acc)[2][2][4][2], const Unit& u, const Sched&, int wr, int wc, int fr, int fq) const {
        const int row0 = u.pm * BM + wr * 64 + fr, col0 = u.pn * BM + wc * 32 + 8 * fq;
#pragma unroll
        for (int ai = 0; ai < 2; ++ai)
#pragma unroll
            for (int m = 0; m < 4; ++m) { u16* rowp = O + (size_t)(row0 + ai * HALF + m * 16) * ldc + col0;
#pragma unroll
                for (int bj = 0; bj < 2; ++bj) { const f32x4 v0 = acc[ai][bj][m][0], v1 = acc[ai][bj][m][1];
                    u32x4 w; w.x = cvt_pk_bf16(v0[0], v0[1]); w.y = cvt_pk_bf16(v0[2], v0[3]); w.z = cvt_pk_bf16(v1[0], v1[1]); w.w = cvt_pk_bf16(v1[2], v1[3]);
                    *(u32x4*)(rowp + bj * HALF) = w; } }
    }
};
__device__ __forceinline__ float silu_f(float v) { return v * __builtin_amdgcn_rcpf(1.f + __builtin_amdgcn_exp2f(-1.4426950408889634f * v)); }
struct EpiSwiglu {
    static constexpr bool PERM = true;
    u16* O; int ldc;
    template <class Sched> __device__ __forceinline__ void operator()(const f32x4 (&acc)[2][2][4][2], const Unit& u, const Sched&, int wr, int wc, int fr, int fq) const {
        const int row0 = u.pm * BM + wr * 64 + fr, col0 = u.pn * HALF + wc * 32 + 8 * fq;
#pragma unroll
        for (int ai = 0; ai < 2; ++ai)
#pragma unroll
            for (int m = 0; m < 4; ++m) { u16* rowp = O + (size_t)(row0 + ai * HALF + m * 16) * ldc + col0;
                f32x4 v0, v1;
#pragma unroll
                for (int i = 0; i < 4; ++i) { v0[i] = silu_f(acc[ai][0][m][0][i]) * acc[ai][1][m][0][i]; v1[i] = silu_f(acc[ai][0][m][1][i]) * acc[ai][1][m][1][i]; }
                u32x4 w; w.x = cvt_pk_bf16(v0[0], v0[1]); w.y = cvt_pk_bf16(v0[2], v0[3]); w.z = cvt_pk_bf16(v1[0], v1[1]); w.w = cvt_pk_bf16(v1[2], v1[3]);
                *(u32x4*)rowp = w; }
    }
};
struct EpiSwiglu8 {
    static constexpr bool PERM = true;
    unsigned char* O; int ldc; const float* isc;
    template <class Sched> __device__ __forceinline__ void operator()(const f32x4 (&acc)[2][2][4][2], const Unit& u, const Sched&, int wr, int wc, int fr, int fq) const {
        const int row0 = u.pm * BM + wr * 64 + fr, col0 = u.pn * HALF + wc * 32 + 8 * fq;
        const float* sp = isc + (size_t)u.e * 7168 + u.pn * BM + wc * 32 + 8 * fq;
        const f32x4 sg0 = *(const f32x4*)sp, sg1 = *(const f32x4*)(sp + 4), su0 = *(const f32x4*)(sp + HALF) * 2.f, su1 = *(const f32x4*)(sp + HALF + 4) * 2.f;
        const f32x4 se0 = sg0 * -1.4426950408889634f, se1 = sg1 * -1.4426950408889634f;
#pragma unroll
        for (int ai = 0; ai < 2; ++ai)
#pragma unroll
            for (int m = 0; m < 4; ++m) { unsigned char* rowp = O + (size_t)(row0 + ai * HALF + m * 16) * ldc + col0;
                f32x4 v0, v1;
#pragma unroll
                for (int i = 0; i < 4; ++i) { const float g0 = acc[ai][0][m][0][i], g1 = acc[ai][0][m][1][i];
                    v0[i] = (g0 * sg0[i]) * __builtin_amdgcn_rcpf(1.f + __builtin_amdgcn_exp2f(g0 * se0[i])) * (acc[ai][1][m][0][i] * su0[i]);
                    v1[i] = (g1 * sg1[i]) * __builtin_amdgcn_rcpf(1.f + __builtin_amdgcn_exp2f(g1 * se1[i])) * (acc[ai][1][m][1][i] * su1[i]); }
                u32x2 w; w.x = pk4_fp8(v0[0], v0[1], v0[2], v0[3]); w.y = pk4_fp8(v1[0], v1[1], v1[2], v1[3]);
                *(u32x2*)rowp = w; }
    }
};
struct EpiQKV {
    static constexpr bool PERM = true;
    u16* Q; u16* K; u16* V; const float* rope; float* ksum; unsigned* kn2;
    template <class Sched> __device__ __forceinline__ void operator()(f32x4 (&acc)[2][2][4][2], const Unit& u, const Sched&, int wr, int wc, int fr, int fq) const {
        const int part = u.pn >> 2, pq = u.pn & 3;
        u16* base = Q + (size_t)part * ((size_t)16384 * 1024);
        const int row0 = u.pm * BM + wr * 64 + fr;
        const bool ropew = (part < 2) && (pq < 2) && ((wc & 1) == 0);
        if (ropew) {
            const float sgn = fq == 0 ? -1.f : 1.f;
#pragma unroll
            for (int ai = 0; ai < 2; ++ai)
#pragma unroll
                for (int m = 0; m < 4; ++m) {
                    const int pos = (row0 + ai * HALF + m * 16) & 4095;
                    const f32x4 t0 = *(const f32x4*)(rope + pos * 16), t1 = *(const f32x4*)(rope + pos * 16 + 4), t2 = *(const f32x4*)(rope + pos * 16 + 8), t3 = *(const f32x4*)(rope + pos * 16 + 12);
                    const float cs[8] = {t0[0], t0[2], t1[0], t1[2], t2[0], t2[2], t3[0], t3[2]}, sn[8] = {t0[1], t0[3], t1[1], t1[3], t2[1], t2[3], t3[1], t3[3]};
#pragma unroll
                    for (int bj = 0; bj < 2; ++bj)
#pragma unroll
                        for (int n = 0; n < 2; ++n)
#pragma unroll
                            for (int i = 0; i < 4; ++i) {
                                const float mine = acc[ai][bj][m][n][i]; const float oth = __shfl_xor(mine, 16);
                                const float rot = mine * cs[4 * n + i] + sgn * oth * sn[4 * n + i];
                                acc[ai][bj][m][n][i] = fq < 2 ? rot : mine;
                            }
                }
        }
        if (part == 1 && pq < 2) {
            const int b = u.pm >> 4, blk = u.pm & 15;
#pragma unroll
            for (int bj = 0; bj < 2; ++bj)
#pragma unroll
                for (int n = 0; n < 2; ++n)
#pragma unroll
                    for (int i = 0; i < 4; ++i) {
                        float s = 0.f;
#pragma unroll
                        for (int ai = 0; ai < 2; ++ai)
#pragma unroll
                            for (int m = 0; m < 4; ++m) s += acc[ai][bj][m][n][i];
                        s += __shfl_xor(s, 1); s += __shfl_xor(s, 2); s += __shfl_xor(s, 4); s += __shfl_xor(s, 8);
                        if (fr == 0) { const int cc = pq * 256 + bj * HALF + wc * 32 + 8 * fq + 4 * n + i;
                            atomicAdd(ksum + ((size_t)(b * 8 + (cc >> 6)) * 16 + blk) * 64 + (cc & 63), s); }
                    }
        }
        if (part == 1 && pq >= 2) {
            const int b = u.pm >> 4;
#pragma unroll
            for (int bj = 0; bj < 2; ++bj) { float mx = 0.f;
#pragma unroll
                for (int ai = 0; ai < 2; ++ai)
#pragma unroll
                    for (int m = 0; m < 4; ++m) { const f32x4 v0 = acc[ai][bj][m][0], v1 = acc[ai][bj][m][1];
                        mx = __builtin_fmaxf(mx, (v0[0] * v0[0] + v0[1] * v0[1]) + (v0[2] * v0[2] + v0[3] * v0[3]) + (v1[0] * v1[0] + v1[1] * v1[1]) + (v1[2] * v1[2] + v1[3] * v1[3])); }
                mx = __builtin_fmaxf(mx, __shfl_xor(mx, 1)); mx = __builtin_fmaxf(mx, __shfl_xor(mx, 2)); mx = __builtin_fmaxf(mx, __shfl_xor(mx, 4)); mx = __builtin_fmaxf(mx, __shfl_xor(mx, 8));
                if (fr == 0) { const int hf = (pq - 2) * 4 + bj * 2 + (wc >> 1); atomicMax(kn2 + (b * 8 + hf) * 8 + (wc & 1) * 4 + fq, __float_as_uint(mx)); } }
        }
        const float sc = part == 0 ? C2 : 1.f;
        const int col0 = pq * BM + wc * 32 + 8 * fq;
#pragma unroll
        for (int ai = 0; ai < 2; ++ai)
#pragma unroll
            for (int m = 0; m < 4; ++m) { u16* rowp = base + (size_t)(row0 + ai * HALF + m * 16) * 1024 + col0;
#pragma unroll
                for (int bj = 0; bj < 2; ++bj) { const f32x4 v0 = acc[ai][bj][m][0] * sc, v1 = acc[ai][bj][m][1] * sc;
                    u32x4 w; w.x = cvt_pk_bf16(v0[0], v0[1]); w.y = cvt_pk_bf16(v0[2], v0[3]); w.z = cvt_pk_bf16(v1[0], v1[1]); w.w = cvt_pk_bf16(v1[2], v1[3]);
                    *(u32x4*)(rowp + bj * HALF) = w; } }
    }
};
struct EpiMoeDown {
    static constexpr bool PERM = true;
    u16* Y; const int* ltw; const float* lg; const float* isc;
    template <class Sched> __device__ __forceinline__ void operator()(const f32x4 (&acc)[2][2][4][2], const Unit& u, const Sched& S, int wr, int wc, int fr, int fq) const {
        const int nv = S.nvalid(u); const size_t lbase = (size_t)u.e * 16384 + u.rt * 256;
        const int col0 = u.pn * BM + wc * 32 + 8 * fq;
        const float* sp = isc + (size_t)u.e * 1024 + col0;
        f32x4 cs[2][2];
#pragma unroll
        for (int bj = 0; bj < 2; ++bj) { cs[bj][0] = *(const f32x4*)(sp + bj * HALF) * 0.5f; cs[bj][1] = *(const f32x4*)(sp + bj * HALF + 4) * 0.5f; }
#pragma unroll
        for (int ai = 0; ai < 2; ++ai)
#pragma unroll
            for (int m = 0; m < 4; ++m) { const int rr = ai * HALF + wr * 64 + m * 16 + fr;
                if (rr < nv) { const int tw = ltw[lbase + rr]; const float g = lg[lbase + rr]; u16* rowp = Y + (size_t)tw * 1024 + col0;
#pragma unroll
                    for (int bj = 0; bj < 2; ++bj) { const f32x4 v0 = acc[ai][bj][m][0] * cs[bj][0] * g, v1 = acc[ai][bj][m][1] * cs[bj][1] * g;
                        u32x4 w; w.x = cvt_pk_bf16(v0[0], v0[1]); w.y = cvt_pk_bf16(v0[2], v0[3]); w.z = cvt_pk_bf16(v1[0], v1[1]); w.w = cvt_pk_bf16(v1[2], v1[3]);
                        *(u32x4*)(rowp + bj * HALF) = w; } } }
    }
};
__device__ __forceinline__ float one_minus_exp(float t) { return t > -0.02f ? -t * (1.f + t * (0.5f + t * (0.16666667f + t * 0.041666667f))) : 1.f - __expf(t); }
struct EpiGates {
    static constexpr bool PERM = true;
    char* wsb; size_t o_la, o_xi, o_conv, o_tab;
    template <class Sched> __device__ __forceinline__ void operator()(f32x4 (&acc)[2][2][4][2], const Unit& u, const Sched&, int wr, int wc, int fr, int fq) const {
        const int row0 = u.pm * BM + wr * 64 + fr, ch0 = u.pn * HALF + wc * 32 + 8 * fq;
        u16* LA = (u16*)(wsb + o_la); u16* XI = (u16*)(wsb + o_xi); const u16* conv = (const u16*)(wsb + o_conv); const float* tab = (const float*)(wsb + o_tab) + ch0;
        asm volatile("" ::: "memory"); __builtin_amdgcn_sched_barrier(0);
        {
            float ba[8], sp8[8];
#pragma unroll
            for (int j = 0; j < 2; ++j) { const f32x4 t = *(const f32x4*)(tab + 4 * j), t2 = *(const f32x4*)(tab + 2 * 1280 + 4 * j); ba[4 * j] = t[0]; ba[4 * j + 1] = t[1]; ba[4 * j + 2] = t[2]; ba[4 * j + 3] = t[3]; sp8[4 * j] = t2[0]; sp8[4 * j + 1] = t2[1]; sp8[4 * j + 2] = t2[2]; sp8[4 * j + 3] = t2[3]; }
#pragma unroll
            for (int ai = 0; ai < 2; ++ai)
#pragma unroll
                for (int m = 0; m < 4; ++m)
#pragma unroll
                    for (int j = 0; j < 8; ++j) acc[ai][0][m][j >> 2][j & 3] = sp8[j] * __builtin_amdgcn_rcpf(1.f + __expf(-(acc[ai][0][m][j >> 2][j & 3] + ba[j])));
        }
        float bx[8];
#pragma unroll
        for (int j = 0; j < 2; ++j) { const f32x4 t = *(const f32x4*)(tab + 1280 + 4 * j); bx[4 * j] = t[0]; bx[4 * j + 1] = t[1]; bx[4 * j + 2] = t[2]; bx[4 * j + 3] = t[3]; }
#pragma unroll
        for (int ai = 0; ai < 2; ++ai)
#pragma unroll
            for (int m = 0; m < 4; ++m) { const size_t off = (size_t)(row0 + ai * HALF + m * 16) * 1280 + ch0;
                const u32x4 cv = *(const u32x4*)(conv + off);
                u32x4 wl, wx;
#pragma unroll
                for (int q = 0; q < 4; ++q) {
                    const float c0 = __uint_as_float(cv[q] << 16), c1 = __uint_as_float(cv[q] & 0xffff0000u);
                    const int j0 = 2 * q, j1 = 2 * q + 1;
                    const float la0 = acc[ai][0][m][j0 >> 2][j0 & 3], la1 = acc[ai][0][m][j1 >> 2][j1 & 3];
                    const float rx0 = acc[ai][1][m][j0 >> 2][j0 & 3] + bx[j0], rx1 = acc[ai][1][m][j1 >> 2][j1 & 3] + bx[j1];
                    const float x0 = __builtin_amdgcn_sqrtf(one_minus_exp(2.f * la0)) * (c0 * __builtin_amdgcn_rcpf(1.f + __expf(-rx0))), x1 = __builtin_amdgcn_sqrtf(one_minus_exp(2.f * la1)) * (c1 * __builtin_amdgcn_rcpf(1.f + __expf(-rx1)));
                    wl[q] = cvt_pk_bf16(la0, la1); wx[q] = cvt_pk_bf16(x0, x1);
                }
                *(u32x4*)(LA + off) = wl; *(u32x4*)(XI + off) = wx;
                asm volatile("" ::: "memory"); }
    }
};
}
#include <hip/hip_bf16.h>
namespace attn_body {
using bf16=__hip_bfloat16;
using bf16x8=__attribute__((ext_vector_type(8)))short;
using s16x4=__attribute__((ext_vector_type(4)))short;
using f32x16=__attribute__((ext_vector_type(16)))float;
using u32x4=__attribute__((ext_vector_type(4)))unsigned;
constexpr int BATCH=4,NHEAD=16,SEQ=4096,D=64,DM=NHEAD*D;
constexpr int NW=8,QBLK=32,QB=QBLK*NW,KVBLK=64,NQB=SEQ/QB;
constexpr int ATTN_PITCH=DM, ATTN_UNIT_ROWS=QB;
__device__ __forceinline__ int crow(int r,int hi){return (r&3)+8*(r>>2)+4*hi;}
#define SBAR() __builtin_amdgcn_sched_barrier(0)
__device__ __forceinline__ void cmask(f32x16&p0,f32x16&p1,int jb,int qrel,int hi){
  const float NEG=-INFINITY; int kb=64*jb+4*hi;
  #pragma unroll
  for(int r=0;r<16;++r){int kv=kb+(r&3)+8*(r>>2); if(kv>qrel)p0[r]=NEG; if(kv+32>qrel)p1[r]=NEG;}
}

constexpr int NSLOT=3, SLOTB=8192;
constexpr int LDS_K=0, LDS_V=NSLOT*SLOTB, LDS_WS=2*NSLOT*SLOTB, LDS_OST=LDS_WS+NW*64*4, LDS_KB=LDS_OST+NW*4096, LDS_BYTES=LDS_KB+16384;
constexpr float C2=0.125f*1.4426950408889634f;
__device__ __forceinline__ void glds16(const void*gsrc,unsigned lds_dst){unsigned keep;
  asm volatile("s_mov_b32 %0, m0\n\ts_mov_b32 m0, %2\n\ts_nop 0\n\tglobal_load_lds_dwordx4 %1, off\n\ts_mov_b32 m0, %0":"=&s"(keep):"v"(gsrc),"s"(lds_dst):"memory");}
__device__ __forceinline__ float max3f(float a,float b,float c){float r;asm("v_max3_f32 %0, %1, %2, %3":"=v"(r):"v"(a),"v"(b),"v"(c));return r;}
__device__ __forceinline__ float max2f(float a,float b){float r;asm("v_max_f32_e32 %0, %1, %2":"=v"(r):"v"(a),"v"(b));return r;}
__device__ __forceinline__ float fadd_s(float a,float b){float r;asm("v_add_f32_e32 %0, %1, %2":"=v"(r):"v"(a),"v"(b));return r;}
__device__ __forceinline__ float fsub_s(float a,float b){float r;asm("v_sub_f32_e32 %0, %1, %2":"=v"(r):"v"(a),"v"(b));return r;}
typedef float f32x2_t __attribute__((ext_vector_type(2))); typedef __bf16 bf16x2_t __attribute__((ext_vector_type(2)));
__device__ __forceinline__ unsigned cvtpk_s(float lo,float hi){f32x2_t v={lo,hi};bf16x2_t b=__builtin_convertvector(v,bf16x2_t);return __builtin_bit_cast(unsigned,b);}
#define WAIT_BAR(N) asm volatile("s_waitcnt vmcnt(" #N ") lgkmcnt(0)\n\ts_barrier":::"memory")

__device__ __forceinline__ void qkt(f32x16&p0,f32x16&p1,const char*Kslot,const bf16x8*qr,const f32x16&negm,int r32,int hi){
  const char*kb=Kslot+hi*1024+r32*16;
  #pragma unroll
  for(int d0=0;d0<4;++d0){
    const bf16x8 b0=*reinterpret_cast<const bf16x8*>(kb+d0*2048);
    const bf16x8 b1=*reinterpret_cast<const bf16x8*>(kb+d0*2048+512);
    if(d0==0){p0=__builtin_amdgcn_mfma_f32_32x32x16_bf16(b0,qr[0],negm,0,0,0);p1=__builtin_amdgcn_mfma_f32_32x32x16_bf16(b1,qr[0],negm,0,0,0);}
    else{p0=__builtin_amdgcn_mfma_f32_32x32x16_bf16(b0,qr[d0],p0,0,0,0);p1=__builtin_amdgcn_mfma_f32_32x32x16_bf16(b1,qr[d0],p1,0,0,0);}}
}
__device__ __forceinline__ void qkt_acc(f32x16&p0,f32x16&p1,const char*Kslot,const bf16x8*qr,int r32,int hi){
  const char*kb=Kslot+hi*1024+r32*16;
  #pragma unroll
  for(int d0=0;d0<4;++d0){
    const bf16x8 b0=*reinterpret_cast<const bf16x8*>(kb+d0*2048);
    const bf16x8 b1=*reinterpret_cast<const bf16x8*>(kb+d0*2048+512);
    p0=__builtin_amdgcn_mfma_f32_32x32x16_bf16(b0,qr[d0],p0,0,0,0);p1=__builtin_amdgcn_mfma_f32_32x32x16_bf16(b1,qr[d0],p1,0,0,0);}
}
typedef __attribute__((address_space(3))) const char* lds_cptr;
typedef short v4i16_t __attribute__((ext_vector_type(4)));
__device__ __forceinline__ void kload8(bf16x8*kf,lds_cptr kp){
  kf[0]=*(const __attribute__((address_space(3))) bf16x8*)(kp);      kf[1]=*(const __attribute__((address_space(3))) bf16x8*)(kp+512);
  kf[2]=*(const __attribute__((address_space(3))) bf16x8*)(kp+2048); kf[3]=*(const __attribute__((address_space(3))) bf16x8*)(kp+2560);
  kf[4]=*(const __attribute__((address_space(3))) bf16x8*)(kp+4096); kf[5]=*(const __attribute__((address_space(3))) bf16x8*)(kp+4608);
  kf[6]=*(const __attribute__((address_space(3))) bf16x8*)(kp+6144); kf[7]=*(const __attribute__((address_space(3))) bf16x8*)(kp+6656);
}
__device__ __forceinline__ void kload2(bf16x8*kf,lds_cptr kp,int j){ kf[2*j]=*(const __attribute__((address_space(3))) bf16x8*)(kp+j*2048); kf[2*j+1]=*(const __attribute__((address_space(3))) bf16x8*)(kp+j*2048+512); }
__device__ __forceinline__ s16x4 vtr(lds_cptr p){ return __builtin_bit_cast(s16x4,__builtin_amdgcn_ds_read_tr16_b64_v4i16((__attribute__((address_space(3))) v4i16_t*)p)); }
__device__ __forceinline__ float rowmax(const f32x16&p0,const f32x16&p1){
  float a=max3f(p0[0],p0[1],p1[0]),b=max3f(p0[2],p0[3],p1[1]);a=max3f(a,p1[2],p1[3]);
  #pragma unroll
  for(int r=4;r<16;r+=4){a=max3f(a,p0[r],p0[r+1]);b=max3f(b,p0[r+2],p0[r+3]);a=max3f(a,p1[r],p1[r+1]);b=max3f(b,p1[r+2],p1[r+3]);}
  const float m=max2f(a,b);
  auto rr=__builtin_amdgcn_permlane32_swap(__float_as_uint(m),__float_as_uint(m),false,false);
  return max2f(__uint_as_float(rr[0]),__uint_as_float(rr[1]));
}
__device__ __forceinline__ void pv(f32x16*o,int vb,bf16x8 pa0,bf16x8 pa1,bf16x8 pa2,bf16x8 pa3){
  #pragma unroll
  for(int d0=0;d0<2;++d0){s16x4 lo[4],hi[4];
    #pragma unroll
    for(int ks=0;ks<4;++ks){
      asm volatile("ds_read_b64_tr_b16 %0,%1 offset:%c2":"=&v"(lo[ks]):"v"(vb),"i"(d0*4096+ks*1024):"memory");
      asm volatile("ds_read_b64_tr_b16 %0,%1 offset:%c2":"=&v"(hi[ks]):"v"(vb),"i"(d0*4096+ks*1024+512):"memory");}
    asm volatile("s_waitcnt lgkmcnt(0)":::"memory");SBAR();
    #define PK(k) (bf16x8){lo[k][0],lo[k][1],lo[k][2],lo[k][3],hi[k][0],hi[k][1],hi[k][2],hi[k][3]}
    o[d0]=__builtin_amdgcn_mfma_f32_32x32x16_bf16(pa0,PK(0),o[d0],0,0,0);
    o[d0]=__builtin_amdgcn_mfma_f32_32x32x16_bf16(pa1,PK(1),o[d0],0,0,0);
    o[d0]=__builtin_amdgcn_mfma_f32_32x32x16_bf16(pa2,PK(2),o[d0],0,0,0);
    o[d0]=__builtin_amdgcn_mfma_f32_32x32x16_bf16(pa3,PK(3),o[d0],0,0,0);
    #undef PK
  }
}

#ifndef ATTN_STORE16
#define ATTN_STORE16(p,v) (*(u32x4*)(p)=(v))
#endif
template<int THRL,bool MOBA> __device__ __forceinline__ void attn_unit(int b,int h,int qb,const bf16*Q,const bf16*__restrict__ K,const bf16*__restrict__ V,bf16*O,char*shm,const float*aux,const unsigned*kn2){
  int tid_=threadIdx.x; asm volatile("":"+v"(tid_));
  const int tid=tid_,lane=tid&63,r32=lane&31,hi=lane>>5; const int wid=__builtin_amdgcn_readfirstlane(tid>>6);
  const long rowbase=(long)b*SEQ; const int q0=qb*QB;
  const bf16*Qw=Q+(rowbase+q0+wid*QBLK)*DM+h*D;
  const bf16*Kh=K+rowbase*DM+h*D,*Vh=V+rowbase*DM+h*D;
  const lds_cptr shm3=(lds_cptr)shm;
  const unsigned lds0=(unsigned)(uintptr_t)shm;
  float*wsf=(float*)(shm+LDS_WS)+wid*64;
  const bf16*ksrc=Kh+(long)lane*DM+wid*8;
  const bf16*vsrc=Vh+(long)(16*(wid&3)+(lane>>2))*DM+(wid>>2)*32+(lane&3)*8;
  const unsigned kdst=lds0+LDS_K+wid*1024, vdst=lds0+LDS_V+wid*1024;
  #define TA(t) (NTA-1-(t))
  #define DMA_K(t,slot) glds16(ksrc+(long)(TA(t))*KVBLK*DM,(unsigned)__builtin_amdgcn_readfirstlane(kdst+(slot)))
  #define DMA_V(t,slot) glds16(vsrc+(long)(TA(t))*KVBLK*DM,(unsigned)__builtin_amdgcn_readfirstlane(vdst+(slot)))
  const int vb0=(int)(lds0+LDS_V)+((lane>>4)&1)*32+(lane&3)*8+(4*hi+((lane&15)>>2))*64;
  const char*Kbase=shm+LDS_K; bf16x8 kf[8];
  const lds_cptr kp0=shm3+LDS_K+hi*1024+r32*16; const lds_cptr vp0=shm3+LDS_V+((lane>>4)&1)*32+(lane&3)*8+(4*hi+((lane&15)>>2))*64;
  const int NTA=(q0+QB)/KVBLK;
  int NT=NTA;
  typedef __attribute__((address_space(3))) const float* lds_fptr; typedef float f32x4_t __attribute__((ext_vector_type(4)));
  const lds_fptr kbl=(lds_fptr)(shm3+LDS_KB);
  if constexpr(MOBA){ if(qb>0){
      if(tid<qb*16){ const f32x4_t v=*(const __attribute__((address_space(1))) f32x4_t*)(aux+tid*4); *(__attribute__((address_space(3))) f32x4_t*)((__attribute__((address_space(3))) char*)shm3+LDS_KB+tid*16)=v; } } }
  else {
    glds16(aux+(wid*2)*256+lane*4,(unsigned)__builtin_amdgcn_readfirstlane(lds0+LDS_KB+(wid*2)*1024));
    glds16(aux+(wid*2+1)*256+lane*4,(unsigned)__builtin_amdgcn_readfirstlane(lds0+LDS_KB+(wid*2+1)*1024)); }
  DMA_K(0,0);DMA_V(0,0);DMA_K(1,SLOTB);
  bf16x8 qr[4];
  #pragma unroll
  for(int d0=0;d0<4;++d0)qr[d0]=*reinterpret_cast<const bf16x8*>(&Qw[(long)r32*DM+d0*16+hi*8]);
  float mhat=0.f,l_reg=0.f;f32x16 o[2];o[0]=f32x16{};o[1]=f32x16{};f32x16 negm=f32x16{};if constexpr(MOBA)asm volatile("":"+v"(negm));
  unsigned amask=0xffffffffu;
  const int qrel=wid*QBLK+r32;
  #define CMASK(P0,P1,t) do{ if((t)<4)cmask(P0,P1,3-(t),qrel,hi); }while(0)
  bool resc=false;
  #define START(P0,P1) do{ const float rm=rowmax(P0,P1); resc=false; \
    { const float dl=rm<-1e37f?0.f:rm; mhat=fadd_s(mhat,dl);     \
      _Pragma("unroll") for(int r=0;r<16;++r){P0[r]=fsub_s(P0[r],dl);P1[r]=fsub_s(P1[r],dl);} \
      if constexpr(MOBA){ _Pragma("unroll") for(int r=0;r<16;++r)negm[r]=-mhat; asm volatile("":"+v"(negm)); } } \
    _Pragma("unroll") for(int r=0;r<16;++r)P0[r]=__builtin_amdgcn_exp2f(P0[r]); }while(0)
  #define RESC() do{ if(resc){ asm volatile("s_waitcnt lgkmcnt(0)":::"memory"); \
      _Pragma("unroll") for(int d_=0;d_<2;++d_) _Pragma("unroll") for(int r=0;r<16;++r)o[d_][r]*=wsf[crow(r,hi)]; } }while(0)
  f32x16 pA0,pA1,pB0,pB1;
  int sl_prev=0,sl_cur=0,sl_next=SLOTB;
  #define ROT() do{sl_prev=sl_cur;sl_cur=sl_next;sl_next=(sl_next==(NSLOT-1)*SLOTB)?0:sl_next+SLOTB;}while(0)
  DMA_K(2,2*SLOTB);
  if constexpr(!MOBA){
    float s2=0.f;
    #pragma unroll
    for(int d0=0;d0<4;++d0){
      #pragma unroll
      for(int i=0;i<8;++i){ const float qv=__uint_as_float(((unsigned)(unsigned short)qr[d0][i])<<16); s2+=qv*qv; } }
    { auto rr=__builtin_amdgcn_permlane32_swap(__float_as_uint(s2),__float_as_uint(s2),false,false); s2=__uint_as_float(rr[0])+__uint_as_float(rr[1]); }
    #pragma unroll
    for(int o_=1;o_<32;o_<<=1)s2=__builtin_fmaxf(s2,__shfl_xor(s2,o_));
    if(lane==0)wsf[63]=s2; }
  WAIT_BAR(3);
  #define INITB(C0,C1,t) do{ const lds_fptr kbp_=kbl+TA(t)*64+4*hi; \
    _Pragma("unroll") for(int g_=0;g_<4;++g_){ const f32x4_t b0_=*(const __attribute__((address_space(3))) f32x4_t*)(kbp_+8*g_), b1_=*(const __attribute__((address_space(3))) f32x4_t*)(kbp_+32+8*g_); \
      _Pragma("unroll") for(int i_=0;i_<4;++i_){ C0[4*g_+i_]=b0_[i_]-mhat; C1[4*g_+i_]=b1_[i_]-mhat; } } }while(0)
  if constexpr(MOBA){
    if(qb>0){
      float qf[32];
      #pragma unroll
      for(int d0=0;d0<4;++d0){
        #pragma unroll
        for(int i=0;i<8;++i)qf[8*d0+i]=__uint_as_float(((unsigned)(unsigned short)qr[d0][i])<<16);}
      float v1=-INFINITY,v2=-INFINITY,v3=-INFINITY;int i1=-1,i2=-1,i3=-1;
      for(int j=0;j<qb;++j){ const lds_fptr kr=kbl+j*64+8*hi; float g=0.f;
        #pragma unroll
        for(int d0=0;d0<4;++d0){ const f32x4_t a_=*(const __attribute__((address_space(3))) f32x4_t*)(kr+16*d0), b_=*(const __attribute__((address_space(3))) f32x4_t*)(kr+16*d0+4);
          g+=qf[8*d0]*a_[0]+qf[8*d0+1]*a_[1]+qf[8*d0+2]*a_[2]+qf[8*d0+3]*a_[3]+qf[8*d0+4]*b_[0]+qf[8*d0+5]*b_[1]+qf[8*d0+6]*b_[2]+qf[8*d0+7]*b_[3]; }
        { auto rr=__builtin_amdgcn_permlane32_swap(__float_as_uint(g),__float_as_uint(g),false,false); g=__uint_as_float(rr[0])+__uint_as_float(rr[1]); }
        if(g>v1){v3=v2;i3=i2;v2=v1;i2=i1;v1=g;i1=j;} else if(g>v2){v3=v2;i3=i2;v2=g;i2=j;} else if(g>v3){v3=g;i3=j;} }
      amask=1u<<qb; if(i1>=0)amask|=1u<<i1; if(i2>=0)amask|=1u<<i2; if(i3>=0)amask|=1u<<i3; }
    qkt(pA0,pA1,Kbase,qr,negm,r32,hi);
  } else {
    float q2=0.f,k2=0.f;
    #pragma unroll
    for(int w_=0;w_<8;++w_){ q2=__builtin_fmaxf(q2,((const float*)(shm+LDS_WS))[w_*64+63]); k2+=__uint_as_float(kn2[w_]); }
    const float bnd=2.f*1.02f*__builtin_sqrtf(q2)*__builtin_sqrtf(k2)-kbl[q0]+64.f;
    const bool dead=(lane<NTA)&&(kbl[64*lane+63]+bnd<0.f);
    const int nskip=__builtin_popcountll(__ballot(dead));
    NT=NTA-nskip; NT=(NT+1)&~1; NT=NT<4?4:NT;
    INITB(pA0,pA1,0); qkt_acc(pA0,pA1,Kbase,qr,r32,hi); }
  asm volatile("s_nop 15\n\ts_nop 7":"+v"(pA0),"+v"(pA1));CMASK(pA0,pA1,0);
  START(pA0,pA1);
  _Pragma("unroll") for(int r=0;r<16;++r)pA1[r]=__builtin_amdgcn_exp2f(pA1[r]);
  WAIT_BAR(0);
  DMA_K(3,0);DMA_V(1,SLOTB);
  ROT();
  kload8(kf,kp0+sl_cur);
  WAIT_BAR(2);
  s16x4 vlo[8],vhi[8]; u32x4 pw0,pw1,pw2,pw3;
  #define PKW(P,B) cvtpk_s(P[B],P[B+1])
  #define PAF(k) __builtin_bit_cast(bf16x8,pw##k)
  #define VFR(i) (bf16x8){vlo[i][0],vlo[i][1],vlo[i][2],vlo[i][3],vhi[i][0],vhi[i][1],vhi[i][2],vhi[i][3]}
  #define PIN(x) asm volatile("":"+v"(x))
  #define MX3(a,b,c) __builtin_fmaxf(__builtin_fmaxf((a),(b)),(c))
  #define GAPA(MF,A0,A1,A2,A3,W0,W1,PW) do{ MF; sacc+=A0; sacc+=A1; sacc+=A2; sacc+=A3; PIN(sacc); W0; W1; PIN(PW); SBAR(); }while(0)
  #define EX(v) __builtin_amdgcn_exp2f(v)
  #define GAPB(MF,X,B) do{ MF; X[B]=EX(X[B]); X[B+1]=EX(X[B+1]); X[B+2]=EX(X[B+2]); X[B+3]=EX(X[B+3]); PIN(X); SBAR(); }while(0)
  #define VRD(i) do{ vlo[i]=vtr(vp_+(((i)>>2)*4096+((i)&3)*1024)); vhi[i]=vtr(vp_+(((i)>>2)*4096+((i)&3)*1024+512)); }while(0)
  #define KRD(G,j) do{ if(G){ kload2(kf,kp0+sl_next,j); SBAR(); } }while(0)
  #define CIN(X) (MOBA?negm:X)
  #define STEP(C0,C1,P0,P1,t,GK,GV,GL) do{ SBAR(); \
    if constexpr(!MOBA){ INITB(C0,C1,t); SBAR(); } \
    const lds_cptr vp_=vp0+sl_prev; \
    VRD(0); SBAR(); float sacc=(P0[0]+P0[1]); \
    GAPA(C0=__builtin_amdgcn_mfma_f32_32x32x16_bf16(kf[0],qr[0],CIN(C0),0,0,0), P0[2],P0[3],P0[4],P0[5],     pw0[0]=PKW(P0,0), pw0[1]=PKW(P0,2), pw0); \
    VRD(4); SBAR(); GAPA(C1=__builtin_amdgcn_mfma_f32_32x32x16_bf16(kf[1],qr[0],CIN(C1),0,0,0), P0[6],P0[7],P0[8],P0[9],     pw0[2]=PKW(P0,4), pw0[3]=PKW(P0,6), pw0); \
    VRD(1); SBAR(); GAPA(C0=__builtin_amdgcn_mfma_f32_32x32x16_bf16(kf[2],qr[1],C0,0,0,0),   P0[10],P0[11],P0[12],P0[13], pw1[0]=PKW(P0,8), pw1[1]=PKW(P0,10), pw1); \
    VRD(5); SBAR(); GAPA(C1=__builtin_amdgcn_mfma_f32_32x32x16_bf16(kf[3],qr[1],C1,0,0,0),   P0[14],P0[15],P1[0],P1[1],   pw1[2]=PKW(P0,12),pw1[3]=PKW(P0,14), pw1); \
    VRD(2); SBAR(); GAPA(C0=__builtin_amdgcn_mfma_f32_32x32x16_bf16(kf[4],qr[2],C0,0,0,0),   P1[2],P1[3],P1[4],P1[5],     pw2[0]=PKW(P1,0), pw2[1]=PKW(P1,2), pw2); \
    VRD(6); SBAR(); GAPA(C1=__builtin_amdgcn_mfma_f32_32x32x16_bf16(kf[5],qr[2],C1,0,0,0),   P1[6],P1[7],P1[8],P1[9],     pw2[2]=PKW(P1,4), pw2[3]=PKW(P1,6), pw2); \
    VRD(3); SBAR(); GAPA(C0=__builtin_amdgcn_mfma_f32_32x32x16_bf16(kf[6],qr[3],C0,0,0,0),   P1[10],P1[11],P1[12],P1[13], pw3[0]=PKW(P1,8), pw3[1]=PKW(P1,10), pw3); \
    VRD(7); SBAR(); GAPA(C1=__builtin_amdgcn_mfma_f32_32x32x16_bf16(kf[7],qr[3],C1,0,0,0),   P1[14],P1[15],0.f,0.f,       pw3[2]=PKW(P1,12),pw3[3]=PKW(P1,14), pw3); \
    if constexpr(MOBA){ const bool okp_=((amask>>(TA((t)-1)>>2))&1u)!=0u; l_reg+=okp_?sacc:0.f; \
      _Pragma("unroll") for(int i_=0;i_<4;++i_){ pw0[i_]=okp_?pw0[i_]:0u; pw1[i_]=okp_?pw1[i_]:0u; pw2[i_]=okp_?pw2[i_]:0u; pw3[i_]=okp_?pw3[i_]:0u; } } \
    else { l_reg+=sacc; } \
    if(GK){DMA_K((t)+3,sl_cur);} if(GV){DMA_V((t)+1,sl_next);} \
    CMASK(C0,C1,t); \
    { float a=MX3(C0[0],C0[1],C1[0]),b=MX3(C0[2],C0[3],C1[1]); a=MX3(a,C1[2],C1[3]); \
      _Pragma("unroll") for(int r=4;r<16;r+=4){a=MX3(a,C0[r],C0[r+1]);b=MX3(b,C0[r+2],C0[r+3]);a=MX3(a,C1[r],C1[r+1]);b=MX3(b,C1[r+2],C1[r+3]);} \
      float rm=__builtin_fmaxf(a,b); { auto rr=__builtin_amdgcn_permlane32_swap(__float_as_uint(rm),__float_as_uint(rm),false,false); rm=__builtin_fmaxf(__uint_as_float(rr[0]),__uint_as_float(rr[1])); } \
      resc=false; \
      if(__builtin_expect(__any(rm>(float)THRL),0)){ const float dl=__builtin_fmaxf(rm,0.f); mhat+=dl; \
        _Pragma("unroll") for(int r=0;r<16;++r){C0[r]-=dl;C1[r]-=dl;} \
        if constexpr(MOBA){ _Pragma("unroll") for(int r=0;r<16;++r)negm[r]=-mhat; asm volatile("":"+v"(negm)); } \
        const float f=__builtin_amdgcn_exp2f(-dl); l_reg*=f; if(hi==0)wsf[r32]=f; resc=true; } } \
    SBAR(); \
    GAPB(o[0]=__builtin_amdgcn_mfma_f32_32x32x16_bf16(PAF(0),VFR(0),o[0],0,0,0), C0,0); \
    GAPB(o[1]=__builtin_amdgcn_mfma_f32_32x32x16_bf16(PAF(0),VFR(4),o[1],0,0,0), C0,4); \
    KRD(GL,0); GAPB(o[0]=__builtin_amdgcn_mfma_f32_32x32x16_bf16(PAF(1),VFR(1),o[0],0,0,0), C0,8); \
    KRD(GL,1); GAPB(o[1]=__builtin_amdgcn_mfma_f32_32x32x16_bf16(PAF(1),VFR(5),o[1],0,0,0), C0,12); \
    KRD(GL,2); GAPB(o[0]=__builtin_amdgcn_mfma_f32_32x32x16_bf16(PAF(2),VFR(2),o[0],0,0,0), C1,0); \
    KRD(GL,3); GAPB(o[1]=__builtin_amdgcn_mfma_f32_32x32x16_bf16(PAF(2),VFR(6),o[1],0,0,0), C1,4); \
    GAPB(o[0]=__builtin_amdgcn_mfma_f32_32x32x16_bf16(PAF(3),VFR(3),o[0],0,0,0), C1,8); \
    GAPB(o[1]=__builtin_amdgcn_mfma_f32_32x32x16_bf16(PAF(3),VFR(7),o[1],0,0,0), C1,12); \
    }while(0)
  int t=1;
  for(;t+5<NT;t+=2){
    STEP(pB0,pB1,pA0,pA1,t,true,true,true);     WAIT_BAR(2); RESC(); ROT();
    STEP(pA0,pA1,pB0,pB1,t+1,true,true,true);   WAIT_BAR(2); RESC(); ROT();
  }
  #define ENDW(tt) do{ if((tt)+3<NT){WAIT_BAR(2);} else if((tt)+2<NT){WAIT_BAR(1);} else {WAIT_BAR(0);} }while(0)
  for(;t+1<NT;t+=2){
    STEP(pB0,pB1,pA0,pA1,t,(t+3<NT),(t+1<NT),(t+1<NT));       ENDW(t);   RESC(); ROT();
    STEP(pA0,pA1,pB0,pB1,t+1,(t+4<NT),(t+2<NT),(t+2<NT));     ENDW(t+1); RESC(); ROT();
  }
  STEP(pB0,pB1,pA0,pA1,NT-1,false,false,false); RESC();
  { float sacc=pB0[0]+pB0[1]; _Pragma("unroll") for(int r=2;r<16;++r)sacc+=pB0[r]; _Pragma("unroll") for(int r=0;r<16;++r)sacc+=pB1[r]; l_reg+=sacc;
    pw0=(u32x4){PKW(pB0,0),PKW(pB0,2),PKW(pB0,4),PKW(pB0,6)};pw1=(u32x4){PKW(pB0,8),PKW(pB0,10),PKW(pB0,12),PKW(pB0,14)};pw2=(u32x4){PKW(pB1,0),PKW(pB1,2),PKW(pB1,4),PKW(pB1,6)};pw3=(u32x4){PKW(pB1,8),PKW(pB1,10),PKW(pB1,12),PKW(pB1,14)};
    SBAR(); pv(o,vb0+sl_cur,PAF(0),PAF(1),PAF(2),PAF(3)); }
  #undef PKW
  #undef PAF
  #undef VFR
  #undef PIN
  #undef MX3
  #undef GAPA
  #undef GAPB
  #undef EX
  #undef VRD
  #undef KRD
  #undef STEP
  #undef CIN
  #undef INITB
  #undef ENDW
  {auto rr=__builtin_amdgcn_permlane32_swap(__float_as_uint(l_reg),__float_as_uint(l_reg),false,false);l_reg=__uint_as_float(rr[0])+__uint_as_float(rr[1]);}
  if(hi==0)wsf[32+r32]=l_reg;asm volatile("s_waitcnt lgkmcnt(0)":::"memory");
  float rli[16];
  #pragma unroll
  for(int r=0;r<16;++r)rli[r]=__builtin_amdgcn_rcpf(wsf[32+crow(r,hi)]);
  bf16*Ow=O+(rowbase+q0+wid*QBLK)*DM+h*D;
  { bf16*stg=(bf16*)(shm+LDS_OST)+wid*2048;
    #pragma unroll
    for(int r=0;r<16;++r){const int orow=crow(r,hi);
      #pragma unroll
      for(int d0=0;d0<2;++d0)stg[orow*64+d0*32+r32]=__float2bfloat16(o[d0][r]*rli[r]);}
    asm volatile("s_waitcnt lgkmcnt(0)":::"memory");
    #pragma unroll
    for(int i=0;i<4;++i){const int row=i*8+(lane>>3),ch=lane&7; const u32x4 v=*(const u32x4*)(stg+row*64+ch*8); ATTN_STORE16(Ow+(long)row*DM+ch*8,v);} }
  asm volatile("s_waitcnt lgkmcnt(0)\n\ts_barrier":::"memory");
  #undef DMA_K
  #undef DMA_V
  #undef TA
  #undef CMASK
  #undef START
  #undef RESC
  #undef ROT
}
constexpr int ATTN_LDS_BYTES=LDS_BYTES;
struct AttnTensors { const bf16* Q; const bf16* K; const bf16* V; bf16* O; };
struct AttnUnit { int b; int h; int qb; };
__device__ __forceinline__ void unit_of(int idx,AttnUnit&u){
  int grp=idx>>5; const int bh=idx&31; bool fox; int qb;
  if(grp<11){fox=false;qb=15-grp;} else if(grp<22){fox=true;qb=15-(grp-11);} else {grp-=22;fox=(grp&1)!=0;qb=4-(grp>>1);}
  u.b=bh>>3; u.h=(bh&7)+(fox?8:0); u.qb=qb;
}
template<int THRL=8> __device__ __forceinline__ void attn_phase(char*lds,const AttnTensors&T,const float*ksum,const float*kbias,const unsigned*kn2,int*qhead,volatile __attribute__((address_space(3))) int*slot){
  AttnUnit u;
  for(;;){
    if(threadIdx.x==0)slot[0]=atomicAdd(qhead,1);
    asm volatile("s_waitcnt vmcnt(0) lgkmcnt(0)\n\ts_barrier":::"memory");
    const int idx=slot[0];
    asm volatile("s_waitcnt lgkmcnt(0)\n\ts_barrier":::"memory");
    if(idx>=1024)break;
    unit_of(idx,u);
    if(u.h<8) attn_unit<THRL,true>(u.b,u.h,u.qb,T.Q,T.K,T.V,T.O,lds,ksum+(size_t)(u.b*8+u.h)*16*64,kn2);
    else attn_unit<THRL,false>(u.b,u.h,u.qb,T.Q,T.K,T.V,T.O,lds,kbias+(size_t)(u.b*8+(u.h-8))*SEQ,kn2+(u.b*8+(u.h-8))*8); }
}
#undef SBAR
#undef WAIT_BAR
}

constexpr size_t MiB = 1u << 20;
constexpr size_t WS_CTL = 0;
constexpr size_t WS_MOD = 1 * MiB;
constexpr size_t WS_ROPE = 1 * MiB + 256 * 1024;
constexpr size_t WS_LOGF = 1 * MiB + 512 * 1024;
constexpr size_t WS_KBIAS = 2 * MiB;
constexpr size_t WS_SP8 = 2 * MiB + 512 * 1024;
constexpr size_t WS_AGG = 3 * MiB;
constexpr size_t WS_LTW = 5 * MiB;
constexpr size_t WS_LG = 5 * MiB + 512 * 1024;
constexpr size_t WS_WMGU = 6 * MiB;
constexpr size_t WS_SB = 64 * MiB;
constexpr size_t WS_WMDN = 118 * MiB;
constexpr size_t WS_SBD = 65 * MiB;
constexpr size_t WS_WAIN = 174 * MiB;
constexpr size_t WS_WAOUT = 180 * MiB;
constexpr size_t WS_WFGU = 182 * MiB;
constexpr size_t WS_WFDN = 193 * MiB;
constexpr size_t WS_WLIN = 199 * MiB;
constexpr size_t WS_WLOUT = 204 * MiB;
constexpr size_t WS_WLG = 207 * MiB;
constexpr size_t WS_HA = 208 * MiB;
constexpr size_t WS_R = 240 * MiB;
constexpr size_t WS_Q = WS_R, WS_K = WS_R + 32 * MiB, WS_V = WS_R + 64 * MiB;
constexpr size_t WS_Y = WS_R + 96 * MiB;
constexpr size_t WS_O = WS_R + 128 * MiB;
constexpr size_t WS_HM = WS_R;
constexpr size_t WS_P2 = WS_R;
constexpr size_t WS_LA = WS_R + 80 * MiB;
constexpr size_t WS_XI = WS_R + 120 * MiB;
constexpr size_t WS_CONV = WS_R + 160 * MiB;
constexpr size_t WS_YL = WS_R + 200 * MiB;
constexpr size_t WS_HMID = WS_R;
constexpr size_t WS_YBUF = 174 * MiB;
constexpr size_t WS_END = 480 * MiB;
constexpr int CW_CNT = 64;
constexpr int CW_BAR = 4096;
constexpr int CW_KSUM = 65536;
constexpr int CW_AQ = 320;
constexpr int CW_CQG = 128, CW_CQD = 192;
constexpr int CW_KN2 = 98304;

constexpr int NWAVES = 8;
constexpr int RING_BYTES = 131072, CTRL_OFF = 139264, MISC_OFF = CTRL_OFF + 320, LDS_BYTES = 147456;

#define LAS __attribute__((address_space(3)))
#define GAS __attribute__((address_space(1)))
typedef GAS unsigned gu32;
#define LDS_WAIT() asm volatile("s_waitcnt lgkmcnt(0)" ::: "memory")

#define XB_TMO      128
#define XB_XCNT(j)  (256  + 64 * (j))
#define XB_XSUB(j)  (1280 + 64 * (j))
#define XB_XGEN(j)  (2304 + 64 * (j))
#define XB_TOP      3328
#define XB_TOPGEN   3392
#define XCD_BAR_WORDS 3456
#define XB_SPIN_CAP (1u << 18)

__device__ __forceinline__ unsigned xb_ld(unsigned* p)              { return __hip_atomic_load(p, __ATOMIC_RELAXED, __HIP_MEMORY_SCOPE_AGENT); }
__device__ __forceinline__ unsigned xb_add(unsigned* p, unsigned v) { return __hip_atomic_fetch_add(p, v, __ATOMIC_RELAXED, __HIP_MEMORY_SCOPE_AGENT); }
__device__ __forceinline__ unsigned xb_xcc_id() { return (unsigned)__builtin_amdgcn_s_getreg((3 << 11) | 20) & 0xFu; }
#define XB_SPIN(cond, bar) do { unsigned _sp = 0; while (cond) { __builtin_amdgcn_s_sleep(1); \
    if ((++_sp & 255u) == 0u) { if (xb_ld(&(bar)[XB_TMO])) break; if (_sp > XB_SPIN_CAP) { atomicAdd(&(bar)[XB_TMO], 1u); break; } } } } while (0)

struct XcdBarrier {
    unsigned* bar; unsigned x;
    volatile LAS unsigned* st;
};

__device__ __forceinline__ XcdBarrier xcd_barrier_post(unsigned* bar, volatile LAS unsigned* st) {
    XcdBarrier b; b.bar = bar; b.x = xb_xcc_id(); b.st = st;
    if (threadIdx.x == 0) (void)xb_add(&bar[XB_XCNT(b.x)], 1u);
    return b;
}
__device__ __forceinline__ void xcd_barrier_complete(unsigned* bar, unsigned x, unsigned& nloc, unsigned& nx) {
    const unsigned G = gridDim.x * gridDim.y * gridDim.z;
    unsigned sum, cnt, mine, sp = 0u;
    for (;;) {
        sum = 0u; cnt = 0u; mine = 0u;
#pragma unroll
        for (unsigned j = 0; j < 16; ++j) { const unsigned c = xb_ld(&bar[XB_XCNT(j)]); sum += c; cnt += (c > 0u) ? 1u : 0u; mine = (j == x) ? c : mine; }
        if (sum == G) break;
        __builtin_amdgcn_s_sleep(1);
        if ((++sp & 255u) == 0u) { if (xb_ld(&bar[XB_TMO])) break; if (sp > XB_SPIN_CAP) { atomicAdd(&bar[XB_TMO], 1u); break; } }
    }
    nloc = mine > 0u ? mine : 1u; nx = cnt > 0u ? cnt : 1u;
}

__device__ __forceinline__ void xcd_barrier(const XcdBarrier& b) {
    asm volatile("s_waitcnt vmcnt(0)" ::: "memory");
    __syncthreads();
    if (threadIdx.x == 0) {
        unsigned* bar = b.bar;
        __builtin_amdgcn_s_waitcnt(0);
        unsigned nloc = b.st[0], nx = b.st[1];
        if (nloc == 0u) { xcd_barrier_complete(bar, b.x, nloc, nx); b.st[0] = nloc; b.st[1] = nx; }
        const unsigned old = xb_add(&bar[XB_XSUB(b.x)], 1u);
        const unsigned gen = old / nloc;
        if (old + 1u == (gen + 1u) * nloc) {
            __builtin_amdgcn_fence(__ATOMIC_RELEASE, "agent");
            asm volatile("s_waitcnt vmcnt(0)" ::: "memory");
            const unsigned og = xb_add(&bar[XB_TOP], 1u);
            const unsigned tg = og / nx;
            if (og + 1u == (tg + 1u) * nx) xb_add(&bar[XB_TOPGEN], 1u);
            else XB_SPIN(xb_ld(&bar[XB_TOPGEN]) == tg, bar);
            __builtin_amdgcn_fence(__ATOMIC_ACQUIRE, "agent");
            xb_add(&bar[XB_XGEN(b.x)], 1u);
            asm volatile("s_waitcnt vmcnt(0)" ::: "memory");
        } else {
            XB_SPIN(xb_ld(&bar[XB_XGEN(b.x)]) == gen, bar);
            __builtin_amdgcn_fence(__ATOMIC_ACQUIRE, "agent");
            asm volatile("s_waitcnt vmcnt(0)" ::: "memory");
        }
    }
    __syncthreads();
}

__device__ __forceinline__ void cvt_item(const float* W, int ld, int K, int k0, int n0, u16* WT, int drow0, LAS float* scr, int lane) {
    float tv[32];
#pragma unroll
    for (int i = 0; i < 32; ++i) { const int kk = 2 * i + (lane >> 5); tv[i] = __builtin_nontemporal_load(W + (size_t)(k0 + kk) * ld + n0 + (lane & 31)); }
#pragma unroll
    for (int i = 0; i < 32; ++i) { const int kk = 2 * i + (lane >> 5); scr[kk * 33 + (lane & 31)] = tv[i]; }
    LDS_WAIT(); asm volatile("" ::: "memory");
    const int c = lane & 7;
#pragma unroll
    for (int j = 0; j < 4; ++j) { const int n = (lane >> 3) + 8 * j; const LAS float* s = scr + (8 * c) * 33 + n;
        u32x4 o; o.x = pk2(s[0 * 33], s[1 * 33]); o.y = pk2(s[2 * 33], s[3 * 33]); o.z = pk2(s[4 * 33], s[5 * 33]); o.w = pk2(s[6 * 33], s[7 * 33]);
        *(u32x4*)(WT + (size_t)(drow0 + n) * K + k0 + 8 * c) = o; }
    LDS_WAIT(); asm volatile("" ::: "memory");
}
__device__ __forceinline__ void cvt_job(const float* W, int ld, int K, int N, u16* WT, int mode, int r, LAS float* scr, int lane) {
    const int nblk = N / 32, kb = r / nblk, nb = r % nblk, n0 = nb * 32;
    const int drow0 = mode == 0 ? n0 : (n0 + (n0 >> 7) * 128 + (mode == 2 ? 128 : 0));
    cvt_item(W, ld, K, kb * 64, n0, WT, drow0, scr, lane);
}

__device__ __forceinline__ void cvt8_item(const float* W, int ld, int n0, unsigned char* WT, float* inv, int drow0, LAS float* t, int tid) {
    const int lane = tid & 63, wave = tid >> 6;
#pragma unroll
    for (int half = 0; half < 2; ++half) {
        float tv[32];
#pragma unroll
        for (int i = 0; i < 32; ++i) { const int kk = (half * 32 + i) * 16 + wave * 2 + (lane >> 5); tv[i] = __builtin_nontemporal_load(W + (size_t)kk * ld + n0 + (lane & 31)); }
#pragma unroll
        for (int i = 0; i < 32; ++i) { const int kk = (half * 32 + i) * 16 + wave * 2 + (lane >> 5); t[(lane & 31) * 1028 + kk] = tv[i]; }
    }
    __syncthreads();
#pragma unroll 1
    for (int r = 0; r < 4; ++r) { const int n = wave * 4 + r; const LAS float* row = t + n * 1028;
        f32x4 v[4]; float mx = 0.f;
#pragma unroll
        for (int j = 0; j < 4; ++j) { v[j] = *(const LAS f32x4*)(row + 256 * j + 4 * lane); mx = __builtin_fmaxf(mx, __builtin_fmaxf(__builtin_fmaxf(__builtin_fabsf(v[j][0]), __builtin_fabsf(v[j][1])), __builtin_fmaxf(__builtin_fabsf(v[j][2]), __builtin_fabsf(v[j][3])))); }
#pragma unroll
        for (int o = 1; o < 64; o <<= 1) mx = __builtin_fmaxf(mx, __shfl_xor(mx, o));
        const int e = (int)((__float_as_uint(mx) >> 23) & 0xffu) - 127;
        const bool ok = mx > 1e-30f && mx < 1e30f;
        const float sc = ok ? __uint_as_float((unsigned)(127 + 7 - e) << 23) : 1.f, isc = ok ? __uint_as_float((unsigned)(127 - 7 + e) << 23) : 1.f;
#pragma unroll
        for (int j = 0; j < 4; ++j) *(unsigned*)(WT + (size_t)(drow0 + n) * 1024 + 256 * j + 4 * lane) = pk4_fp8(v[j][0] * sc, v[j][1] * sc, v[j][2] * sc, v[j][3] * sc);
        if (lane == 0) inv[drow0 + n] = isc;
    }
    __syncthreads();
}

__device__ __forceinline__ void cvt8d_item(const float* W, int n0, unsigned char* WT, float* inv, LAS float* t, int tid) {
    const int lane = tid & 63, wave = tid >> 6;
    LAS float* red = t + 32 * 1028;
    float mx = 0.f;
    for (int i0 = 0; i0 < 224; i0 += 32) { float tv[32];
#pragma unroll
        for (int i = 0; i < 32; ++i) { const int kk = (i0 + i) * 16 + wave * 2 + (lane >> 5); tv[i] = W[(size_t)kk * 1024 + n0 + (lane & 31)]; }
#pragma unroll
        for (int i = 0; i < 32; ++i) mx = __builtin_fmaxf(mx, __builtin_fabsf(tv[i])); }
    mx = __builtin_fmaxf(mx, __shfl_xor(mx, 32));
    if (lane < 32) red[wave * 32 + lane] = mx;
    __syncthreads();
    if (tid < 32) { float m8 = 0.f;
#pragma unroll
        for (int w8 = 0; w8 < 8; ++w8) m8 = __builtin_fmaxf(m8, red[w8 * 32 + tid]);
        const int e = (int)((__float_as_uint(m8) >> 23) & 0xffu) - 127; const bool ok = m8 > 1e-30f && m8 < 1e30f;
        red[256 + tid] = ok ? __uint_as_float((unsigned)(127 + 7 - e) << 23) : 1.f; inv[n0 + tid] = ok ? __uint_as_float((unsigned)(127 - 7 + e) << 23) : 1.f; }
    __syncthreads();
#pragma unroll 1
    for (int k0 = 0; k0 < 3584; k0 += 1024) { const int nh = (k0 + 1024 <= 3584) ? 2 : 1;
        for (int half = 0; half < nh; ++half) { float tv[32];
#pragma unroll
            for (int i = 0; i < 32; ++i) { const int kk = (half * 32 + i) * 16 + wave * 2 + (lane >> 5); tv[i] = __builtin_nontemporal_load(W + (size_t)(k0 + kk) * 1024 + n0 + (lane & 31)); }
#pragma unroll
            for (int i = 0; i < 32; ++i) { const int kk = (half * 32 + i) * 16 + wave * 2 + (lane >> 5); t[(lane & 31) * 1028 + kk] = tv[i]; } }
        __syncthreads();
#pragma unroll 1
        for (int r = 0; r < 4; ++r) { const int n = wave * 4 + r; const LAS float* row = t + n * 1028; const float sc = red[256 + n];
#pragma unroll
            for (int j = 0; j < 4; ++j) if (j < 2 * nh) { const f32x4 v = *(const LAS f32x4*)(row + 256 * j + 4 * lane);
                *(unsigned*)(WT + (size_t)(n0 + n) * 3584 + k0 + 256 * j + 4 * lane) = pk4_fp8(v[0] * sc, v[1] * sc, v[2] * sc, v[3] * sc); } }
        __syncthreads();
    }
}


namespace lru {
typedef short bf16x8 __attribute__((ext_vector_type(8)));
typedef float f32x2 __attribute__((ext_vector_type(2)));
constexpr int AP = 272;
constexpr int L_AS = 0, L_BS = 256 * AP, L_GB = L_BS + 64 * AP, L_YS = L_GB + 256 * 64, L_WA = L_YS + 256 * 64, L_CW = L_WA + 8 * 32 * 8, L_END = L_CW + 5 * 128 * 4;
static_assert(L_END <= 131072, "LDS");
__device__ __forceinline__ float bfl(unsigned short v) { return __uint_as_float(((unsigned)v) << 16); }
__device__ __forceinline__ float gelu_fast(float x) { const float u2 = 1.5957691216057308f * (x + 0.044715f * x * x * x); return x - x * __builtin_amdgcn_rcpf(1.f + __expf(u2)); }
__device__ __forceinline__ void seg_apply(float& h, float A, float H) { h = __expf(A) * h + H; }
__device__ __forceinline__ void phase(LAS unsigned char* lds, int job, const float* cw, const float* cb, const u16* P2, u16* YL, const u16* WLG, const float* tab) {
    const int tid = threadIdx.x, lane = tid & 63, w = tid >> 6, l15 = lane & 15, g = lane >> 4;
    const int b = job / 40, n = (job % 40) >> 2, q = job & 3;
    const size_t row0 = (size_t)b * 4096;
    { const int r = tid >> 3, pc = tid & 7;
        const u16* src = WLG + ((size_t)n * 256 + (r < 32 ? 32 * q + r : 128 + 32 * q + (r - 32))) * 128 + pc * 16;
        const u32x4 v0 = *(const u32x4*)src, v1 = *(const u32x4*)(src + 8);
        *(LAS u32x4*)(lds + L_BS + r * AP + pc * 32) = v0; *(LAS u32x4*)(lds + L_BS + r * AP + pc * 32 + 16) = v1; }
    float ba[2], bx[2], sp[2];
#pragma unroll
    for (int chn = 0; chn < 2; ++chn) { const int c = 128 * n + 32 * q + 16 * chn + l15; ba[chn] = tab[c]; bx[chn] = tab[1280 + c]; sp[chn] = tab[2560 + c]; }
    u32x4 areg[11], gbreg[2];
    if (tid < 128) { LAS float* cwl = (LAS float*)(lds + L_CW); const int c = 128 * n + tid; cwl[tid] = cw[c]; cwl[128 + tid] = cw[1280 + c]; cwl[256 + tid] = cw[2560 + c]; cwl[384 + tid] = cw[3840 + c]; cwl[512 + tid] = cb[c]; }
    __syncthreads();
    const u16* aptr = P2 + (row0 + (tid >> 4) * 8) * 2560 + 1280 + 128 * n + (tid & 15) * 8;
    const u16* gptr = P2 + (row0 + (tid >> 2)) * 2560 + 128 * n + 32 * q + (tid & 3) * 8;
#define LRU_LOAD(t) do { _Pragma("unroll") for (int i = 0; i < 11; ++i) areg[i] = ((t) * 256 + (tid >> 4) * 8 + i >= 3) ? *(const u32x4*)(aptr + ((long)(t) * 256 + i - 3) * 2560) : (u32x4){0u, 0u, 0u, 0u}; \
        _Pragma("unroll") for (int i = 0; i < 2; ++i) gbreg[i] = *(const u32x4*)(gptr + ((size_t)(t) * 256 + 128 * i) * 2560); } while (0)
#define LRU_STASH() do { float cwr[4][8], cbr[8]; { const LAS float* cwl_ = (const LAS float*)(lds + L_CW) + (tid & 15) * 8; \
            _Pragma("unroll") for (int e_ = 0; e_ < 8; ++e_) { cwr[0][e_] = cwl_[e_]; cwr[1][e_] = cwl_[128 + e_]; cwr[2][e_] = cwl_[256 + e_]; cwr[3][e_] = cwl_[384 + e_]; cbr[e_] = cwl_[512 + e_]; } } \
        _Pragma("unroll") for (int i = 0; i < 8; ++i) { u32x4 o_; \
            _Pragma("unroll") for (int q_ = 0; q_ < 4; ++q_) { \
                const float lo_ = cbr[2 * q_] + cwr[0][2 * q_] * __uint_as_float(areg[i][q_] << 16) + cwr[1][2 * q_] * __uint_as_float(areg[i + 1][q_] << 16) + cwr[2][2 * q_] * __uint_as_float(areg[i + 2][q_] << 16) + cwr[3][2 * q_] * __uint_as_float(areg[i + 3][q_] << 16); \
                const float hi_ = cbr[2 * q_ + 1] + cwr[0][2 * q_ + 1] * __uint_as_float(areg[i][q_] & 0xffff0000u) + cwr[1][2 * q_ + 1] * __uint_as_float(areg[i + 1][q_] & 0xffff0000u) + cwr[2][2 * q_ + 1] * __uint_as_float(areg[i + 2][q_] & 0xffff0000u) + cwr[3][2 * q_ + 1] * __uint_as_float(areg[i + 3][q_] & 0xffff0000u); \
                o_[q_] = pk2(lo_, hi_); } \
            *(LAS u32x4*)(lds + L_AS + ((tid >> 4) * 8 + i) * AP + (tid & 15) * 16) = o_; } \
        _Pragma("unroll") for (int i = 0; i < 2; ++i) *(LAS u32x4*)(lds + L_GB + ((tid >> 2) + 128 * i) * 64 + (tid & 3) * 16) = gbreg[i]; } while (0)
    LRU_LOAD(0); LRU_STASH();
    __syncthreads();
    float hrun[2] = {0.f, 0.f};
    const int aoff = L_AS + (32 * w + l15) * AP + 16 * g, boff = L_BS + l15 * AP + 16 * g;
    for (int t = 0; t < 16; ++t) {
        if (t + 1 < 16) LRU_LOAD(t + 1);
        f32x4 acc[2][4];
#pragma unroll
        for (int m = 0; m < 2; ++m)
#pragma unroll
            for (int nn = 0; nn < 4; ++nn) acc[m][nn] = (f32x4){0.f, 0.f, 0.f, 0.f};
#pragma unroll
        for (int ks = 0; ks < 4; ++ks) {
            bf16x8 af[2], bfr[4];
#pragma unroll
            for (int m = 0; m < 2; ++m) af[m] = *(const LAS bf16x8*)(lds + aoff + 16 * m * AP + 64 * ks);
#pragma unroll
            for (int nn = 0; nn < 4; ++nn) bfr[nn] = *(const LAS bf16x8*)(lds + boff + 16 * nn * AP + 64 * ks);
#pragma unroll
            for (int m = 0; m < 2; ++m)
#pragma unroll
                for (int nn = 0; nn < 4; ++nn) acc[m][nn] = __builtin_amdgcn_mfma_f32_16x16x32_bf16(af[m], bfr[nn], acc[m][nn], 0, 0, 0);
        }
        float E[2][2][4], hl[2][2][4];
#pragma unroll
        for (int chn = 0; chn < 2; ++chn)
#pragma unroll
            for (int m = 0; m < 2; ++m) { float pe = 1.f, hh = 0.f;
#pragma unroll
                for (int r = 0; r < 4; ++r) { const int rt = 32 * w + 16 * m + 4 * g + r;
                    const float cv = bfl(*(const LAS unsigned short*)(lds + L_AS + rt * AP + (32 * q + 16 * chn + l15) * 2));
                    const float la = sp[chn] * __builtin_amdgcn_rcpf(1.f + __expf(-(acc[m][chn][r] + ba[chn])));
                    const float ig = __builtin_amdgcn_rcpf(1.f + __expf(-(acc[m][chn + 2][r] + bx[chn])));
                    const float av = __expf(la), t2 = 2.f * la;
                    const float om = t2 > -0.02f ? -t2 * (1.f + t2 * (0.5f + t2 * (0.16666667f + t2 * 0.041666667f))) : 1.f - av * av;
                    const float xi = __builtin_amdgcn_sqrtf(om) * (ig * cv);
                    pe *= av; hh = av * hh + xi; E[chn][m][r] = pe; hl[chn][m][r] = hh; } }
        float gE[2][2][4], gH[2][2][4];
#pragma unroll
        for (int chn = 0; chn < 2; ++chn)
#pragma unroll
            for (int m = 0; m < 2; ++m)
#pragma unroll
                for (int gg = 0; gg < 4; ++gg) { gE[chn][m][gg] = __shfl(E[chn][m][3], l15 + 16 * gg); gH[chn][m][gg] = __shfl(hl[chn][m][3], l15 + 16 * gg); }
        if (g == 0) {
#pragma unroll
            for (int chn = 0; chn < 2; ++chn) { float Ew = 1.f, Hw = 0.f;
#pragma unroll
                for (int m = 0; m < 2; ++m)
#pragma unroll
                    for (int gg = 0; gg < 4; ++gg) { Hw = gE[chn][m][gg] * Hw + gH[chn][m][gg]; Ew *= gE[chn][m][gg]; }
                *(LAS f32x2*)(lds + L_WA + (w * 32 + 16 * chn + l15) * 8) = (f32x2){Ew, Hw}; }
        }
        __syncthreads();
#pragma unroll
        for (int chn = 0; chn < 2; ++chn) {
            float hw = hrun[chn], hall = hrun[chn];
#pragma unroll
            for (int ww = 0; ww < 8; ++ww) { const f32x2 sg = *(const LAS f32x2*)(lds + L_WA + (ww * 32 + 16 * chn + l15) * 8); hall = sg[0] * hall + sg[1]; if (ww < w) hw = hall; }
            hrun[chn] = hall;
            float h0 = hw;
#pragma unroll
            for (int gg = 0; gg < 3; ++gg) if (gg < g) h0 = gE[chn][0][gg] * h0 + gH[chn][0][gg];
            float h1 = hw;
#pragma unroll
            for (int gg = 0; gg < 4; ++gg) h1 = gE[chn][0][gg] * h1 + gH[chn][0][gg];
#pragma unroll
            for (int gg = 0; gg < 3; ++gg) if (gg < g) h1 = gE[chn][1][gg] * h1 + gH[chn][1][gg];
#pragma unroll
            for (int m = 0; m < 2; ++m)
#pragma unroll
                for (int r = 0; r < 4; ++r) { const int rt = 32 * w + 16 * m + 4 * g + r; const int cc = 16 * chn + l15;
                    const float h = E[chn][m][r] * (m == 0 ? h0 : h1) + hl[chn][m][r];
                    const float gb = bfl(*(const LAS unsigned short*)(lds + L_GB + rt * 64 + cc * 2));
                    *(LAS unsigned short*)(lds + L_YS + rt * 64 + cc * 2) = f2bf(gelu_fast(gb) * h); }
        }
        __syncthreads();
#pragma unroll
        for (int i = 0; i < 2; ++i) { const int rr = (tid >> 2) + 128 * i; const u32x4 v = *(const LAS u32x4*)(lds + L_YS + rr * 64 + (tid & 3) * 16);
            *(u32x4*)(YL + (row0 + (size_t)t * 256 + rr) * 1280 + 128 * n + 32 * q + (tid & 3) * 8) = v; }
        if (t + 1 < 16) LRU_STASH();
        __syncthreads();
    }
#undef LRU_LOAD
#undef LRU_STASH
}
}

struct Args { const float* in[25]; float* out; char* ws; int ph_lo, ph_hi, li, pad; };

#define PHASE_VARS char* ws = a.ws; \
    const float* x = a.in[0]; const float* norm_g = a.in[4]; float* mod = (float*)(ws + WS_MOD); const float* mod0 = mod; const float* mod1 = mod + 4 * MODW; \
    float* rope = (float*)(ws + WS_ROPE); float* logf = (float*)(ws + WS_LOGF); float* kbias = (float*)(ws + WS_KBIAS); float* agg = (float*)(ws + WS_AGG); \
    int* ltw = (int*)(ws + WS_LTW); float* lg = (float*)(ws + WS_LG); int* cnt = (int*)(ws + WS_CTL) + CW_CNT; float* ksum = (float*)(ws + WS_CTL) + CW_KSUM; \
    u16* HA = (u16*)(ws + WS_HA); float* Y = (float*)(ws + WS_Y); float* out = a.out; \
    (void)x; (void)norm_g; (void)mod0; (void)mod1; (void)rope; (void)logf; (void)kbias; (void)agg; (void)ltw; (void)lg; (void)cnt; (void)ksum; (void)HA; (void)Y; (void)out;

__device__ __forceinline__ void conv_drain(const float* wg, const float* wu, const float* wd, char* ws, LAS unsigned char* lds, int ng, int nd) {
    const int tid = threadIdx.x; volatile LAS int* qs_ = (volatile LAS int*)(lds + CTRL_OFF + 64);
    for (int n_ = 0; n_ < nd; ++n_) { __syncthreads(); if (tid == 0) qs_[0] = atomicAdd((int*)(ws + WS_CTL) + CW_CQD, 1); __syncthreads(); const int it_ = qs_[0]; if (it_ >= 8 * 32) break;
        { const int e_ = it_ >> 5, n0_ = (it_ & 31) * 32; cvt8d_item(wd + (size_t)e_ * DEXP * D, n0_, (unsigned char*)(ws + WS_WMDN) + (size_t)e_ * 1024 * 3584, (float*)(ws + WS_SBD) + (size_t)e_ * 1024, (LAS float*)lds, tid); } }
    for (int n_ = 0; n_ < ng; ++n_) { __syncthreads(); if (tid == 0) qs_[0] = atomicAdd((int*)(ws + WS_CTL) + CW_CQG, 1); __syncthreads(); const int it_ = qs_[0]; if (it_ >= 16 * 112) break;
        { const int j_ = it_ / 112, nb_ = it_ % 112, e_ = j_ >> 1, which_ = j_ & 1, n0_ = nb_ * 32;
          cvt8_item((which_ ? wu : wg) + (size_t)e_ * D * DEXP, DEXP, n0_, (unsigned char*)(ws + WS_WMGU) + (size_t)e_ * 7168 * 1024, (float*)(ws + WS_SB) + (size_t)e_ * 7168, n0_ + (n0_ >> 7) * 128 + which_ * 128, (LAS float*)lds, tid); } }
}
#define CONV_DRAIN(NG, ND) conv_drain(a.in[22], a.in[23], a.in[24], ws, lds, (NG), (ND))
__global__ void __launch_bounds__(NWAVES * 64, 2) mega(Args a) {
    extern __shared__ __attribute__((aligned(16))) unsigned char lds_raw[];
    LAS unsigned char* lds = (LAS unsigned char*)lds_raw;
    volatile LAS unsigned* MISC = (volatile LAS unsigned*)(lds + MISC_OFF);
    const int tid = threadIdx.x, lane = tid & 63, wave = __builtin_amdgcn_readfirstlane(tid >> 6);
    const int G = gridDim.x, bid = blockIdx.x;
    unsigned* ctl = (unsigned*)(a.ws + WS_CTL);
    for (int u = tid; u < (LDS_BYTES - CTRL_OFF) / 4; u += NWAVES * 64) ((LAS unsigned*)(lds + CTRL_OFF))[u] = 0u;
    __syncthreads();
    const int lo = a.ph_lo, hi = a.ph_hi;
    const bool multi = (hi - lo) > 1;
    XcdBarrier bar; bar.bar = ctl + CW_BAR + a.li * XCD_BAR_WORDS; bar.x = 0; bar.st = nullptr;
    if (multi) bar = xcd_barrier_post(ctl + CW_BAR + a.li * XCD_BAR_WORDS, MISC + 8);
#ifndef PHMASK
#define PHMASK 0x7ffff
#endif
#define IN(k) ((((PHMASK) >> (k)) & 1) && lo <= (k) && (k) < hi)
#define SEAM(k) do { if (IN(k) && IN((k) + 1)) xcd_barrier(bar); } while (0)
#ifndef REPEAT_MASK
#define REPEAT_MASK 0
#endif
#define NREP(k) ((((REPEAT_MASK) >> (k)) & 1) ? 2 : 1)
    const int gw = bid * NWAVES + wave, NGW = G * NWAVES;

    if (IN(0)) { PHASE_VARS
        {
            LAS float* scs = (LAS float*)lds; LAS float* part = (LAS float*)(lds + 16384);
            const float* c = a.in[1];
            for (int i = tid; i < NB * D; i += NWAVES * 64) { const float v = c[i]; scs[i] = v / (1.f + __expf(-v)); }
            __syncthreads();
            const int n = bid * 48 + (lane < 48 ? lane : 47), l = n / MODW, nn = n % MODW;
            const float* w = a.in[2] + (size_t)l * D * MODW + nn + (size_t)(wave * 128) * MODW;
            float a0 = 0.f, a1 = 0.f, a2 = 0.f, a3 = 0.f;
            for (int k0 = 0; k0 < 128; k0 += 32) { float wv[32];
#pragma unroll
                for (int k = 0; k < 32; ++k) wv[k] = __builtin_nontemporal_load(w + (size_t)(k0 + k) * MODW);
#pragma unroll
                for (int k = 0; k < 32; ++k) { const int kk = wave * 128 + k0 + k; a0 += scs[kk] * wv[k]; a1 += scs[D + kk] * wv[k]; a2 += scs[2 * D + kk] * wv[k]; a3 += scs[3 * D + kk] * wv[k]; } }
            part[(wave * 64 + lane) * 4 + 0] = a0; part[(wave * 64 + lane) * 4 + 1] = a1; part[(wave * 64 + lane) * 4 + 2] = a2; part[(wave * 64 + lane) * 4 + 3] = a3;
            __syncthreads();
            if (tid < 192) { const int col = tid >> 2, b = tid & 3; float s = 0.f;
#pragma unroll
                for (int w8 = 0; w8 < 8; ++w8) s += part[(w8 * 64 + col) * 4 + b];
                const int n2 = bid * 48 + col, l2 = n2 / MODW, nn2 = n2 % MODW;
                mod[(l2 * 4 + b) * MODW + nn2] = s + a.in[3][l2 * MODW + nn2]; }
            __syncthreads();
        }
        if (gw < 512) { const int i = gw * 64 + lane; const int pos = i >> 3, f = i & 7;
            const float inv = exp2f(-(float)f * 0.125f * 18.931568569324174f); const float ang = (float)pos * inv; float sn, cs; sincosf(ang, &sn, &cs);
            rope[2 * i] = cs; rope[2 * i + 1] = sn; }
        if (bid == 255) { for (int c = tid; c < DRNN; c += NWAVES * 64) { float* tb = (float*)(ws + WS_SP8); tb[c] = a.in[15][c]; tb[1280 + c] = a.in[17][c]; tb[2560 + c] = -8.f * log1pf(__expf(-a.in[18][c])); } }
        {
            LAS float* scr = (LAS float*)(lds + wave * 16384);
            constexpr int I_AIN = 16 * 96, I_AOUT = 16 * 32, I_FG = 16 * 88, I_FD = 44 * 32, I_LIN = 16 * 80, I_LOUT = 20 * 32, I_LG = 2 * 4, I_MG = 16 * 112, I_MD = 56 * 32;
            int cum = 0;
#define CVT_LOOP(NIT, CALL) do { for (int r = (gw + NGW - (cum % NGW)) % NGW; r < (NIT); r += NGW) { CALL; } cum += (NIT); } while (0)
            CVT_LOOP(I_AIN, cvt_job(a.in[5], NIN, D, 3072, (u16*)(ws + WS_WAIN), 0, r, scr, lane));
            CVT_LOOP(I_AOUT, cvt_job(a.in[7], D, D, D, (u16*)(ws + WS_WAOUT), 0, r, scr, lane));
            CVT_LOOP(I_FG, cvt_job(a.in[8], DFF, D, DFF, (u16*)(ws + WS_WFGU), 1, r, scr, lane));
            CVT_LOOP(I_FG, cvt_job(a.in[9], DFF, D, DFF, (u16*)(ws + WS_WFGU), 2, r, scr, lane));
            CVT_LOOP(I_FD, cvt_job(a.in[10], D, DFF, D, (u16*)(ws + WS_WFDN), 0, r, scr, lane));
            CVT_LOOP(I_LIN, cvt_job(a.in[11], 2560, D, 2560, (u16*)(ws + WS_WLIN), 0, r, scr, lane));
            CVT_LOOP(I_LOUT, cvt_job(a.in[19], D, DRNN, D, (u16*)(ws + WS_WLOUT), 0, r, scr, lane));
            CVT_LOOP(10 * I_LG, cvt_job(a.in[14] + (size_t)(r / I_LG) * 16384, 128, 128, 128, (u16*)(ws + WS_WLG) + (size_t)(r / I_LG) * 256 * 128, 0, r % I_LG, scr, lane));
            CVT_LOOP(10 * I_LG, cvt_job(a.in[16] + (size_t)(r / I_LG) * 16384, 128, 128, 128, (u16*)(ws + WS_WLG) + (size_t)(r / I_LG) * 256 * 128 + 128 * 128, 0, r % I_LG, scr, lane));
#undef CVT_LOOP
            __syncthreads();
        }
    }
    SEAM(0);
    _Pragma("unroll") for (int rep_ = 0; rep_ < NREP(1); ++rep_) { if (rep_) xcd_barrier(bar);
    if (IN(1)) { PHASE_VARS RowP p{}; p.xres = x; p.y_mode = 0; p.g_pre = norm_g + 0 * D; p.sh = mod0 + 0 * D; p.sc = mod0 + 1 * D; p.hout = HA;
        p.extra = 1; p.wex = a.in[5]; p.wex_ld = NIN; p.wex_off = 3072; p.bex = a.in[6]; p.logf = logf; row_pass(p, bid, G, (LAS float*)lds); }
    }
    SEAM(1);
    _Pragma("unroll") for (int rep_ = 0; rep_ < NREP(2); ++rep_) { if (rep_) xcd_barrier(bar);
    if (IN(2)) { PHASE_VARS
        if (bid < 32) { LAS float* tot = (LAS float*)(lds + CTRL_OFF + 1024);
            const float* src = logf + (size_t)bid * S + tid * 8; float v[8]; float s = 0.f;
#pragma unroll
            for (int i = 0; i < 8; ++i) { s += src[i]; v[i] = s; }
            tot[tid] = s; __syncthreads();
            float base = 0.f; for (int i = 0; i < tid; ++i) base += tot[i];
#pragma unroll
            for (int i = 0; i < 8; ++i) kbias[(size_t)bid * S + tid * 8 + i] = -(base + v[i]) * LOG2E;
            __syncthreads(); }
        pg8::DenseOrder So; So.init(HA, D, ws + WS_WAIN, M, 3072, D, G, bid);
        pg8::EpiQKV E{(u16*)(ws + WS_Q), (u16*)(ws + WS_K), (u16*)(ws + WS_V), rope, ksum, (unsigned*)(ws + WS_CTL) + CW_KN2};
        pg8::gemm_phase<pg8::EpiQKV, pg8::DenseOrder, false, true>(lds, D, D, So, E);
    }
    }
    SEAM(2);
    _Pragma("unroll") for (int rep_ = 0; rep_ < NREP(3); ++rep_) { if (rep_) xcd_barrier(bar);
    if (IN(3)) { PHASE_VARS
        const attn_body::AttnTensors AT{(const attn_body::bf16*)(ws + WS_Q), (const attn_body::bf16*)(ws + WS_K), (const attn_body::bf16*)(ws + WS_V), (attn_body::bf16*)(ws + WS_O)};
        attn_body::attn_phase<8>((char*)lds_raw, AT, ksum, kbias, (const unsigned*)(ws + WS_CTL) + CW_KN2, (int*)(ws + WS_CTL) + CW_AQ, (volatile LAS int*)(lds + CTRL_OFF + 64)); }
    }
    SEAM(3);
    _Pragma("unroll") for (int rep_ = 0; rep_ < NREP(4); ++rep_) { if (rep_) xcd_barrier(bar);
    if (IN(4)) { PHASE_VARS pg8::DenseOrder So; So.init(ws + WS_O, D, ws + WS_WAOUT, M, D, D, G, bid); pg8::EpiBf16 E{(u16*)Y, D};
        pg8::gemm_phase<pg8::EpiBf16, pg8::DenseOrder, false, false>(lds, D, D, So, E); }
    }
    SEAM(4);
    _Pragma("unroll") for (int rep_ = 0; rep_ < NREP(5); ++rep_) { if (rep_) xcd_barrier(bar);
    if (IN(5)) { PHASE_VARS RowP p{}; p.xres = x; p.y = Y; p.y_mode = 1; p.g_post = norm_g + 1 * D; p.gate = mod0 + 2 * D; p.xout = out;
        p.g_pre = norm_g + 2 * D; p.sh = mod0 + 3 * D; p.sc = mod0 + 4 * D; p.hout = HA; row_pass(p, bid, G, (LAS float*)lds); }
    }
    SEAM(5);
    _Pragma("unroll") for (int rep_ = 0; rep_ < NREP(6); ++rep_) { if (rep_) xcd_barrier(bar);
    if (IN(6)) { PHASE_VARS pg8::DenseOrder So; So.init(HA, D, ws + WS_WFGU, M, 2 * DFF, D, G, bid); pg8::EpiSwiglu E{(u16*)(ws + WS_HM), DFF};
        pg8::gemm_phase<pg8::EpiSwiglu, pg8::DenseOrder, false, true>(lds, D, D, So, E);
        if (bid >= 1408 - 5 * G) CONV_DRAIN(2, 0); }
    }
    SEAM(6);
    _Pragma("unroll") for (int rep_ = 0; rep_ < NREP(7); ++rep_) { if (rep_) xcd_barrier(bar);
    if (IN(7)) { PHASE_VARS pg8::DenseOrder So; So.init(ws + WS_HM, DFF, ws + WS_WFDN, M, D, DFF, G, bid); pg8::EpiBf16 E{(u16*)Y, D};
        pg8::gemm_phase<pg8::EpiBf16, pg8::DenseOrder, false, false>(lds, DFF, DFF, So, E); }
    }
    SEAM(7);
    if (IN(8)) { PHASE_VARS RowP p{}; p.xres = out; p.y = Y; p.y_mode = 1; p.g_post = norm_g + 3 * D; p.gate = mod0 + 5 * D; p.xout = out;
        p.g_pre = norm_g + 4 * D; p.sh = mod1 + 0 * D; p.sc = mod1 + 1 * D; p.hout = HA; row_pass(p, bid, G, (LAS float*)lds); }
    SEAM(8);
    _Pragma("unroll") for (int rep_ = 0; rep_ < NREP(9); ++rep_) { if (rep_) xcd_barrier(bar);
    if (IN(9)) { PHASE_VARS pg8::DenseOrder So; So.init(HA, D, ws + WS_WLIN, M, 2560, D, G, bid); pg8::EpiBf16 E{(u16*)(ws + WS_P2), 2560};
        pg8::gemm_phase<pg8::EpiBf16, pg8::DenseOrder, false, true>(lds, D, D, So, E);
        if (bid >= 640 - 2 * G) CONV_DRAIN(3, 0); }
    }
    SEAM(9);
    _Pragma("unroll") for (int rep_ = 0; rep_ < NREP(11); ++rep_) { if (rep_) xcd_barrier(bar);
    if (IN(11)) { PHASE_VARS
        if (bid < 160) lru::phase(lds, bid, a.in[12], a.in[13], (const u16*)(ws + WS_P2), (u16*)(ws + WS_YL), (const u16*)(ws + WS_WLG), (const float*)(ws + WS_SP8));
        else CONV_DRAIN(0, 3);
    }
    }
    SEAM(11);
    _Pragma("unroll") for (int rep_ = 0; rep_ < NREP(14); ++rep_) { if (rep_) xcd_barrier(bar);
    if (IN(14)) { PHASE_VARS pg8::DenseOrder So; So.init(ws + WS_YL, DRNN, ws + WS_WLOUT, M, D, DRNN, G, bid); pg8::EpiBf16 E{(u16*)Y, D};
        pg8::gemm_phase<pg8::EpiBf16, pg8::DenseOrder, false, false>(lds, DRNN, DRNN, So, E); }
    }
    SEAM(14);
    if (IN(15)) { PHASE_VARS RowP p{}; p.xres = out; p.y = Y; p.y_mode = 1; p.g_post = norm_g + 5 * D; p.gate = mod1 + 2 * D; p.xout = out;
        p.g_pre = norm_g + 6 * D; p.sh = mod1 + 3 * D; p.sc = mod1 + 4 * D; p.hout = HA;
        p.h8 = (unsigned char*)HA;
        p.extra = 2; p.wex = a.in[20]; p.wex_ld = 8; p.wex_off = 0; p.bex = a.in[21]; p.cnt = cnt; p.list_tw = ltw; p.list_g = lg; row_pass(p, bid, G, (LAS float*)lds);
        CONV_DRAIN(1 << 20, 1 << 20); }
    SEAM(15);
    _Pragma("unroll") for (int rep_ = 0; rep_ < NREP(16); ++rep_) { if (rep_) xcd_barrier(bar);
    if (IN(16)) { PHASE_VARS pg8::MoeOrder So; So.init(cnt, HA, ws + WS_WMGU, (size_t)7168 * 1024, 2 * DEXP, D / 2, G, bid, ltw, 1); pg8::EpiSwiglu8 E{(unsigned char*)(ws + WS_HMID), DEXP, (const float*)(ws + WS_SB)};
        pg8::gemm_phase<pg8::EpiSwiglu8, pg8::MoeOrder, true, true, true>(lds, D / 2, D / 2, So, E); }
    }
    SEAM(16);
    _Pragma("unroll") for (int rep_ = 0; rep_ < NREP(17); ++rep_) { if (rep_) xcd_barrier(bar);
    if (IN(17)) { PHASE_VARS pg8::MoeOrder So; So.init(cnt, ws + WS_HMID, ws + WS_WMDN, (size_t)1024 * 3584, D, DEXP / 2, G, bid, ltw, 0); pg8::EpiMoeDown E{(u16*)(ws + WS_YBUF), ltw, lg, (const float*)(ws + WS_SBD)};
        pg8::gemm_phase<pg8::EpiMoeDown, pg8::MoeOrder, false, true, true>(lds, DEXP / 2, DEXP / 2, So, E); }
    }
    SEAM(17);
    if (IN(18)) { PHASE_VARS RowP p{}; p.xres = out; p.y = (const float*)(ws + WS_YBUF); p.y_mode = 2; p.g_post = norm_g + 7 * D; p.gate = mod1 + 5 * D; p.xout = out; row_pass(p, bid, G, (LAS float*)lds); }
#undef IN
#undef SEAM
}

extern "C" void kernel_launch(void* const* d_in, const int* in_sizes, int n_in, void* d_out, int out_size, void* d_ws, size_t ws_size, hipStream_t stream) {
    static int grid = 0;
    if (grid == 0) {
        if (n_in != 25 || out_size != M * D || ws_size < WS_END) { fprintf(stderr, "kernel_launch: unexpected sizes (n_in %d out %d ws %zu)\n", n_in, out_size, ws_size); grid = -1; return; }
        int dev = 0, cus = 0;
        if (hipGetDevice(&dev) != hipSuccess || hipDeviceGetAttribute(&cus, hipDeviceAttributeMultiprocessorCount, dev) != hipSuccess) { grid = -1; return; }
        if (hipFuncSetAttribute((const void*)mega, hipFuncAttributeMaxDynamicSharedMemorySize, LDS_BYTES) != hipSuccess) { fprintf(stderr, "kernel_launch: hipFuncSetAttribute failed\n"); grid = -1; return; }
        (void)hipGetLastError();
        grid = cus;
    }
    if (grid < 0) return;
    char* ws = (char*)d_ws;
    (void)hipMemsetAsync(ws + WS_CTL, 0, 1 * MiB, stream);
    Args a{};
    for (int i = 0; i < 25; ++i) a.in[i] = (const float*)d_in[i];
    a.out = (float*)d_out; a.ws = ws;
#if defined(MK_PER_PHASE)
    for (int ph = 0; ph <= 18; ++ph) { a.ph_lo = ph; a.ph_hi = ph + 1; hipLaunchKernelGGL(mega, dim3(grid), dim3(NWAVES * 64), LDS_BYTES, stream, a); }
#else
    a.ph_lo = 0; a.ph_hi = 19;
    hipLaunchKernelGGL(mega, dim3(grid), dim3(NWAVES * 64), LDS_BYTES, stream, a);
#if defined(PROBE_PH)
    a.ph_lo = PROBE_PH; a.ph_hi = PROBE_PH + PROBE_N; a.li = 1;
    hipLaunchKernelGGL(mega, dim3(grid), dim3(NWAVES * 64), LDS_BYTES, stream, a);
#endif
#endif
}
```

```cpp
#include <hip/hip_runtime.h>
#include <cstdint>
#include <cstdio>
#include <cmath>

typedef unsigned short u16;
typedef float f32x4 __attribute__((ext_vector_type(4)));
typedef unsigned u32x4 __attribute__((ext_vector_type(4)));
typedef unsigned u32x2 __attribute__((ext_vector_type(2)));

constexpr int D = 1024, NB = 4, S = 4096, M = NB * S;
constexpr int NIN = 3080;
constexpr int DFF = 2816, DRNN = 1280, NE = 8, DEXP = 3584;
constexpr int MODW = 6 * D;
constexpr float EPS = 1e-6f;
constexpr float LOG2E = 1.4426950408889634f;
constexpr float C2 = 0.125f * LOG2E;

__device__ __forceinline__ u16 f2bf(float f) { unsigned u = __float_as_uint(f); return (u16)((u + 0x7fffu + ((u >> 16) & 1u)) >> 16); }
__device__ __forceinline__ float bf2f(u16 h) { return __uint_as_float(((unsigned)h) << 16); }
__device__ __forceinline__ unsigned pk2(float lo, float hi) { return (unsigned)f2bf(lo) | ((unsigned)f2bf(hi) << 16); }
__device__ __forceinline__ unsigned pk4_fp8(float a, float b, float c, float d) {
    a = __builtin_amdgcn_fmed3f(a, -448.f, 448.f); b = __builtin_amdgcn_fmed3f(b, -448.f, 448.f); c = __builtin_amdgcn_fmed3f(c, -448.f, 448.f); d = __builtin_amdgcn_fmed3f(d, -448.f, 448.f);
    unsigned w = 0u; w = __builtin_amdgcn_cvt_pk_fp8_f32(a, b, w, false); w = __builtin_amdgcn_cvt_pk_fp8_f32(c, d, w, true); return w; }
__device__ __forceinline__ float wave_sum(float v) {
#pragma unroll
    for (int o = 1; o < 64; o <<= 1) v += __shfl_xor(v, o);
    return v;
}
__device__ __forceinline__ float sigmoidf_(float x) { return 1.f / (1.f + __expf(-x)); }

struct RowP {
    const float* xres; const float* y; const float* g_post; const float* gate; float* xout;
    const float* g_pre; const float* sc; const float* sh; u16* hout;
    const float* wex; const float* bex;
    float* logf; int* cnt; int* list_tw; float* list_g; unsigned char* h8;
    int y_mode; int extra; int wex_ld; int wex_off;
};
__device__ __forceinline__ void row_pass(const RowP& p, int blk, int nblk, __attribute__((address_space(3))) float* wl) {
    const int lane = threadIdx.x & 63, wave = threadIdx.x >> 6, nw = blockDim.x >> 6;
    if (p.extra) {
        for (int idx = threadIdx.x; idx < 8 * D; idx += blockDim.x) { const int k = idx >> 3, o = idx & 7; wl[o * D + k] = p.wex[(size_t)k * p.wex_ld + p.wex_off + o]; }
        __syncthreads();
    }
    for (int m = blk * nw + wave; m < M; m += nblk * nw) {
        const int b = m / S, t = m % S;
        f32x4 xv[4];
#pragma unroll
        for (int j = 0; j < 4; ++j) xv[j] = __builtin_nontemporal_load((const f32x4*)(p.xres + (size_t)m * D + 256 * j + 4 * lane));
        if (p.y_mode) {
            f32x4 yv[4]; float ss = 0.f;
#pragma unroll
            for (int j = 0; j < 4; ++j) {
                if (p.y_mode == 1) { const u32x2 p0 = __builtin_nontemporal_load((const u32x2*)((const u16*)p.y + (size_t)m * D + 256 * j + 4 * lane));
                    yv[j] = (f32x4){__uint_as_float(p0.x << 16), __uint_as_float(p0.x & 0xffff0000u), __uint_as_float(p0.y << 16), __uint_as_float(p0.y & 0xffff0000u)}; }
                else { const u16* yb = (const u16*)p.y + (size_t)m * 2 * D + 256 * j + 4 * lane; const u32x2 p0 = __builtin_nontemporal_load((const u32x2*)yb), p1 = __builtin_nontemporal_load((const u32x2*)(yb + D));
                    yv[j] = (f32x4){__uint_as_float(p0.x << 16) + __uint_as_float(p1.x << 16), __uint_as_float(p0.x & 0xffff0000u) + __uint_as_float(p1.x & 0xffff0000u),
                                    __uint_as_float(p0.y << 16) + __uint_as_float(p1.y << 16), __uint_as_float(p0.y & 0xffff0000u) + __uint_as_float(p1.y & 0xffff0000u)}; }
                ss += yv[j].x * yv[j].x + yv[j].y * yv[j].y + yv[j].z * yv[j].z + yv[j].w * yv[j].w;
            }
            const float rstd = rsqrtf(wave_sum(ss) * (1.f / D) + EPS);
#pragma unroll
            for (int j = 0; j < 4; ++j) {
                const f32x4 g = *(const f32x4*)(p.g_post + 256 * j + 4 * lane), ga = *(const f32x4*)(p.gate + (size_t)b * MODW + 256 * j + 4 * lane);
                xv[j] = xv[j] + ga * (yv[j] * rstd * g);
            }
        }
        if (p.xout) {
#pragma unroll
            for (int j = 0; j < 4; ++j) __builtin_nontemporal_store(xv[j], (f32x4*)(p.xout + (size_t)m * D + 256 * j + 4 * lane));
        }
        if (p.g_pre) {
            float ss = 0.f;
#pragma unroll
            for (int j = 0; j < 4; ++j) ss += xv[j].x * xv[j].x + xv[j].y * xv[j].y + xv[j].z * xv[j].z + xv[j].w * xv[j].w;
            const float rstd = rsqrtf(wave_sum(ss) * (1.f / D) + EPS);
            f32x4 hv[4];
#pragma unroll
            for (int j = 0; j < 4; ++j) {
                const f32x4 g = *(const f32x4*)(p.g_pre + 256 * j + 4 * lane), s1 = *(const f32x4*)(p.sc + (size_t)b * MODW + 256 * j + 4 * lane), s0 = *(const f32x4*)(p.sh + (size_t)b * MODW + 256 * j + 4 * lane);
                hv[j] = xv[j] * rstd * g * (s1 + 1.0f) + s0;
                if (p.h8) __builtin_nontemporal_store(pk4_fp8(hv[j].x, hv[j].y, hv[j].z, hv[j].w), (unsigned*)(p.h8 + (size_t)m * D + 256 * j + 4 * lane));
                else { u32x2 w; w.x = pk2(hv[j].x, hv[j].y); w.y = pk2(hv[j].z, hv[j].w); __builtin_nontemporal_store(w, (u32x2*)(p.hout + (size_t)m * D + 256 * j + 4 * lane)); }
            }
            if (p.extra) {
                float dt[8];
#pragma unroll
                for (int o = 0; o < 8; ++o) dt[o] = 0.f;
#pragma unroll
                for (int j = 0; j < 4; ++j)
#pragma unroll
                    for (int o = 0; o < 8; ++o) { const f32x4 w4 = *(const __attribute__((address_space(3))) f32x4*)(wl + o * D + 256 * j + 4 * lane);
                        dt[o] += hv[j][0] * w4[0] + hv[j][1] * w4[1] + hv[j][2] * w4[2] + hv[j][3] * w4[3]; }
#pragma unroll
                for (int o = 0; o < 8; ++o) dt[o] = wave_sum(dt[o]) + p.bex[o];
                if (p.extra == 1) {
                    if (lane < 8) {
                        float xl = dt[0];
#pragma unroll
                        for (int o = 1; o < 8; ++o) xl = (lane == o) ? dt[o] : xl;
                        const float ls = xl > 0.f ? -log1pf(__expf(-xl)) : xl - log1pf(__expf(xl));
                        p.logf[((size_t)b * 8 + lane) * S + t] = ls;
                    }
                } else if (lane == 0) {
                    float v1 = -INFINITY, v2 = -INFINITY; int i1 = 0, i2 = 0;
#pragma unroll
                    for (int o = 0; o < 8; ++o) { const float g = dt[o]; if (g > v1) { v2 = v1; i2 = i1; v1 = g; i1 = o; } else if (g > v2) { v2 = g; i2 = o; } }
                    const float g1 = 1.f / (1.f + __expf(v2 - v1)), g2 = 1.f - g1;
                    int pos = atomicAdd(p.cnt + i1, 1); p.list_tw[i1 * M + pos] = m * 2; p.list_g[i1 * M + pos] = g1;
                    pos = atomicAdd(p.cnt + i2, 1); p.list_tw[i2 * M + pos] = m * 2 + 1; p.list_g[i2 * M + pos] = g2;
                }
            }
        }
    }
}
__device__ __forceinline__ float gelu_tanh(float x) { return 0.5f * x * (1.f + tanhf(0.7978845608028654f * (x + 0.044715f * x * x * x))); }
namespace pg8 {
#define PG8_LAS __attribute__((address_space(3)))
typedef unsigned short bf16_t;
typedef short bf16x8 __attribute__((ext_vector_type(8)));
typedef int i32x4_t __attribute__((ext_vector_type(4)));
constexpr int BM = 256, BK = 64, HALF = 128, HTB = HALF * BK * 2  , STAGE_BYTES = 8 * HTB, NXCD = 8, WGM = 8;

__host__ __device__ __forceinline__ int lds_byte(int r, int c) { const int st = (r >> 4) * 2 + (c >> 5), rr = r & 15, cc = c & 31, ob = rr * 64 + cc * 2; return st * 1024 + (ob ^ (((ob >> 9) & 1) << 5)); }
__host__ __device__ __forceinline__ void stage_rc(int b, int& R, int& C) { const int st = b / 1024, sb = b % 1024, swz = sb ^ (((sb >> 9) & 1) << 5); R = (st >> 1) * 16 + swz / 64; C = (st & 1) * 32 + (swz % 64) / 2; }
__host__ __device__ __forceinline__ int perm32(int rho) { const int n = rho >> 4, i = rho & 15; return 8 * (i >> 2) + 4 * n + (i & 3); }

struct Unit { int pm, pn; const char* A; const char* B; int e, rt; };

struct DenseOrder {
    int nM, nN, nwg, G, c; const char* A; const char* Bt; unsigned tstepA, tstepB, cstepA;
    __device__ void init(const void* A_, int lda, const void* Bt_, int M, int N, int K, int G_, int c_) { nM = M / BM; nN = N / BM; nwg = nM * nN; G = G_; c = c_; A = (const char*)A_; Bt = (const char*)Bt_; tstepA = (unsigned)BM * lda * 2; tstepB = (unsigned)BM * K * 2; cstepA = 0; }
    __device__ bool next(int i, Unit& u) const {
        const long L = (long)i * G + c; if (L >= nwg) return false;
        int wgid = (int)L; { const int q = nwg / NXCD, r = nwg % NXCD, xcd = wgid % NXCD, off = wgid / NXCD; wgid = (xcd < r ? xcd * (q + 1) : r * (q + 1) + (xcd - r) * q) + off; }
        const int nig = WGM * nN, gid = wgid / nig, fm = gid * WGM, gsz = (nM - fm) < WGM ? (nM - fm) : WGM;
        u.pm = fm + ((wgid % nig) % gsz); u.pn = (wgid % nig) / gsz; u.A = A + (size_t)u.pm * tstepA + (size_t)u.pn * cstepA; u.B = Bt + (size_t)u.pn * tstepB; u.e = 0; u.rt = 0; return true;
    }
    __device__ __forceinline__ unsigned grow(const Unit&, int) const { return 0u; }
};
struct MoeOrder {
    int tp[9]; int cnt[8]; int nN, G, c, total; const char* A; const char* Bt; size_t estrideB, tstepB, tstepA; const int* ltw; int K2; int gather;
    __device__ void init(const int* cntp, const void* A_, const void* Bt_, size_t estrideB_, int N, int K, int G_, int c_, const int* ltw_, int gather_) {
        int s = 0;
        for (int e = 0; e < 8; ++e) { cnt[e] = __builtin_amdgcn_readfirstlane(cntp[e]); tp[e] = s; s += (cnt[e] + 255) >> 8; }
        tp[8] = s; nN = N / BM; total = s * nN; G = G_; c = c_; A = (const char*)A_; Bt = (const char*)Bt_; estrideB = estrideB_; tstepB = (size_t)BM * K * 2; tstepA = (size_t)BM * K * 2; ltw = ltw_; K2 = K * 2; gather = gather_;
    }
    __device__ bool next(int i, Unit& u) const {
        const long L = (long)i * G + c; if (L >= total) return false;
        const int tg = (int)(L / nN); u.pn = (int)(L % nN); u.pm = tg;
        int e = 0, tpe = 0;
#pragma unroll
        for (int j = 1; j < 8; ++j) if (tg >= tp[j]) { e = j; tpe = tp[j]; }
        u.e = e; u.rt = tg - tpe;
        u.A = gather ? A : A + (size_t)tg * tstepA; u.B = Bt + (size_t)e * estrideB + (size_t)u.pn * tstepB; return true;
    }
    __device__ __forceinline__ int nvalid(const Unit& u) const { int n = 0;
#pragma unroll
        for (int j = 0; j < 8; ++j) n = (u.e == j) ? cnt[j] : n;
        n -= u.rt * 256; return n > 256 ? 256 : n; }
    __device__ __forceinline__ unsigned grow(const Unit& u, int rr) const {
        const int nv = nvalid(u); int tok = 0;
        if (rr < nv) tok = ltw[(size_t)u.e * 16384 + u.rt * 256 + rr] >> 1;
        return (unsigned)tok * (unsigned)K2;
    }
};

__device__ __forceinline__ unsigned cvt_pk_bf16(float lo, float hi) { unsigned r; asm volatile("v_cvt_pk_bf16_f32 %0, %1, %2" : "=v"(r) : "v"(lo), "v"(hi)); return r; }

template <class Epi, class Sched, bool GATHER, bool ALIGN_EPI, bool FP8 = false>
__device__ __forceinline__ void gemm_phase(PG8_LAS unsigned char* lds, const int K, const int lda, const Sched& S, const Epi& E) {
    const int tid = threadIdx.x, wid = __builtin_amdgcn_readfirstlane(tid >> 6), lane = tid & 63, wr = wid >> 2, wc = wid & 3, fr = lane & 15, fq = lane >> 4;
    const int nt = K / BK;
    unsigned voffA[2], voffB[2]; int RA[2], CA[2];
#pragma unroll
    for (int i = 0; i < 2; ++i) { int R, C; stage_rc(tid * 16 + i * 8192, R, C); const int Rb = Epi::PERM ? ((R & ~31) + perm32(R & 31)) : R;
        RA[i] = R; CA[i] = C; voffA[i] = (unsigned)(R * lda + C) * 2u; voffB[i] = (unsigned)(Rb * K + C) * 2u; }
    const size_t kstep = (size_t)(BK * 2);
    const size_t hstepB = (size_t)HALF * K * 2;
    const size_t hstepA = GATHER ? 0 : (size_t)HALF * lda * 2;
    const unsigned ldsw = (unsigned)wid * 1024u;
    const unsigned ldsa = (unsigned)__builtin_amdgcn_readfirstlane((int)((unsigned)(size_t)lds + ldsw));
    const int aoff = lds_byte(wr * 64 + fr, fq * 8), boff = lds_byte(wc * 32 + fr, fq * 8);
#define PG8_SA(b, h) (((b) * 2 + (h)) * HTB)
#define PG8_SB(b, h) ((4 + (b) * 2 + (h)) * HTB)
#define PG8_STAGE(bufoff, gbase, voff) do { _Pragma("unroll") for (int _i = 0; _i < 2; ++_i) { unsigned _keep; \
        asm volatile("s_mov_b32 %0, m0\n\ts_mov_b32 m0, %3\n\ts_nop 0\n\tglobal_load_lds_dwordx4 %1, %2\n\ts_mov_b32 m0, %0" : "=&s"(_keep) : "v"((voff)[_i]), "s"((const char*)(gbase)), "s"(ldsa + (unsigned)(bufoff) + (unsigned)(_i * 8192)) : "memory"); } } while (0)
#define PG8_LDA(dst, b, h) do { _Pragma("unroll") for (int m = 0; m < 4; ++m) _Pragma("unroll") for (int k = 0; k < 2; ++k) dst[m][k] = *(const PG8_LAS bf16x8*)(lds + PG8_SA(b, h) + aoff + m * 2048 + k * 1024); } while (0)
#define PG8_LDB(dst, b, h) do { _Pragma("unroll") for (int n = 0; n < 2; ++n) _Pragma("unroll") for (int k = 0; k < 2; ++k) dst[n][k] = *(const PG8_LAS bf16x8*)(lds + PG8_SB(b, h) + boff + n * 2048 + k * 1024); } while (0)
#define PG8_CAT(X) __builtin_shufflevector(__builtin_bit_cast(i32x4_t, (X)[0]), __builtin_bit_cast(i32x4_t, (X)[1]), 0, 1, 2, 3, 4, 5, 6, 7)
#define PG8_MMA(ai, bj, At, Bt) do { __builtin_amdgcn_s_setprio(1); _Pragma("unroll") for (int m = 0; m < 4; ++m) _Pragma("unroll") for (int n = 0; n < 2; ++n) { \
        if constexpr (FP8) asm volatile("v_mfma_scale_f32_16x16x128_f8f6f4 %0, %1, %2, %0, %3, %3 op_sel_hi:[0,0,0]" : "+v"(acc[ai][bj][m][n]) : "v"(PG8_CAT(Bt[n])), "v"(PG8_CAT(At[m])), "v"(0x7f7f7f7f));   \
        else { _Pragma("unroll") for (int k = 0; k < 2; ++k) acc[ai][bj][m][n] = __builtin_amdgcn_mfma_f32_16x16x32_bf16(Bt[n][k], At[m][k], acc[ai][bj][m][n], 0, 0, 0); } } \
        __builtin_amdgcn_s_setprio(0); } while (0)
#define PG8_WAIT_V(n) asm volatile("s_waitcnt vmcnt(" #n ")" ::: "memory")
#define PG8_WAIT_L(n) asm volatile("s_waitcnt lgkmcnt(" #n ")" ::: "memory")
#define PG8_BAR __builtin_amdgcn_s_barrier()
#define PG8_SCHED __builtin_amdgcn_sched_barrier(0)
    Unit cur, nxt; int ui = 0;
    if (!S.next(0, cur)) return;
    unsigned gc[2][2], gn[2][2];
#pragma unroll
    for (int h = 0; h < 2; ++h)
#pragma unroll
        for (int i = 0; i < 2; ++i) { gc[h][i] = GATHER ? S.grow(cur, h * HALF + RA[i]) + (unsigned)CA[i] * 2u : voffA[i]; gn[h][i] = gc[h][i]; }
    f32x4 acc[2][2][4][2];
#pragma unroll
    for (int a = 0; a < 2; ++a)
#pragma unroll
        for (int b = 0; b < 2; ++b)
#pragma unroll
            for (int m = 0; m < 4; ++m)
#pragma unroll
                for (int n = 0; n < 2; ++n) acc[a][b][m][n] = (f32x4){0.f, 0.f, 0.f, 0.f};
    bf16x8 At[4][2], B0[2][2], B1[2][2];
    const char* cA = cur.A; const char* cB = cur.B;
    PG8_STAGE(PG8_SB(0, 0), cB, voffB); PG8_STAGE(PG8_SB(0, 1), cB + hstepB, voffB); PG8_STAGE(PG8_SA(0, 0), cA, gc[0]); PG8_STAGE(PG8_SA(0, 1), cA + hstepA, gc[1]);
    if (wr == 1) PG8_BAR;
    PG8_WAIT_V(2); PG8_BAR;
    PG8_STAGE(PG8_SB(1, 0), cB + kstep, voffB); PG8_STAGE(PG8_SA(1, 0), cA + kstep, gc[0]); PG8_STAGE(PG8_SB(1, 1), cB + hstepB + kstep, voffB);
    PG8_WAIT_V(6); PG8_BAR;
    for (;;) {
        const bool has_next = S.next(ui + 1, nxt);
        const char* nA = has_next ? nxt.A : cA; const char* nB = has_next ? nxt.B : cB;
        if (GATHER) {
#pragma unroll
            for (int h = 0; h < 2; ++h)
#pragma unroll
                for (int i = 0; i < 2; ++i) gn[h][i] = has_next ? S.grow(nxt, h * HALF + RA[i]) + (unsigned)CA[i] * 2u : gc[h][i];
        }
        for (int t = 0; t < nt; t += 2) {
            const bool last = (t == nt - 2);
            const char* a1 = cA + (size_t)(t + 1) * kstep;
            const char* a2 = last ? nA : cA + (size_t)(t + 2) * kstep; const char* b2 = last ? nB : cB + (size_t)(t + 2) * kstep;
            const char* a3 = a2 + kstep; const char* b3 = b2 + kstep;
            unsigned g2[2][2];
#pragma unroll
            for (int h = 0; h < 2; ++h)
#pragma unroll
                for (int i = 0; i < 2; ++i) g2[h][i] = (GATHER && last) ? gn[h][i] : gc[h][i];
            PG8_LDB(B0, 0, 0); PG8_LDB(B1, 0, 1); PG8_SCHED; PG8_LDA(At, 0, 0); PG8_STAGE(PG8_SA(1, 1), a1 + hstepA, gc[1]);
            PG8_WAIT_V(8); PG8_WAIT_L(0); PG8_BAR; PG8_MMA(0, 0, At, B0); PG8_MMA(0, 1, At, B1); PG8_BAR; PG8_SCHED;
            PG8_LDA(At, 0, 1); PG8_STAGE(PG8_SB(0, 0), b2, voffB); PG8_STAGE(PG8_SB(0, 1), b2 + hstepB, voffB); PG8_STAGE(PG8_SA(0, 0), a2, g2[0]);
            PG8_WAIT_V(8); PG8_WAIT_L(0); PG8_BAR; PG8_MMA(1, 0, At, B0); PG8_MMA(1, 1, At, B1); PG8_BAR; PG8_SCHED;
            PG8_LDB(B0, 1, 0); PG8_LDB(B1, 1, 1); PG8_SCHED; PG8_LDA(At, 1, 0); PG8_STAGE(PG8_SA(0, 1), a2 + hstepA, g2[1]);
            PG8_WAIT_V(8); PG8_WAIT_L(0); PG8_BAR; PG8_MMA(0, 0, At, B0); PG8_MMA(0, 1, At, B1); PG8_BAR; PG8_SCHED;
            PG8_LDA(At, 1, 1); PG8_STAGE(PG8_SB(1, 0), b3, voffB); PG8_STAGE(PG8_SB(1, 1), b3 + hstepB, voffB); PG8_STAGE(PG8_SA(1, 0), a3, g2[0]);
            PG8_WAIT_V(8); PG8_WAIT_L(0); PG8_BAR; PG8_MMA(1, 0, At, B0); PG8_MMA(1, 1, At, B1); PG8_BAR; PG8_SCHED;
        }
        if constexpr (ALIGN_EPI) { if (wr == 0) PG8_BAR; }
        if constexpr (FP8) asm volatile("s_nop 15\n\ts_nop 7" ::: "memory");
        E(acc, cur, S, wr, wc, fr, fq);
        if (!has_next) break;
#pragma unroll
        for (int a = 0; a < 2; ++a)
#pragma unroll
            for (int b = 0; b < 2; ++b)
#pragma unroll
                for (int m = 0; m < 4; ++m)
#pragma unroll
                    for (int n = 0; n < 2; ++n) acc[a][b][m][n] = (f32x4){0.f, 0.f, 0.f, 0.f};
        cur = nxt; cA = nA; cB = nB; ++ui;
#pragma unroll
        for (int h = 0; h < 2; ++h)
#pragma unroll
            for (int i = 0; i < 2; ++i) gc[h][i] = gn[h][i];
        if constexpr (ALIGN_EPI) { if (wr == 1) PG8_BAR; }
    }
    PG8_WAIT_V(0);
    if constexpr (!ALIGN_EPI) { if (wr == 0) PG8_BAR; }
    PG8_BAR;
#undef PG8_SA
#undef PG8_SB
#undef PG8_STAGE
#undef PG8_LDA
#undef PG8_LDB
#undef PG8_MMA
#undef PG8_CAT
#undef PG8_WAIT_V
#undef PG8_WAIT_L
#undef PG8_BAR
#undef PG8_SCHED
}
}
namespace pg8 {
struct EpiF32 {
    static constexpr bool PERM = false;
    float* C; int ldc;
    template <class Sched> __device__ __forceinline__ void operator()(const f32x4 (&acc)[2][2][4][2], const Unit& u, const Sched&, int wr, int wc, int fr, int fq) const {
        const int row0 = u.pm * BM + wr * 64 + fr, col0 = u.pn * BM + wc * 32 + 4 * fq;
#pragma unroll
        for (int ai = 0; ai < 2; ++ai)
#pragma unroll
            for (int m = 0; m < 4; ++m) { float* rowp = C + (size_t)(row0 + ai * HALF + m * 16) * ldc + col0;
#pragma unroll
                for (int bj = 0; bj < 2; ++bj)
#pragma unroll
                    for (int n = 0; n < 2; ++n) *(f32x4*)(rowp + bj * HALF + n * 16) = acc[ai][bj][m][n]; }
    }
};
struct EpiBf16 {
    static constexpr bool PERM = true;
    u16* O; int ldc;
    template <class Sched> __device__ __forceinline__ void operator()(const f32x4 (&acc)[2][2][4][2], const Unit& u, const Sched&, int wr, int wc, int fr, int fq) const {
        const int row0 = u.pm * BM + wr * 64 + fr, col0 = u.pn * BM + wc * 32 + 8 * fq;
#pragma unroll
        for (int ai = 0; ai < 2; ++ai)
#pragma unroll
            for (int m = 0; m < 4; ++m) { u16* rowp = O + (size_t)(row0 + ai * HALF + m * 16) * ldc + col0;
#pragma unroll
                for (int bj = 0; bj < 2; ++bj) { const f32x4 v0 = acc[ai][bj][m][0], v1 = acc[ai][bj][m][1];
                    u32x4 w; w.x = cvt_pk_bf16(v0[0], v0[1]); w.y = cvt_pk_bf16(v0[2], v0[3]); w.z = cvt_pk_bf16(v1[0], v1[1]); w.w = cvt_pk_bf16(v1[2], v1[3]);
                    *(u32x4*)(rowp + bj * HALF) = w; } }
    }
};
__device__ __forceinline__ float silu_f(float v) { return v * __builtin_amdgcn_rcpf(1.f + __builtin_amdgcn_exp2f(-1.4426950408889634f * v)); }
struct EpiSwiglu {
    static constexpr bool PERM = true;
    u16* O; int ldc;
    template <class Sched> __device__ __forceinline__ void operator()(const f32x4 (&acc)[2][2][4][2], const Unit& u, const Sched&, int wr, int wc, int fr, int fq) const {
        const int row0 = u.pm * BM + wr * 64 + fr, col0 = u.pn * HALF + wc * 32 + 8 * fq;
#pragma unroll
        for (int ai = 0; ai < 2; ++ai)
#pragma unroll
            for (int m = 0; m < 4; ++m) { u16* rowp = O + (size_t)(row0 + ai * HALF + m * 16) * ldc + col0;
                f32x4 v0, v1;
#pragma unroll
                for (int i = 0; i < 4; ++i) { v0[i] = silu_f(acc[ai][0][m][0][i]) * acc[ai][1][m][0][i]; v1[i] = silu_f(acc[ai][0][m][1][i]) * acc[ai][1][m][1][i]; }
                u32x4 w; w.x = cvt_pk_bf16(v0[0], v0[1]); w.y = cvt_pk_bf16(v0[2], v0[3]); w.z = cvt_pk_bf16(v1[0], v1[1]); w.w = cvt_pk_bf16(v1[2], v1[3]);
                *(u32x4*)rowp = w; }
    }
};
struct EpiSwiglu8 {
    static constexpr bool PERM = true;
    unsigned char* O; int ldc; const float* isc;
    template <class Sched> __device__ __forceinline__ void operator()(const f32x4 (&acc)[2][2][4][2], const Unit& u, const Sched&, int wr, int wc, int fr, int fq) const {
        const int row0 = u.pm * BM + wr * 64 + fr, col0 = u.pn * HALF + wc * 32 + 8 * fq;
        const float* sp = isc + (size_t)u.e * 7168 + u.pn * BM + wc * 32 + 8 * fq;
        const f32x4 sg0 = *(const f32x4*)sp, sg1 = *(const f32x4*)(sp + 4), su0 = *(const f32x4*)(sp + HALF) * 2.f, su1 = *(const f32x4*)(sp + HALF + 4) * 2.f;
        const f32x4 se0 = sg0 * -1.4426950408889634f, se1 = sg1 * -1.4426950408889634f;
#pragma unroll
        for (int ai = 0; ai < 2; ++ai)
#pragma unroll
            for (int m = 0; m < 4; ++m) { unsigned char* rowp = O + (size_t)(row0 + ai * HALF + m * 16) * ldc + col0;
                f32x4 v0, v1;
#pragma unroll
                for (int i = 0; i < 4; ++i) { const float g0 = acc[ai][0][m][0][i], g1 = acc[ai][0][m][1][i];
                    v0[i] = (g0 * sg0[i]) * __builtin_amdgcn_rcpf(1.f + __builtin_amdgcn_exp2f(g0 * se0[i])) * (acc[ai][1][m][0][i] * su0[i]);
                    v1[i] = (g1 * sg1[i]) * __builtin_amdgcn_rcpf(1.f + __builtin_amdgcn_exp2f(g1 * se1[i])) * (acc[ai][1][m][1][i] * su1[i]); }
                u32x2 w; w.x = pk4_fp8(v0[0], v0[1], v0[2], v0[3]); w.y = pk4_fp8(v1[0], v1[1], v1[2], v1[3]);
                *(u32x2*)rowp = w; }
    }
};
struct EpiQKV {
    static constexpr bool PERM = true;
    u16* Q; u16* K; u16* V; const float* rope; float* ksum; unsigned* kn2;
    template <class Sched> __device__ __forceinline__ void operator()(f32x4 (&acc)[2][2][4][2], const Unit& u, const Sched&, int wr, int wc, int fr, int fq) const {
        const int part = u.pn >> 2, pq = u.pn & 3;
        u16* base = Q + (size_t)part * ((size_t)16384 * 1024);
        const int row0 = u.pm * BM + wr * 64 + fr;
        const bool ropew = (part < 2) && (pq < 2) && ((wc & 1) == 0);
        if (ropew) {
            const float sgn = fq == 0 ? -1.f : 1.f;
#pragma unroll
            for (int ai = 0; ai < 2; ++ai)
#pragma unroll
                for (int m = 0; m < 4; ++m) {
                    const int pos = (row0 + ai * HALF + m * 16) & 4095;
                    const f32x4 t0 = *(const f32x4*)(rope + pos * 16), t1 = *(const f32x4*)(rope + pos * 16 + 4), t2 = *(const f32x4*)(rope + pos * 16 + 8), t3 = *(const f32x4*)(rope + pos * 16 + 12);
                    const float cs[8] = {t0[0], t0[2], t1[0], t1[2], t2[0], t2[2], t3[0], t3[2]}, sn[8] = {t0[1], t0[3], t1[1], t1[3], t2[1], t2[3], t3[1], t3[3]};
#pragma unroll
                    for (int bj = 0; bj < 2; ++bj)
#pragma unroll
                        for (int n = 0; n < 2; ++n)
#pragma unroll
                            for (int i = 0; i < 4; ++i) {
                                const float mine = acc[ai][bj][m][n][i]; const float oth = __shfl_xor(mine, 16);
                                const float rot = mine * cs[4 * n + i] + sgn * oth * sn[4 * n + i];
                                acc[ai][bj][m][n][i] = fq < 2 ? rot : mine;
                            }
                }
        }
        if (part == 1 && pq < 2) {
            const int b = u.pm >> 4, blk = u.pm & 15;
#pragma unroll
            for (int bj = 0; bj < 2; ++bj)
#pragma unroll
                for (int n = 0; n < 2; ++n)
#pragma unroll
                    for (int i = 0; i < 4; ++i) {
                        float s = 0.f;
#pragma unroll
                        for (int ai = 0; ai < 2; ++ai)
#pragma unroll
                            for (int m = 0; m < 4; ++m) s += acc[ai][bj][m][n][i];
                        s += __shfl_xor(s, 1); s += __shfl_xor(s, 2); s += __shfl_xor(s, 4); s += __shfl_xor(s, 8);
                        if (fr == 0) { const int cc = pq * 256 + bj * HALF + wc * 32 + 8 * fq + 4 * n + i;
                            atomicAdd(ksum + ((size_t)(b * 8 + (cc >> 6)) * 16 + blk) * 64 + (cc & 63), s); }
                    }
        }
        if (part == 1 && pq >= 2) {
            const int b = u.pm >> 4;
#pragma unroll
            for (int bj = 0; bj < 2; ++bj) { float mx = 0.f;
#pragma unroll
                for (int ai = 0; ai < 2; ++ai)
#pragma unroll
                    for (int m = 0; m < 4; ++m) { const f32x4 v0 = acc[ai][bj][m][0], v1 = acc[ai][bj][m][1];
                        mx = __builtin_fmaxf(mx, (v0[0] * v0[0] + v0[1] * v0[1]) + (v0[2] * v0[2] + v0[3] * v0[3]) + (v1[0] * v1[0] + v1[1] * v1[1]) + (v1[2] * v1[2] + v1[3] * v1[3])); }
                mx = __builtin_fmaxf(mx, __shfl_xor(mx, 1)); mx = __builtin_fmaxf(mx, __shfl_xor(mx, 2)); mx = __builtin_fmaxf(mx, __shfl_xor(mx, 4)); mx = __builtin_fmaxf(mx, __shfl_xor(mx, 8));
                if (fr == 0) { const int hf = (pq - 2) * 4 + bj * 2 + (wc >> 1); atomicMax(kn2 + (b * 8 + hf) * 8 + (wc & 1) * 4 + fq, __float_as_uint(mx)); } }
        }
        const float sc = part == 0 ? C2 : 1.f;
        const int col0 = pq * BM + wc * 32 + 8 * fq;
#pragma unroll
        for (int ai = 0; ai < 2; ++ai)
#pragma unroll
            for (int m = 0; m < 4; ++m) { u16* rowp = base + (size_t)(row0 + ai * HALF + m * 16) * 1024 + col0;
#pragma unroll
                for (int bj = 0; bj < 2; ++bj) { const f32x4 v0 = acc[ai][bj][m][0] * sc, v1 = acc[ai][bj][m][1] * sc;
                    u32x4 w; w.x = cvt_pk_bf16(v0[0], v0[1]); w.y = cvt_pk_bf16(v0[2], v0[3]); w.z = cvt_pk_bf16(v1[0], v1[1]); w.w = cvt_pk_bf16(v1[2], v1[3]);
                    *(u32x4*)(rowp + bj * HALF) = w; } }
    }
};
struct EpiMoeDown {
    static constexpr bool PERM = true;
    u16* Y; const int* ltw; const float* lg; const float* isc;
    template <class Sched> __device__ __forceinline__ void operator()(const f32x4 (&acc)[2][2][4][2], const Unit& u, const Sched& S, int wr, int wc, int fr, int fq) const {
        const int nv = S.nvalid(u); const size_t lbase = (size_t)u.e * 16384 + u.rt * 256;
        const int col0 = u.pn * BM + wc * 32 + 8 * fq;
        const float* sp = isc + (size_t)u.e * 1024 + col0;
        f32x4 cs[2][2];
#pragma unroll
        for (int bj = 0; bj < 2; ++bj) { cs[bj][0] = *(const f32x4*)(sp + bj * HALF) * 0.5f; cs[bj][1] = *(const f32x4*)(sp + bj * HALF + 4) * 0.5f; }
#pragma unroll
        for (int ai = 0; ai < 2; ++ai)
#pragma unroll
            for (int m = 0; m < 4; ++m) { const int rr = ai * HALF + wr * 64 + m * 16 + fr;
                if (rr < nv) { const int tw = ltw[lbase + rr]; const float g = lg[lbase + rr]; u16* rowp = Y + (size_t)tw * 1024 + col0;
#pragma unroll
                    for (int bj = 0; bj < 2; ++bj) { const f32x4 v0 = acc[ai][bj][m][0] * cs[bj][0] * g, v1 = acc[ai][bj][m][1] * cs[bj][1] * g;
                        u32x4 w; w.x = cvt_pk_bf16(v0[0], v0[1]); w.y = cvt_pk_bf16(v0[2], v0[3]); w.z = cvt_pk_bf16(v1[0], v1[1]); w.w = cvt_pk_bf16(v1[2], v1[3]);
                        *(u32x4*)(rowp + bj * HALF) = w; } } }
    }
};
__device__ __forceinline__ float one_minus_exp(float t) { return t > -0.02f ? -t * (1.f + t * (0.5f + t * (0.16666667f + t * 0.041666667f))) : 1.f - __expf(t); }
struct EpiGates {
    static constexpr bool PERM = true;
    char* wsb; size_t o_la, o_xi, o_conv, o_tab;
    template <class Sched> __device__ __forceinline__ void operator()(f32x4 (&acc)[2][2][4][2], const Unit& u, const Sched&, int wr, int wc, int fr, int fq) const {
        const int row0 = u.pm * BM + wr * 64 + fr, ch0 = u.pn * HALF + wc * 32 + 8 * fq;
        u16* LA = (u16*)(wsb + o_la); u16* XI = (u16*)(wsb + o_xi); const u16* conv = (const u16*)(wsb + o_conv); const float* tab = (const float*)(wsb + o_tab) + ch0;
        asm volatile("" ::: "memory"); __builtin_amdgcn_sched_barrier(0);
        {
            float ba[8], sp8[8];
#pragma unroll
            for (int j = 0; j < 2; ++j) { const f32x4 t = *(const f32x4*)(tab + 4 * j), t2 = *(const f32x4*)(tab + 2 * 1280 + 4 * j); ba[4 * j] = t[0]; ba[4 * j + 1] = t[1]; ba[4 * j + 2] = t[2]; ba[4 * j + 3] = t[3]; sp8[4 * j] = t2[0]; sp8[4 * j + 1] = t2[1]; sp8[4 * j + 2] = t2[2]; sp8[4 * j + 3] = t2[3]; }
#pragma unroll
            for (int ai = 0; ai < 2; ++ai)
#pragma unroll
                for (int m = 0; m < 4; ++m)
#pragma unroll
                    for (int j = 0; j < 8; ++j) acc[ai][0][m][j >> 2][j & 3] = sp8[j] * __builtin_amdgcn_rcpf(1.f + __expf(-(acc[ai][0][m][j >> 2][j & 3] + ba[j])));
        }
        float bx[8];
#pragma unroll
        for (int j = 0; j < 2; ++j) { const f32x4 t = *(const f32x4*)(tab + 1280 + 4 * j); bx[4 * j] = t[0]; bx[4 * j + 1] = t[1]; bx[4 * j + 2] = t[2]; bx[4 * j + 3] = t[3]; }
#pragma unroll
        for (int ai = 0; ai < 2; ++ai)
#pragma unroll
            for (int m = 0; m < 4; ++m) { const size_t off = (size_t)(row0 + ai * HALF + m * 16) * 1280 + ch0;
                const u32x4 cv = *(const u32x4*)(conv + off);
                u32x4 wl, wx;
#pragma unroll
                for (int q = 0; q < 4; ++q) {
                    const float c0 = __uint_as_float(cv[q] << 16), c1 = __uint_as_float(cv[q] & 0xffff0000u);
                    const int j0 = 2 * q, j1 = 2 * q + 1;
                    const float la0 = acc[ai][0][m][j0 >> 2][j0 & 3], la1 = acc[ai][0][m][j1 >> 2][j1 & 3];
                    const float rx0 = acc[ai][1][m][j0 >> 2][j0 & 3] + bx[j0], rx1 = acc[ai][1][m][j1 >> 2][j1 & 3] + bx[j1];
                    const float x0 = __builtin_amdgcn_sqrtf(one_minus_exp(2.f * la0)) * (c0 * __builtin_amdgcn_rcpf(1.f + __expf(-rx0))), x1 = __builtin_amdgcn_sqrtf(one_minus_exp(2.f * la1)) * (c1 * __builtin_amdgcn_rcpf(1.f + __expf(-rx1)));
                    wl[q] = cvt_pk_bf16(la0, la1); wx[q] = cvt_pk_bf16(x0, x1);
                }
                *(u32x4*)(LA + off) = wl; *(u32x4*)(XI + off) = wx;
                asm volatile("" ::: "memory"); }
    }
};
}
#include <hip/hip_bf16.h>
namespace attn_body {
using bf16=__hip_bfloat16;
using bf16x8=__attribute__((ext_vector_type(8)))short;
using s16x4=__attribute__((ext_vector_type(4)))short;
using f32x16=__attribute__((ext_vector_type(16)))float;
using u32x4=__attribute__((ext_vector_type(4)))unsigned;
constexpr int BATCH=4,NHEAD=16,SEQ=4096,D=64,DM=NHEAD*D;
constexpr int NW=8,QBLK=32,QB=QBLK*NW,KVBLK=64,NQB=SEQ/QB;
constexpr int ATTN_PITCH=DM, ATTN_UNIT_ROWS=QB;
__device__ __forceinline__ int crow(int r,int hi){return (r&3)+8*(r>>2)+4*hi;}
#define SBAR() __builtin_amdgcn_sched_barrier(0)
__device__ __forceinline__ void cmask(f32x16&p0,f32x16&p1,int jb,int qrel,int hi){
  const float NEG=-INFINITY; int kb=64*jb+4*hi;
  #pragma unroll
  for(int r=0;r<16;++r){int kv=kb+(r&3)+8*(r>>2); if(kv>qrel)p0[r]=NEG; if(kv+32>qrel)p1[r]=NEG;}
}

constexpr int NSLOT=3, SLOTB=8192;
constexpr int LDS_K=0, LDS_V=NSLOT*SLOTB, LDS_WS=2*NSLOT*SLOTB, LDS_OST=LDS_WS+NW*64*4, LDS_KB=LDS_OST+NW*4096, LDS_BYTES=LDS_KB+16384;
constexpr float C2=0.125f*1.4426950408889634f;
__device__ __forceinline__ void glds16(const void*gsrc,unsigned lds_dst){unsigned keep;
  asm volatile("s_mov_b32 %0, m0\n\ts_mov_b32 m0, %2\n\ts_nop 0\n\tglobal_load_lds_dwordx4 %1, off\n\ts_mov_b32 m0, %0":"=&s"(keep):"v"(gsrc),"s"(lds_dst):"memory");}
__device__ __forceinline__ float max3f(float a,float b,float c){float r;asm("v_max3_f32 %0, %1, %2, %3":"=v"(r):"v"(a),"v"(b),"v"(c));return r;}
__device__ __forceinline__ float max2f(float a,float b){float r;asm("v_max_f32_e32 %0, %1, %2":"=v"(r):"v"(a),"v"(b));return r;}
__device__ __forceinline__ float fadd_s(float a,float b){float r;asm("v_add_f32_e32 %0, %1, %2":"=v"(r):"v"(a),"v"(b));return r;}
__device__ __forceinline__ float fsub_s(float a,float b){float r;asm("v_sub_f32_e32 %0, %1, %2":"=v"(r):"v"(a),"v"(b));return r;}
typedef float f32x2_t __attribute__((ext_vector_type(2))); typedef __bf16 bf16x2_t __attribute__((ext_vector_type(2)));
__device__ __forceinline__ unsigned cvtpk_s(float lo,float hi){f32x2_t v={lo,hi};bf16x2_t b=__builtin_convertvector(v,bf16x2_t);return __builtin_bit_cast(unsigned,b);}
#define WAIT_BAR(N) asm volatile("s_waitcnt vmcnt(" #N ") lgkmcnt(0)\n\ts_barrier":::"memory")

__device__ __forceinline__ void qkt(f32x16&p0,f32x16&p1,const char*Kslot,const bf16x8*qr,const f32x16&negm,int r32,int hi){
  const char*kb=Kslot+hi*1024+r32*16;
  #pragma unroll
  for(int d0=0;d0<4;++d0){
    const bf16x8 b0=*reinterpret_cast<const bf16x8*>(kb+d0*2048);
    const bf16x8 b1=*reinterpret_cast<const bf16x8*>(kb+d0*2048+512);
    if(d0==0){p0=__builtin_amdgcn_mfma_f32_32x32x16_bf16(b0,qr[0],negm,0,0,0);p1=__builtin_amdgcn_mfma_f32_32x32x16_bf16(b1,qr[0],negm,0,0,0);}
    else{p0=__builtin_amdgcn_mfma_f32_32x32x16_bf16(b0,qr[d0],p0,0,0,0);p1=__builtin_amdgcn_mfma_f32_32x32x16_bf16(b1,qr[d0],p1,0,0,0);}}
}
__device__ __forceinline__ void qkt_acc(f32x16&p0,f32x16&p1,const char*Kslot,const bf16x8*qr,int r32,int hi){
  const char*kb=Kslot+hi*1024+r32*16;
  #pragma unroll
  for(int d0=0;d0<4;++d0){
    const bf16x8 b0=*reinterpret_cast<const bf16x8*>(kb+d0*2048);
    const bf16x8 b1=*reinterpret_cast<const bf16x8*>(kb+d0*2048+512);
    p0=__builtin_amdgcn_mfma_f32_32x32x16_bf16(b0,qr[d0],p0,0,0,0);p1=__builtin_amdgcn_mfma_f32_32x32x16_bf16(b1,qr[d0],p1,0,0,0);}
}
typedef __attribute__((address_space(3))) const char* lds_cptr;
typedef short v4i16_t __attribute__((ext_vector_type(4)));
__device__ __forceinline__ void kload8(bf16x8*kf,lds_cptr kp){
  kf[0]=*(const __attribute__((address_space(3))) bf16x8*)(kp);      kf[1]=*(const __attribute__((address_space(3))) bf16x8*)(kp+512);
  kf[2]=*(const __attribute__((address_space(3))) bf16x8*)(kp+2048); kf[3]=*(const __attribute__((address_space(3))) bf16x8*)(kp+2560);
  kf[4]=*(const __attribute__((address_space(3))) bf16x8*)(kp+4096); kf[5]=*(const __attribute__((address_space(3))) bf16x8*)(kp+4608);
  kf[6]=*(const __attribute__((address_space(3))) bf16x8*)(kp+6144); kf[7]=*(const __attribute__((address_space(3))) bf16x8*)(kp+6656);
}
__device__ __forceinline__ void kload2(bf16x8*kf,lds_cptr kp,int j){ kf[2*j]=*(const __attribute__((address_space(3))) bf16x8*)(kp+j*2048); kf[2*j+1]=*(const __attribute__((address_space(3))) bf16x8*)(kp+j*2048+512); }
__device__ __forceinline__ s16x4 vtr(lds_cptr p){ return __builtin_bit_cast(s16x4,__builtin_amdgcn_ds_read_tr16_b64_v4i16((__attribute__((address_space(3))) v4i16_t*)p)); }
__device__ __forceinline__ float rowmax(const f32x16&p0,const f32x16&p1){
  float a=max3f(p0[0],p0[1],p1[0]),b=max3f(p0[2],p0[3],p1[1]);a=max3f(a,p1[2],p1[3]);
  #pragma unroll
  for(int r=4;r<16;r+=4){a=max3f(a,p0[r],p0[r+1]);b=max3f(b,p0[r+2],p0[r+3]);a=max3f(a,p1[r],p1[r+1]);b=max3f(b,p1[r+2],p1[r+3]);}
  const float m=max2f(a,b);
  auto rr=__builtin_amdgcn_permlane32_swap(__float_as_uint(m),__float_as_uint(m),false,false);
  return max2f(__uint_as_float(rr[0]),__uint_as_float(rr[1]));
}
__device__ __forceinline__ void pv(f32x16*o,int vb,bf16x8 pa0,bf16x8 pa1,bf16x8 pa2,bf16x8 pa3){
  #pragma unroll
  for(int d0=0;d0<2;++d0){s16x4 lo[4],hi[4];
    #pragma unroll
    for(int ks=0;ks<4;++ks){
      asm volatile("ds_read_b64_tr_b16 %0,%1 offset:%c2":"=&v"(lo[ks]):"v"(vb),"i"(d0*4096+ks*1024):"memory");
      asm volatile("ds_read_b64_tr_b16 %0,%1 offset:%c2":"=&v"(hi[ks]):"v"(vb),"i"(d0*4096+ks*1024+512):"memory");}
    asm volatile("s_waitcnt lgkmcnt(0)":::"memory");SBAR();
    #define PK(k) (bf16x8){lo[k][0],lo[k][1],lo[k][2],lo[k][3],hi[k][0],hi[k][1],hi[k][2],hi[k][3]}
    o[d0]=__builtin_amdgcn_mfma_f32_32x32x16_bf16(pa0,PK(0),o[d0],0,0,0);
    o[d0]=__builtin_amdgcn_mfma_f32_32x32x16_bf16(pa1,PK(1),o[d0],0,0,0);
    o[d0]=__builtin_amdgcn_mfma_f32_32x32x16_bf16(pa2,PK(2),o[d0],0,0,0);
    o[d0]=__builtin_amdgcn_mfma_f32_32x32x16_bf16(pa3,PK(3),o[d0],0,0,0);
    #undef PK
  }
}

#ifndef ATTN_STORE16
#define ATTN_STORE16(p,v) (*(u32x4*)(p)=(v))
#endif
template<int THRL,bool MOBA> __device__ __forceinline__ void attn_unit(int b,int h,int qb,const bf16*Q,const bf16*__restrict__ K,const bf16*__restrict__ V,bf16*O,char*shm,const float*aux,const unsigned*kn2){
  int tid_=threadIdx.x; asm volatile("":"+v"(tid_));
  const int tid=tid_,lane=tid&63,r32=lane&31,hi=lane>>5; const int wid=__builtin_amdgcn_readfirstlane(tid>>6);
  const long rowbase=(long)b*SEQ; const int q0=qb*QB;
  const bf16*Qw=Q+(rowbase+q0+wid*QBLK)*DM+h*D;
  const bf16*Kh=K+rowbase*DM+h*D,*Vh=V+rowbase*DM+h*D;
  const lds_cptr shm3=(lds_cptr)shm;
  const unsigned lds0=(unsigned)(uintptr_t)shm;
  float*wsf=(float*)(shm+LDS_WS)+wid*64;
  const bf16*ksrc=Kh+(long)lane*DM+wid*8;
  const bf16*vsrc=Vh+(long)(16*(wid&3)+(lane>>2))*DM+(wid>>2)*32+(lane&3)*8;
  const unsigned kdst=lds0+LDS_K+wid*1024, vdst=lds0+LDS_V+wid*1024;
  #define TA(t) (NTA-1-(t))
  #define DMA_K(t,slot) glds16(ksrc+(long)(TA(t))*KVBLK*DM,(unsigned)__builtin_amdgcn_readfirstlane(kdst+(slot)))
  #define DMA_V(t,slot) glds16(vsrc+(long)(TA(t))*KVBLK*DM,(unsigned)__builtin_amdgcn_readfirstlane(vdst+(slot)))
  const int vb0=(int)(lds0+LDS_V)+((lane>>4)&1)*32+(lane&3)*8+(4*hi+((lane&15)>>2))*64;
  const char*Kbase=shm+LDS_K; bf16x8 kf[8];
  const lds_cptr kp0=shm3+LDS_K+hi*1024+r32*16; const lds_cptr vp0=shm3+LDS_V+((lane>>4)&1)*32+(lane&3)*8+(4*hi+((lane&15)>>2))*64;
  const int NTA=(q0+QB)/KVBLK;
  int NT=NTA;
  typedef __attribute__((address_space(3))) const float* lds_fptr; typedef float f32x4_t __attribute__((ext_vector_type(4)));
  const lds_fptr kbl=(lds_fptr)(shm3+LDS_KB);
  if constexpr(MOBA){ if(qb>0){
      if(tid<qb*16){ const f32x4_t v=*(const __attribute__((address_space(1))) f32x4_t*)(aux+tid*4); *(__attribute__((address_space(3))) f32x4_t*)((__attribute__((address_space(3))) char*)shm3+LDS_KB+tid*16)=v; } } }
  else {
    glds16(aux+(wid*2)*256+lane*4,(unsigned)__builtin_amdgcn_readfirstlane(lds0+LDS_KB+(wid*2)*1024));
    glds16(aux+(wid*2+1)*256+lane*4,(unsigned)__builtin_amdgcn_readfirstlane(lds0+LDS_KB+(wid*2+1)*1024)); }
  DMA_K(0,0);DMA_V(0,0);DMA_K(1,SLOTB);
  bf16x8 qr[4];
  #pragma unroll
  for(int d0=0;d0<4;++d0)qr[d0]=*reinterpret_cast<const bf16x8*>(&Qw[(long)r32*DM+d0*16+hi*8]);
  float mhat=0.f,l_reg=0.f;f32x16 o[2];o[0]=f32x16{};o[1]=f32x16{};f32x16 negm=f32x16{};if constexpr(MOBA)asm volatile("":"+v"(negm));
  unsigned amask=0xffffffffu;
  const int qrel=wid*QBLK+r32;
  #define CMASK(P0,P1,t) do{ if((t)<4)cmask(P0,P1,3-(t),qrel,hi); }while(0)
  bool resc=false;
  #define START(P0,P1) do{ const float rm=rowmax(P0,P1); resc=false; \
    { const float dl=rm<-1e37f?0.f:rm; mhat=fadd_s(mhat,dl);     \
      _Pragma("unroll") for(int r=0;r<16;++r){P0[r]=fsub_s(P0[r],dl);P1[r]=fsub_s(P1[r],dl);} \
      if constexpr(MOBA){ _Pragma("unroll") for(int r=0;r<16;++r)negm[r]=-mhat; asm volatile("":"+v"(negm)); } } \
    _Pragma("unroll") for(int r=0;r<16;++r)P0[r]=__builtin_amdgcn_exp2f(P0[r]); }while(0)
  #define RESC() do{ if(resc){ asm volatile("s_waitcnt lgkmcnt(0)":::"memory"); \
      _Pragma("unroll") for(int d_=0;d_<2;++d_) _Pragma("unroll") for(int r=0;r<16;++r)o[d_][r]*=wsf[crow(r,hi)]; } }while(0)
  f32x16 pA0,pA1,pB0,pB1;
  int sl_prev=0,sl_cur=0,sl_next=SLOTB;
  #define ROT() do{sl_prev=sl_cur;sl_cur=sl_next;sl_next=(sl_next==(NSLOT-1)*SLOTB)?0:sl_next+SLOTB;}while(0)
  DMA_K(2,2*SLOTB);
  if constexpr(!MOBA){
    float s2=0.f;
    #pragma unroll
    for(int d0=0;d0<4;++d0){
      #pragma unroll
      for(int i=0;i<8;++i){ const float qv=__uint_as_float(((unsigned)(unsigned short)qr[d0][i])<<16); s2+=qv*qv; } }
    { auto rr=__builtin_amdgcn_permlane32_swap(__float_as_uint(s2),__float_as_uint(s2),false,false); s2=__uint_as_float(rr[0])+__uint_as_float(rr[1]); }
    #pragma unroll
    for(int o_=1;o_<32;o_<<=1)s2=__builtin_fmaxf(s2,__shfl_xor(s2,o_));
    if(lane==0)wsf[63]=s2; }
  WAIT_BAR(3);
  #define INITB(C0,C1,t) do{ const lds_fptr kbp_=kbl+TA(t)*64+4*hi; \
    _Pragma("unroll") for(int g_=0;g_<4;++g_){ const f32x4_t b0_=*(const __attribute__((address_space(3))) f32x4_t*)(kbp_+8*g_), b1_=*(const __attribute__((address_space(3))) f32x4_t*)(kbp_+32+8*g_); \
      _Pragma("unroll") for(int i_=0;i_<4;++i_){ C0[4*g_+i_]=b0_[i_]-mhat; C1[4*g_+i_]=b1_[i_]-mhat; } } }while(0)
  if constexpr(MOBA){
    if(qb>0){
      float qf[32];
      #pragma unroll
      for(int d0=0;d0<4;++d0){
        #pragma unroll
        for(int i=0;i<8;++i)qf[8*d0+i]=__uint_as_float(((unsigned)(unsigned short)qr[d0][i])<<16);}
      float v1=-INFINITY,v2=-INFINITY,v3=-INFINITY;int i1=-1,i2=-1,i3=-1;
      for(int j=0;j<qb;++j){ const lds_fptr kr=kbl+j*64+8*hi; float g=0.f;
        #pragma unroll
        for(int d0=0;d0<4;++d0){ const f32x4_t a_=*(const __attribute__((address_space(3))) f32x4_t*)(kr+16*d0), b_=*(const __attribute__((address_space(3))) f32x4_t*)(kr+16*d0+4);
          g+=qf[8*d0]*a_[0]+qf[8*d0+1]*a_[1]+qf[8*d0+2]*a_[2]+qf[8*d0+3]*a_[3]+qf[8*d0+4]*b_[0]+qf[8*d0+5]*b_[1]+qf[8*d0+6]*b_[2]+qf[8*d0+7]*b_[3]; }
        { auto rr=__builtin_amdgcn_permlane32_swap(__float_as_uint(g),__float_as_uint(g),false,false); g=__uint_as_float(rr[0])+__uint_as_float(rr[1]); }
        if(g>v1){v3=v2;i3=i2;v2=v1;i2=i1;v1=g;i1=j;} else if(g>v2){v3=v2;i3=i2;v2=g;i2=j;} else if(g>v3){v3=g;i3=j;} }
      amask=1u<<qb; if(i1>=0)amask|=1u<<i1; if(i2>=0)amask|=1u<<i2; if(i3>=0)amask|=1u<<i3; }
    qkt(pA0,pA1,Kbase,qr,negm,r32,hi);
  } else {
    float q2=0.f,k2=0.f;
    #pragma unroll
    for(int w_=0;w_<8;++w_){ q2=__builtin_fmaxf(q2,((const float*)(shm+LDS_WS))[w_*64+63]); k2+=__uint_as_float(kn2[w_]); }
    const float bnd=2.f*1.02f*__builtin_sqrtf(q2)*__builtin_sqrtf(k2)-kbl[q0]+64.f;
    const bool dead=(lane<NTA)&&(kbl[64*lane+63]+bnd<0.f);
    const int nskip=__builtin_popcountll(__ballot(dead));
    NT=NTA-nskip; NT=(NT+1)&~1; NT=NT<4?4:NT;
    INITB(pA0,pA1,0); qkt_acc(pA0,pA1,Kbase,qr,r32,hi); }
  asm volatile("s_nop 15\n\ts_nop 7":"+v"(pA0),"+v"(pA1));CMASK(pA0,pA1,0);
  START(pA0,pA1);
  _Pragma("unroll") for(int r=0;r<16;++r)pA1[r]=__builtin_amdgcn_exp2f(pA1[r]);
  WAIT_BAR(0);
  DMA_K(3,0);DMA_V(1,SLOTB);
  ROT();
  kload8(kf,kp0+sl_cur);
  WAIT_BAR(2);
  s16x4 vlo[8],vhi[8]; u32x4 pw0,pw1,pw2,pw3;
  #define PKW(P,B) cvtpk_s(P[B],P[B+1])
  #define PAF(k) __builtin_bit_cast(bf16x8,pw##k)
  #define VFR(i) (bf16x8){vlo[i][0],vlo[i][1],vlo[i][2],vlo[i][3],vhi[i][0],vhi[i][1],vhi[i][2],vhi[i][3]}
  #define PIN(x) asm volatile("":"+v"(x))
  #define MX3(a,b,c) __builtin_fmaxf(__builtin_fmaxf((a),(b)),(c))
  #define GAPA(MF,A0,A1,A2,A3,W0,W1,PW) do{ MF; sacc+=A0; sacc+=A1; sacc+=A2; sacc+=A3; PIN(sacc); W0; W1; PIN(PW); SBAR(); }while(0)
  #define EX(v) __builtin_amdgcn_exp2f(v)
  #define GAPB(MF,X,B) do{ MF; X[B]=EX(X[B]); X[B+1]=EX(X[B+1]); X[B+2]=EX(X[B+2]); X[B+3]=EX(X[B+3]); PIN(X); SBAR(); }while(0)
  #define VRD(i) do{ vlo[i]=vtr(vp_+(((i)>>2)*4096+((i)&3)*1024)); vhi[i]=vtr(vp_+(((i)>>2)*4096+((i)&3)*1024+512)); }while(0)
  #define KRD(G,j) do{ if(G){ kload2(kf,kp0+sl_next,j); SBAR(); } }while(0)
  #define CIN(X) (MOBA?negm:X)
  #define STEP(C0,C1,P0,P1,t,GK,GV,GL) do{ SBAR(); \
    if constexpr(!MOBA){ INITB(C0,C1,t); SBAR(); } \
    const lds_cptr vp_=vp0+sl_prev; \
    VRD(0); SBAR(); float sacc=(P0[0]+P0[1]); \
    GAPA(C0=__builtin_amdgcn_mfma_f32_32x32x16_bf16(kf[0],qr[0],CIN(C0),0,0,0), P0[2],P0[3],P0[4],P0[5],     pw0[0]=PKW(P0,0), pw0[1]=PKW(P0,2), pw0); \
    VRD(4); SBAR(); GAPA(C1=__builtin_amdgcn_mfma_f32_32x32x16_bf16(kf[1],qr[0],CIN(C1),0,0,0), P0[6],P0[7],P0[8],P0[9],     pw0[2]=PKW(P0,4), pw0[3]=PKW(P0,6), pw0); \
    VRD(1); SBAR(); GAPA(C0=__builtin_amdgcn_mfma_f32_32x32x16_bf16(kf[2],qr[1],C0,0,0,0),   P0[10],P0[11],P0[12],P0[13], pw1[0]=PKW(P0,8), pw1[1]=PKW(P0,10), pw1); \
    VRD(5); SBAR(); GAPA(C1=__builtin_amdgcn_mfma_f32_32x32x16_bf16(kf[3],qr[1],C1,0,0,0),   P0[14],P0[15],P1[0],P1[1],   pw1[2]=PKW(P0,12),pw1[3]=PKW(P0,14), pw1); \
    VRD(2); SBAR(); GAPA(C0=__builtin_amdgcn_mfma_f32_32x32x16_bf16(kf[4],qr[2],C0,0,0,0),   P1[2],P1[3],P1[4],P1[5],     pw2[0]=PKW(P1,0), pw2[1]=PKW(P1,2), pw2); \
    VRD(6); SBAR(); GAPA(C1=__builtin_amdgcn_mfma_f32_32x32x16_bf16(kf[5],qr[2],C1,0,0,0),   P1[6],P1[7],P1[8],P1[9],     pw2[2]=PKW(P1,4), pw2[3]=PKW(P1,6), pw2); \
    VRD(3); SBAR(); GAPA(C0=__builtin_amdgcn_mfma_f32_32x32x16_bf16(kf[6],qr[3],C0,0,0,0),   P1[10],P1[11],P1[12],P1[13], pw3[0]=PKW(P1,8), pw3[1]=PKW(P1,10), pw3); \
    VRD(7); SBAR(); GAPA(C1=__builtin_amdgcn_mfma_f32_32x32x16_bf16(kf[7],qr[3],C1,0,0,0),   P1[14],P1[15],0.f,0.f,       pw3[2]=PKW(P1,12),pw3[3]=PKW(P1,14), pw3); \
    if constexpr(MOBA){ const bool okp_=((amask>>(TA((t)-1)>>2))&1u)!=0u; l_reg+=okp_?sacc:0.f; \
      _Pragma("unroll") for(int i_=0;i_<4;++i_){ pw0[i_]=okp_?pw0[i_]:0u; pw1[i_]=okp_?pw1[i_]:0u; pw2[i_]=okp_?pw2[i_]:0u; pw3[i_]=okp_?pw3[i_]:0u; } } \
    else { l_reg+=sacc; } \
    if(GK){DMA_K((t)+3,sl_cur);} if(GV){DMA_V((t)+1,sl_next);} \
    CMASK(C0,C1,t); \
    { float a=MX3(C0[0],C0[1],C1[0]),b=MX3(C0[2],C0[3],C1[1]); a=MX3(a,C1[2],C1[3]); \
      _Pragma("unroll") for(int r=4;r<16;r+=4){a=MX3(a,C0[r],C0[r+1]);b=MX3(b,C0[r+2],C0[r+3]);a=MX3(a,C1[r],C1[r+1]);b=MX3(b,C1[r+2],C1[r+3]);} \
      float rm=__builtin_fmaxf(a,b); { auto rr=__builtin_amdgcn_permlane32_swap(__float_as_uint(rm),__float_as_uint(rm),false,false); rm=__builtin_fmaxf(__uint_as_float(rr[0]),__uint_as_float(rr[1])); } \
      resc=false; \
      if(__builtin_expect(__any(rm>(float)THRL),0)){ const float dl=__builtin_fmaxf(rm,0.f); mhat+=dl; \
        _Pragma("unroll") for(int r=0;r<16;++r){C0[r]-=dl;C1[r]-=dl;} \
        if constexpr(MOBA){ _Pragma("unroll") for(int r=0;r<16;++r)negm[r]=-mhat; asm volatile("":"+v"(negm)); } \
        const float f=__builtin_amdgcn_exp2f(-dl); l_reg*=f; if(hi==0)wsf[r32]=f; resc=true; } } \
    SBAR(); \
    GAPB(o[0]=__builtin_amdgcn_mfma_f32_32x32x16_bf16(PAF(0),VFR(0),o[0],0,0,0), C0,0); \
    GAPB(o[1]=__builtin_amdgcn_mfma_f32_32x32x16_bf16(PAF(0),VFR(4),o[1],0,0,0), C0,4); \
    KRD(GL,0); GAPB(o[0]=__builtin_amdgcn_mfma_f32_32x32x16_bf16(PAF(1),VFR(1),o[0],0,0,0), C0,8); \
    KRD(GL,1); GAPB(o[1]=__builtin_amdgcn_mfma_f32_32x32x16_bf16(PAF(1),VFR(5),o[1],0,0,0), C0,12); \
    KRD(GL,2); GAPB(o[0]=__builtin_amdgcn_mfma_f32_32x32x16_bf16(PAF(2),VFR(2),o[0],0,0,0), C1,0); \
    KRD(GL,3); GAPB(o[1]=__builtin_amdgcn_mfma_f32_32x32x16_bf16(PAF(2),VFR(6),o[1],0,0,0), C1,4); \
    GAPB(o[0]=__builtin_amdgcn_mfma_f32_32x32x16_bf16(PAF(3),VFR(3),o[0],0,0,0), C1,8); \
    GAPB(o[1]=__builtin_amdgcn_mfma_f32_32x32x16_bf16(PAF(3),VFR(7),o[1],0,0,0), C1,12); \
    }while(0)
  int t=1;
  for(;t+5<NT;t+=2){
    STEP(pB0,pB1,pA0,pA1,t,true,true,true);     WAIT_BAR(2); RESC(); ROT();
    STEP(pA0,pA1,pB0,pB1,t+1,true,true,true);   WAIT_BAR(2); RESC(); ROT();
  }
  #define ENDW(tt) do{ if((tt)+3<NT){WAIT_BAR(2);} else if((tt)+2<NT){WAIT_BAR(1);} else {WAIT_BAR(0);} }while(0)
  for(;t+1<NT;t+=2){
    STEP(pB0,pB1,pA0,pA1,t,(t+3<NT),(t+1<NT),(t+1<NT));       ENDW(t);   RESC(); ROT();
    STEP(pA0,pA1,pB0,pB1,t+1,(t+4<NT),(t+2<NT),(t+2<NT));     ENDW(t+1); RESC(); ROT();
  }
  STEP(pB0,pB1,pA0,pA1,NT-1,false,false,false); RESC();
  { float sacc=pB0[0]+pB0[1]; _Pragma("unroll") for(int r=2;r<16;++r)sacc+=pB0[r]; _Pragma("unroll") for(int r=0;r<16;++r)sacc+=pB1[r]; l_reg+=sacc;
    pw0=(u32x4){PKW(pB0,0),PKW(pB0,2),PKW(pB0,4),PKW(pB0,6)};pw1=(u32x4){PKW(pB0,8),PKW(pB0,10),PKW(pB0,12),PKW(pB0,14)};pw2=(u32x4){PKW(pB1,0),PKW(pB1,2),PKW(pB1,4),PKW(pB1,6)};pw3=(u32x4){PKW(pB1,8),PKW(pB1,10),PKW(pB1,12),PKW(pB1,14)};
    SBAR(); pv(o,vb0+sl_cur,PAF(0),PAF(1),PAF(2),PAF(3)); }
  #undef PKW
  #undef PAF
  #undef VFR
  #undef PIN
  #undef MX3
  #undef GAPA
  #undef GAPB
  #undef EX
  #undef VRD
  #undef KRD
  #undef STEP
  #undef CIN
  #undef INITB
  #undef ENDW
  {auto rr=__builtin_amdgcn_permlane32_swap(__float_as_uint(l_reg),__float_as_uint(l_reg),false,false);l_reg=__uint_as_float(rr[0])+__uint_as_float(rr[1]);}
  if(hi==0)wsf[32+r32]=l_reg;asm volatile("s_waitcnt lgkmcnt(0)":::"memory");
  float rli[16];
  #pragma unroll
  for(int r=0;r<16;++r)rli[r]=__builtin_amdgcn_rcpf(wsf[32+crow(r,hi)]);
  bf16*Ow=O+(rowbase+q0+wid*QBLK)*DM+h*D;
  { bf16*stg=(bf16*)(shm+LDS_OST)+wid*2048;
    #pragma unroll
    for(int r=0;r<16;++r){const int orow=crow(r,hi);
      #pragma unroll
      for(int d0=0;d0<2;++d0)stg[orow*64+d0*32+r32]=__float2bfloat16(o[d0][r]*rli[r]);}
    asm volatile("s_waitcnt lgkmcnt(0)":::"memory");
    #pragma unroll
    for(int i=0;i<4;++i){const int row=i*8+(lane>>3),ch=lane&7; const u32x4 v=*(const u32x4*)(stg+row*64+ch*8); ATTN_STORE16(Ow+(long)row*DM+ch*8,v);} }
  asm volatile("s_waitcnt lgkmcnt(0)\n\ts_barrier":::"memory");
  #undef DMA_K
  #undef DMA_V
  #undef TA
  #undef CMASK
  #undef START
  #undef RESC
  #undef ROT
}
constexpr int ATTN_LDS_BYTES=LDS_BYTES;
struct AttnTensors { const bf16* Q; const bf16* K; const bf16* V; bf16* O; };
struct AttnUnit { int b; int h; int qb; };
__device__ __forceinline__ void unit_of(int idx,AttnUnit&u){
  int grp=idx>>5; const int bh=idx&31; bool fox; int qb;
  if(grp<11){fox=false;qb=15-grp;} else if(grp<22){fox=true;qb=15-(grp-11);} else {grp-=22;fox=(grp&1)!=0;qb=4-(grp>>1);}
  u.b=bh>>3; u.h=(bh&7)+(fox?8:0); u.qb=qb;
}
template<int THRL=8> __device__ __forceinline__ void attn_phase(char*lds,const AttnTensors&T,const float*ksum,const float*kbias,const unsigned*kn2,int*qhead,volatile __attribute__((address_space(3))) int*slot){
  AttnUnit u;
  for(;;){
    if(threadIdx.x==0)slot[0]=atomicAdd(qhead,1);
    asm volatile("s_waitcnt vmcnt(0) lgkmcnt(0)\n\ts_barrier":::"memory");
    const int idx=slot[0];
    asm volatile("s_waitcnt lgkmcnt(0)\n\ts_barrier":::"memory");
    if(idx>=1024)break;
    unit_of(idx,u);
    if(u.h<8) attn_unit<THRL,true>(u.b,u.h,u.qb,T.Q,T.K,T.V,T.O,lds,ksum+(size_t)(u.b*8+u.h)*16*64,kn2);
    else attn_unit<THRL,false>(u.b,u.h,u.qb,T.Q,T.K,T.V,T.O,lds,kbias+(size_t)(u.b*8+(u.h-8))*SEQ,kn2+(u.b*8+(u.h-8))*8); }
}
#undef SBAR
#undef WAIT_BAR
}

constexpr size_t MiB = 1u << 20;
constexpr size_t WS_CTL = 0;
constexpr size_t WS_MOD = 1 * MiB;
constexpr size_t WS_ROPE = 1 * MiB + 256 * 1024;
constexpr size_t WS_LOGF = 1 * MiB + 512 * 1024;
constexpr size_t WS_KBIAS = 2 * MiB;
constexpr size_t WS_SP8 = 2 * MiB + 512 * 1024;
constexpr size_t WS_AGG = 3 * MiB;
constexpr size_t WS_LTW = 5 * MiB;
constexpr size_t WS_LG = 5 * MiB + 512 * 1024;
constexpr size_t WS_WMGU = 6 * MiB;
constexpr size_t WS_SB = 64 * MiB;
constexpr size_t WS_WMDN = 118 * MiB;
constexpr size_t WS_SBD = 65 * MiB;
constexpr size_t WS_WAIN = 174 * MiB;
constexpr size_t WS_WAOUT = 180 * MiB;
constexpr size_t WS_WFGU = 182 * MiB;
constexpr size_t WS_WFDN = 193 * MiB;
constexpr size_t WS_WLIN = 199 * MiB;
constexpr size_t WS_WLOUT = 204 * MiB;
constexpr size_t WS_WLG = 207 * MiB;
constexpr size_t WS_HA = 208 * MiB;
constexpr size_t WS_R = 240 * MiB;
constexpr size_t WS_Q = WS_R, WS_K = WS_R + 32 * MiB, WS_V = WS_R + 64 * MiB;
constexpr size_t WS_Y = WS_R + 96 * MiB;
constexpr size_t WS_O = WS_R + 128 * MiB;
constexpr size_t WS_HM = WS_R;
constexpr size_t WS_P2 = WS_R;
constexpr size_t WS_LA = WS_R + 80 * MiB;
constexpr size_t WS_XI = WS_R + 120 * MiB;
constexpr size_t WS_CONV = WS_R + 160 * MiB;
constexpr size_t WS_YL = WS_R + 200 * MiB;
constexpr size_t WS_HMID = WS_R;
constexpr size_t WS_YBUF = 174 * MiB;
constexpr size_t WS_END = 480 * MiB;
constexpr int CW_CNT = 64;
constexpr int CW_BAR = 4096;
constexpr int CW_KSUM = 65536;
constexpr int CW_AQ = 320;
constexpr int CW_CQG = 128, CW_CQD = 192;
constexpr int CW_KN2 = 98304;

constexpr int NWAVES = 8;
constexpr int RING_BYTES = 131072, CTRL_OFF = 139264, MISC_OFF = CTRL_OFF + 320, LDS_BYTES = 147456;

#define LAS __attribute__((address_space(3)))
#define GAS __attribute__((address_space(1)))
typedef GAS unsigned gu32;
#define LDS_WAIT() asm volatile("s_waitcnt lgkmcnt(0)" ::: "memory")

#define XB_TMO      128
#define XB_XCNT(j)  (256  + 64 * (j))
#define XB_XSUB(j)  (1280 + 64 * (j))
#define XB_XGEN(j)  (2304 + 64 * (j))
#define XB_TOP      3328
#define XB_TOPGEN   3392
#define XCD_BAR_WORDS 3456
#define XB_SPIN_CAP (1u << 18)

__device__ __forceinline__ unsigned xb_ld(unsigned* p)              { return __hip_atomic_load(p, __ATOMIC_RELAXED, __HIP_MEMORY_SCOPE_AGENT); }
__device__ __forceinline__ unsigned xb_add(unsigned* p, unsigned v) { return __hip_atomic_fetch_add(p, v, __ATOMIC_RELAXED, __HIP_MEMORY_SCOPE_AGENT); }
__device__ __forceinline__ unsigned xb_xcc_id() { return (unsigned)__builtin_amdgcn_s_getreg((3 << 11) | 20) & 0xFu; }
#define XB_SPIN(cond, bar) do { unsigned _sp = 0; while (cond) { __builtin_amdgcn_s_sleep(1); \
    if ((++_sp & 255u) == 0u) { if (xb_ld(&(bar)[XB_TMO])) break; if (_sp > XB_SPIN_CAP) { atomicAdd(&(bar)[XB_TMO], 1u); break; } } } } while (0)

struct XcdBarrier {
    unsigned* bar; unsigned x;
    volatile LAS unsigned* st;
};

__device__ __forceinline__ XcdBarrier xcd_barrier_post(unsigned* bar, volatile LAS unsigned* st) {
    XcdBarrier b; b.bar = bar; b.x = xb_xcc_id(); b.st = st;
    if (threadIdx.x == 0) (void)xb_add(&bar[XB_XCNT(b.x)], 1u);
    return b;
}
__device__ __forceinline__ void xcd_barrier_complete(unsigned* bar, unsigned x, unsigned& nloc, unsigned& nx) {
    const unsigned G = gridDim.x * gridDim.y * gridDim.z;
    unsigned sum, cnt, mine, sp = 0u;
    for (;;) {
        sum = 0u; cnt = 0u; mine = 0u;
#pragma unroll
        for (unsigned j = 0; j < 16; ++j) { const unsigned c = xb_ld(&bar[XB_XCNT(j)]); sum += c; cnt += (c > 0u) ? 1u : 0u; mine = (j == x) ? c : mine; }
        if (sum == G) break;
        __builtin_amdgcn_s_sleep(1);
        if ((++sp & 255u) == 0u) { if (xb_ld(&bar[XB_TMO])) break; if (sp > XB_SPIN_CAP) { atomicAdd(&bar[XB_TMO], 1u); break; } }
    }
    nloc = mine > 0u ? mine : 1u; nx = cnt > 0u ? cnt : 1u;
}

__device__ __forceinline__ void xcd_barrier(const XcdBarrier& b) {
    asm volatile("s_waitcnt vmcnt(0)" ::: "memory");
    __syncthreads();
    if (threadIdx.x == 0) {
        unsigned* bar = b.bar;
        __builtin_amdgcn_s_waitcnt(0);
        unsigned nloc = b.st[0], nx = b.st[1];
        if (nloc == 0u) { xcd_barrier_complete(bar, b.x, nloc, nx); b.st[0] = nloc; b.st[1] = nx; }
        const unsigned old = xb_add(&bar[XB_XSUB(b.x)], 1u);
        const unsigned gen = old / nloc;
        if (old + 1u == (gen + 1u) * nloc) {
            __builtin_amdgcn_fence(__ATOMIC_RELEASE, "agent");
            asm volatile("s_waitcnt vmcnt(0)" ::: "memory");
            const unsigned og = xb_add(&bar[XB_TOP], 1u);
            const unsigned tg = og / nx;
            if (og + 1u == (tg + 1u) * nx) xb_add(&bar[XB_TOPGEN], 1u);
            else XB_SPIN(xb_ld(&bar[XB_TOPGEN]) == tg, bar);
            __builtin_amdgcn_fence(__ATOMIC_ACQUIRE, "agent");
            xb_add(&bar[XB_XGEN(b.x)], 1u);
            asm volatile("s_waitcnt vmcnt(0)" ::: "memory");
        } else {
            XB_SPIN(xb_ld(&bar[XB_XGEN(b.x)]) == gen, bar);
            __builtin_amdgcn_fence(__ATOMIC_ACQUIRE, "agent");
            asm volatile("s_waitcnt vmcnt(0)" ::: "memory");
        }
    }
    __syncthreads();
}

__device__ __forceinline__ void cvt_item(const float* W, int ld, int K, int k0, int n0, u16* WT, int drow0, LAS float* scr, int lane) {
    float tv[32];
#pragma unroll
    for (int i = 0; i < 32; ++i) { const int kk = 2 * i + (lane >> 5); tv[i] = __builtin_nontemporal_load(W + (size_t)(k0 + kk) * ld + n0 + (lane & 31)); }
#pragma unroll
    for (int i = 0; i < 32; ++i) { const int kk = 2 * i + (lane >> 5); scr[kk * 33 + (lane & 31)] = tv[i]; }
    LDS_WAIT(); asm volatile("" ::: "memory");
    const int c = lane & 7;
#pragma unroll
    for (int j = 0; j < 4; ++j) { const int n = (lane >> 3) + 8 * j; const LAS float* s = scr + (8 * c) * 33 + n;
        u32x4 o; o.x = pk2(s[0 * 33], s[1 * 33]); o.y = pk2(s[2 * 33], s[3 * 33]); o.z = pk2(s[4 * 33], s[5 * 33]); o.w = pk2(s[6 * 33], s[7 * 33]);
        *(u32x4*)(WT + (size_t)(drow0 + n) * K + k0 + 8 * c) = o; }
    LDS_WAIT(); asm volatile("" ::: "memory");
}
__device__ __forceinline__ void cvt_job(const float* W, int ld, int K, int N, u16* WT, int mode, int r, LAS float* scr, int lane) {
    const int nblk = N / 32, kb = r / nblk, nb = r % nblk, n0 = nb * 32;
    const int drow0 = mode == 0 ? n0 : (n0 + (n0 >> 7) * 128 + (mode == 2 ? 128 : 0));
    cvt_item(W, ld, K, kb * 64, n0, WT, drow0, scr, lane);
}

__device__ __forceinline__ void cvt8_item(const float* W, int ld, int n0, unsigned char* WT, float* inv, int drow0, LAS float* t, int tid) {
    const int lane = tid & 63, wave = tid >> 6;
#pragma unroll
    for (int half = 0; half < 2; ++half) {
        float tv[32];
#pragma unroll
        for (int i = 0; i < 32; ++i) { const int kk = (half * 32 + i) * 16 + wave * 2 + (lane >> 5); tv[i] = __builtin_nontemporal_load(W + (size_t)kk * ld + n0 + (lane & 31)); }
#pragma unroll
        for (int i = 0; i < 32; ++i) { const int kk = (half * 32 + i) * 16 + wave * 2 + (lane >> 5); t[(lane & 31) * 1028 + kk] = tv[i]; }
    }
    __syncthreads();
#pragma unroll 1
    for (int r = 0; r < 4; ++r) { const int n = wave * 4 + r; const LAS float* row = t + n * 1028;
        f32x4 v[4]; float mx = 0.f;
#pragma unroll
        for (int j = 0; j < 4; ++j) { v[j] = *(const LAS f32x4*)(row + 256 * j + 4 * lane); mx = __builtin_fmaxf(mx, __builtin_fmaxf(__builtin_fmaxf(__builtin_fabsf(v[j][0]), __builtin_fabsf(v[j][1])), __builtin_fmaxf(__builtin_fabsf(v[j][2]), __builtin_fabsf(v[j][3])))); }
#pragma unroll
        for (int o = 1; o < 64; o <<= 1) mx = __builtin_fmaxf(mx, __shfl_xor(mx, o));
        const int e = (int)((__float_as_uint(mx) >> 23) & 0xffu) - 127;
        const bool ok = mx > 1e-30f && mx < 1e30f;
        const float sc = ok ? __uint_as_float((unsigned)(127 + 7 - e) << 23) : 1.f, isc = ok ? __uint_as_float((unsigned)(127 - 7 + e) << 23) : 1.f;
#pragma unroll
        for (int j = 0; j < 4; ++j) *(unsigned*)(WT + (size_t)(drow0 + n) * 1024 + 256 * j + 4 * lane) = pk4_fp8(v[j][0] * sc, v[j][1] * sc, v[j][2] * sc, v[j][3] * sc);
        if (lane == 0) inv[drow0 + n] = isc;
    }
    __syncthreads();
}

__device__ __forceinline__ void cvt8d_item(const float* W, int n0, unsigned char* WT, float* inv, LAS float* t, int tid) {
    const int lane = tid & 63, wave = tid >> 6;
    LAS float* red = t + 32 * 1028;
    float mx = 0.f;
    for (int i0 = 0; i0 < 224; i0 += 32) { float tv[32];
#pragma unroll
        for (int i = 0; i < 32; ++i) { const int kk = (i0 + i) * 16 + wave * 2 + (lane >> 5); tv[i] = W[(size_t)kk * 1024 + n0 + (lane & 31)]; }
#pragma unroll
        for (int i = 0; i < 32; ++i) mx = __builtin_fmaxf(mx, __builtin_fabsf(tv[i])); }
    mx = __builtin_fmaxf(mx, __shfl_xor(mx, 32));
    if (lane < 32) red[wave * 32 + lane] = mx;
    __syncthreads();
    if (tid < 32) { float m8 = 0.f;
#pragma unroll
        for (int w8 = 0; w8 < 8; ++w8) m8 = __builtin_fmaxf(m8, red[w8 * 32 + tid]);
        const int e = (int)((__float_as_uint(m8) >> 23) & 0xffu) - 127; const bool ok = m8 > 1e-30f && m8 < 1e30f;
        red[256 + tid] = ok ? __uint_as_float((unsigned)(127 + 7 - e) << 23) : 1.f; inv[n0 + tid] = ok ? __uint_as_float((unsigned)(127 - 7 + e) << 23) : 1.f; }
    __syncthreads();
#pragma unroll 1
    for (int k0 = 0; k0 < 3584; k0 += 1024) { const int nh = (k0 + 1024 <= 3584) ? 2 : 1;
        for (int half = 0; half < nh; ++half) { float tv[32];
#pragma unroll
            for (int i = 0; i < 32; ++i) { const int kk = (half * 32 + i) * 16 + wave * 2 + (lane >> 5); tv[i] = __builtin_nontemporal_load(W + (size_t)(k0 + kk) * 1024 + n0 + (lane & 31)); }
#pragma unroll
            for (int i = 0; i < 32; ++i) { const int kk = (half * 32 + i) * 16 + wave * 2 + (lane >> 5); t[(lane & 31) * 1028 + kk] = tv[i]; } }
        __syncthreads();
#pragma unroll 1
        for (int r = 0; r < 4; ++r) { const int n = wave * 4 + r; const LAS float* row = t + n * 1028; const float sc = red[256 + n];
#pragma unroll
            for (int j = 0; j < 4; ++j) if (j < 2 * nh) { const f32x4 v = *(const LAS f32x4*)(row + 256 * j + 4 * lane);
                *(unsigned*)(WT + (size_t)(n0 + n) * 3584 + k0 + 256 * j + 4 * lane) = pk4_fp8(v[0] * sc, v[1] * sc, v[2] * sc, v[3] * sc); } }
        __syncthreads();
    }
}


namespace lru {
typedef short bf16x8 __attribute__((ext_vector_type(8)));
typedef float f32x2 __attribute__((ext_vector_type(2)));
constexpr int AP = 272;
constexpr int L_AS = 0, L_BS = 256 * AP, L_GB = L_BS + 64 * AP, L_YS = L_GB + 256 * 64, L_WA = L_YS + 256 * 64, L_CW = L_WA + 8 * 32 * 8, L_END = L_CW + 5 * 128 * 4;
static_assert(L_END <= 131072, "LDS");
__device__ __forceinline__ float bfl(unsigned short v) { return __uint_as_float(((unsigned)v) << 16); }
__device__ __forceinline__ float gelu_fast(float x) { const float u2 = 1.5957691216057308f * (x + 0.044715f * x * x * x); return x - x * __builtin_amdgcn_rcpf(1.f + __expf(u2)); }
__device__ __forceinline__ void seg_apply(float& h, float A, float H) { h = __expf(A) * h + H; }
__device__ __forceinline__ void phase(LAS unsigned char* lds, int job, const float* cw, const float* cb, const u16* P2, u16* YL, const u16* WLG, const float* tab) {
    const int tid = threadIdx.x, lane = tid & 63, w = tid >> 6, l15 = lane & 15, g = lane >> 4;
    const int b = job / 40, n = (job % 40) >> 2, q = job & 3;
    const size_t row0 = (size_t)b * 4096;
    { const int r = tid >> 3, pc = tid & 7;
        const u16* src = WLG + ((size_t)n * 256 + (r < 32 ? 32 * q + r : 128 + 32 * q + (r - 32))) * 128 + pc * 16;
        const u32x4 v0 = *(const u32x4*)src, v1 = *(const u32x4*)(src + 8);
        *(LAS u32x4*)(lds + L_BS + r * AP + pc * 32) = v0; *(LAS u32x4*)(lds + L_BS + r * AP + pc * 32 + 16) = v1; }
    float ba[2], bx[2], sp[2];
#pragma unroll
    for (int chn = 0; chn < 2; ++chn) { const int c = 128 * n + 32 * q + 16 * chn + l15; ba[chn] = tab[c]; bx[chn] = tab[1280 + c]; sp[chn] = tab[2560 + c]; }
    u32x4 areg[11], gbreg[2];
    if (tid < 128) { LAS float* cwl = (LAS float*)(lds + L_CW); const int c = 128 * n + tid; cwl[tid] = cw[c]; cwl[128 + tid] = cw[1280 + c]; cwl[256 + tid] = cw[2560 + c]; cwl[384 + tid] = cw[3840 + c]; cwl[512 + tid] = cb[c]; }
    __syncthreads();
    const u16* aptr = P2 + (row0 + (tid >> 4) * 8) * 2560 + 1280 + 128 * n + (tid & 15) * 8;
    const u16* gptr = P2 + (row0 + (tid >> 2)) * 2560 + 128 * n + 32 * q + (tid & 3) * 8;
#define LRU_LOAD(t) do { _Pragma("unroll") for (int i = 0; i < 11; ++i) areg[i] = ((t) * 256 + (tid >> 4) * 8 + i >= 3) ? *(const u32x4*)(aptr + ((long)(t) * 256 + i - 3) * 2560) : (u32x4){0u, 0u, 0u, 0u}; \
        _Pragma("unroll") for (int i = 0; i < 2; ++i) gbreg[i] = *(const u32x4*)(gptr + ((size_t)(t) * 256 + 128 * i) * 2560); } while (0)
#define LRU_STASH() do { float cwr[4][8], cbr[8]; { const LAS float* cwl_ = (const LAS float*)(lds + L_CW) + (tid & 15) * 8; \
            _Pragma("unroll") for (int e_ = 0; e_ < 8; ++e_) { cwr[0][e_] = cwl_[e_]; cwr[1][e_] = cwl_[128 + e_]; cwr[2][e_] = cwl_[256 + e_]; cwr[3][e_] = cwl_[384 + e_]; cbr[e_] = cwl_[512 + e_]; } } \
        _Pragma("unroll") for (int i = 0; i < 8; ++i) { u32x4 o_; \
            _Pragma("unroll") for (int q_ = 0; q_ < 4; ++q_) { \
                const float lo_ = cbr[2 * q_] + cwr[0][2 * q_] * __uint_as_float(areg[i][q_] << 16) + cwr[1][2 * q_] * __uint_as_float(areg[i + 1][q_] << 16) + cwr[2][2 * q_] * __uint_as_float(areg[i + 2][q_] << 16) + cwr[3][2 * q_] * __uint_as_float(areg[i + 3][q_] << 16); \
                const float hi_ = cbr[2 * q_ + 1] + cwr[0][2 * q_ + 1] * __uint_as_float(areg[i][q_] & 0xffff0000u) + cwr[1][2 * q_ + 1] * __uint_as_float(areg[i + 1][q_] & 0xffff0000u) + cwr[2][2 * q_ + 1] * __uint_as_float(areg[i + 2][q_] & 0xffff0000u) + cwr[3][2 * q_ + 1] * __uint_as_float(areg[i + 3][q_] & 0xffff0000u); \
                o_[q_] = pk2(lo_, hi_); } \
            *(LAS u32x4*)(lds + L_AS + ((tid >> 4) * 8 + i) * AP + (tid & 15) * 16) = o_; } \
        _Pragma("unroll") for (int i = 0; i < 2; ++i) *(LAS u32x4*)(lds + L_GB + ((tid >> 2) + 128 * i) * 64 + (tid & 3) * 16) = gbreg[i]; } while (0)
    LRU_LOAD(0); LRU_STASH();
    __syncthreads();
    float hrun[2] = {0.f, 0.f};
    const int aoff = L_AS + (32 * w + l15) * AP + 16 * g, boff = L_BS + l15 * AP + 16 * g;
    for (int t = 0; t < 16; ++t) {
        if (t + 1 < 16) LRU_LOAD(t + 1);
        f32x4 acc[2][4];
#pragma unroll
        for (int m = 0; m < 2; ++m)
#pragma unroll
            for (int nn = 0; nn < 4; ++nn) acc[m][nn] = (f32x4){0.f, 0.f, 0.f, 0.f};
#pragma unroll
        for (int ks = 0; ks < 4; ++ks) {
            bf16x8 af[2], bfr[4];
#pragma unroll
            for (int m = 0; m < 2; ++m) af[m] = *(const LAS bf16x8*)(lds + aoff + 16 * m * AP + 64 * ks);
#pragma unroll
            for (int nn = 0; nn < 4; ++nn) bfr[nn] = *(const LAS bf16x8*)(lds + boff + 16 * nn * AP + 64 * ks);
#pragma unroll
            for (int m = 0; m < 2; ++m)
#pragma unroll
                for (int nn = 0; nn < 4; ++nn) acc[m][nn] = __builtin_amdgcn_mfma_f32_16x16x32_bf16(af[m], bfr[nn], acc[m][nn], 0, 0, 0);
        }
        float E[2][2][4], hl[2][2][4];
#pragma unroll
        for (int chn = 0; chn < 2; ++chn)
#pragma unroll
            for (int m = 0; m < 2; ++m) { float pe = 1.f, hh = 0.f;
#pragma unroll
                for (int r = 0; r < 4; ++r) { const int rt = 32 * w + 16 * m + 4 * g + r;
                    const float cv = bfl(*(const LAS unsigned short*)(lds + L_AS + rt * AP + (32 * q + 16 * chn + l15) * 2));
                    const float la = sp[chn] * __builtin_amdgcn_rcpf(1.f + __expf(-(acc[m][chn][r] + ba[chn])));
                    const float ig = __builtin_amdgcn_rcpf(1.f + __expf(-(acc[m][chn + 2][r] + bx[chn])));
                    const float av = __expf(la), t2 = 2.f * la;
                    const float om = t2 > -0.02f ? -t2 * (1.f + t2 * (0.5f + t2 * (0.16666667f + t2 * 0.041666667f))) : 1.f - av * av;
                    const float xi = __builtin_amdgcn_sqrtf(om) * (ig * cv);
                    pe *= av; hh = av * hh + xi; E[chn][m][r] = pe; hl[chn][m][r] = hh; } }
        float gE[2][2][4], gH[2][2][4];
#pragma unroll
        for (int chn = 0; chn < 2; ++chn)
#pragma unroll
            for (int m = 0; m < 2; ++m)
#pragma unroll
                for (int gg = 0; gg < 4; ++gg) { gE[chn][m][gg] = __shfl(E[chn][m][3], l15 + 16 * gg); gH[chn][m][gg] = __shfl(hl[chn][m][3], l15 + 16 * gg); }
        if (g == 0) {
#pragma unroll
            for (int chn = 0; chn < 2; ++chn) { float Ew = 1.f, Hw = 0.f;
#pragma unroll
                for (int m = 0; m < 2; ++m)
#pragma unroll
                    for (int gg = 0; gg < 4; ++gg) { Hw = gE[chn][m][gg] * Hw + gH[chn][m][gg]; Ew *= gE[chn][m][gg]; }
                *(LAS f32x2*)(lds + L_WA + (w * 32 + 16 * chn + l15) * 8) = (f32x2){Ew, Hw}; }
        }
        __syncthreads();
#pragma unroll
        for (int chn = 0; chn < 2; ++chn) {
            float hw = hrun[chn], hall = hrun[chn];
#pragma unroll
            for (int ww = 0; ww < 8; ++ww) { const f32x2 sg = *(const LAS f32x2*)(lds + L_WA + (ww * 32 + 16 * chn + l15) * 8); hall = sg[0] * hall + sg[1]; if (ww < w) hw = hall; }
            hrun[chn] = hall;
            float h0 = hw;
#pragma unroll
            for (int gg = 0; gg < 3; ++gg) if (gg < g) h0 = gE[chn][0][gg] * h0 + gH[chn][0][gg];
            float h1 = hw;
#pragma unroll
            for (int gg = 0; gg < 4; ++gg) h1 = gE[chn][0][gg] * h1 + gH[chn][0][gg];
#pragma unroll
            for (int gg = 0; gg < 3; ++gg) if (gg < g) h1 = gE[chn][1][gg] * h1 + gH[chn][1][gg];
#pragma unroll
            for (int m = 0; m < 2; ++m)
#pragma unroll
                for (int r = 0; r < 4; ++r) { const int rt = 32 * w + 16 * m + 4 * g + r; const int cc = 16 * chn + l15;
                    const float h = E[chn][m][r] * (m == 0 ? h0 : h1) + hl[chn][m][r];
                    const float gb = bfl(*(const LAS unsigned short*)(lds + L_GB + rt * 64 + cc * 2));
                    *(LAS unsigned short*)(lds + L_YS + rt * 64 + cc * 2) = f2bf(gelu_fast(gb) * h); }
        }
        __syncthreads();
#pragma unroll
        for (int i = 0; i < 2; ++i) { const int rr = (tid >> 2) + 128 * i; const u32x4 v = *(const LAS u32x4*)(lds + L_YS + rr * 64 + (tid & 3) * 16);
            *(u32x4*)(YL + (row0 + (size_t)t * 256 + rr) * 1280 + 128 * n + 32 * q + (tid & 3) * 8) = v; }
        if (t + 1 < 16) LRU_STASH();
        __syncthreads();
    }
#undef LRU_LOAD
#undef LRU_STASH
}
}

struct Args { const float* in[25]; float* out; char* ws; int ph_lo, ph_hi, li, pad; };

#define PHASE_VARS char* ws = a.ws; \
    const float* x = a.in[0]; const float* norm_g = a.in[4]; float* mod = (float*)(ws + WS_MOD); const float* mod0 = mod; const float* mod1 = mod + 4 * MODW; \
    float* rope = (float*)(ws + WS_ROPE); float* logf = (float*)(ws + WS_LOGF); float* kbias = (float*)(ws + WS_KBIAS); float* agg = (float*)(ws + WS_AGG); \
    int* ltw = (int*)(ws + WS_LTW); float* lg = (float*)(ws + WS_LG); int* cnt = (int*)(ws + WS_CTL) + CW_CNT; float* ksum = (float*)(ws + WS_CTL) + CW_KSUM; \
    u16* HA = (u16*)(ws + WS_HA); float* Y = (float*)(ws + WS_Y); float* out = a.out; \
    (void)x; (void)norm_g; (void)mod0; (void)mod1; (void)rope; (void)logf; (void)kbias; (void)agg; (void)ltw; (void)lg; (void)cnt; (void)ksum; (void)HA; (void)Y; (void)out;

__device__ __forceinline__ void conv_drain(const float* wg, const float* wu, const float* wd, char* ws, LAS unsigned char* lds, int ng, int nd) {
    const int tid = threadIdx.x; volatile LAS int* qs_ = (volatile LAS int*)(lds + CTRL_OFF + 64);
    for (int n_ = 0; n_ < nd; ++n_) { __syncthreads(); if (tid == 0) qs_[0] = atomicAdd((int*)(ws + WS_CTL) + CW_CQD, 1); __syncthreads(); const int it_ = qs_[0]; if (it_ >= 8 * 32) break;
        { const int e_ = it_ >> 5, n0_ = (it_ & 31) * 32; cvt8d_item(wd + (size_t)e_ * DEXP * D, n0_, (unsigned char*)(ws + WS_WMDN) + (size_t)e_ * 1024 * 3584, (float*)(ws + WS_SBD) + (size_t)e_ * 1024, (LAS float*)lds, tid); } }
    for (int n_ = 0; n_ < ng; ++n_) { __syncthreads(); if (tid == 0) qs_[0] = atomicAdd((int*)(ws + WS_CTL) + CW_CQG, 1); __syncthreads(); const int it_ = qs_[0]; if (it_ >= 16 * 112) break;
        { const int j_ = it_ / 112, nb_ = it_ % 112, e_ = j_ >> 1, which_ = j_ & 1, n0_ = nb_ * 32;
          cvt8_item((which_ ? wu : wg) + (size_t)e_ * D * DEXP, DEXP, n0_, (unsigned char*)(ws + WS_WMGU) + (size_t)e_ * 7168 * 1024, (float*)(ws + WS_SB) + (size_t)e_ * 7168, n0_ + (n0_ >> 7) * 128 + which_ * 128, (LAS float*)lds, tid); } }
}
#define CONV_DRAIN(NG, ND) conv_drain(a.in[22], a.in[23], a.in[24], ws, lds, (NG), (ND))
__global__ void __launch_bounds__(NWAVES * 64, 2) mega(Args a) {
    extern __shared__ __attribute__((aligned(16))) unsigned char lds_raw[];
    LAS unsigned char* lds = (LAS unsigned char*)lds_raw;
    volatile LAS unsigned* MISC = (volatile LAS unsigned*)(lds + MISC_OFF);
    const int tid = threadIdx.x, lane = tid & 63, wave = __builtin_amdgcn_readfirstlane(tid >> 6);
    const int G = gridDim.x, bid = blockIdx.x;
    unsigned* ctl = (unsigned*)(a.ws + WS_CTL);
    for (int u = tid; u < (LDS_BYTES - CTRL_OFF) / 4; u += NWAVES * 64) ((LAS unsigned*)(lds + CTRL_OFF))[u] = 0u;
    __syncthreads();
    const int lo = a.ph_lo, hi = a.ph_hi;
    const bool multi = (hi - lo) > 1;
    XcdBarrier bar; bar.bar = ctl + CW_BAR + a.li * XCD_BAR_WORDS; bar.x = 0; bar.st = nullptr;
    if (multi) bar = xcd_barrier_post(ctl + CW_BAR + a.li * XCD_BAR_WORDS, MISC + 8);
#ifndef PHMASK
#define PHMASK 0x7ffff
#endif
#define IN(k) ((((PHMASK) >> (k)) & 1) && lo <= (k) && (k) < hi)
#define SEAM(k) do { if (IN(k) && IN((k) + 1)) xcd_barrier(bar); } while (0)
#ifndef REPEAT_MASK
#define REPEAT_MASK 0
#endif
#define NREP(k) ((((REPEAT_MASK) >> (k)) & 1) ? 2 : 1)
    const int gw = bid * NWAVES + wave, NGW = G * NWAVES;

    if (IN(0)) { PHASE_VARS
        {
            LAS float* scs = (LAS float*)lds; LAS float* part = (LAS float*)(lds + 16384);
            const float* c = a.in[1];
            for (int i = tid; i < NB * D; i += NWAVES * 64) { const float v = c[i]; scs[i] = v / (1.f + __expf(-v)); }
            __syncthreads();
            const int n = bid * 48 + (lane < 48 ? lane : 47), l = n / MODW, nn = n % MODW;
            const float* w = a.in[2] + (size_t)l * D * MODW + nn + (size_t)(wave * 128) * MODW;
            float a0 = 0.f, a1 = 0.f, a2 = 0.f, a3 = 0.f;
            for (int k0 = 0; k0 < 128; k0 += 32) { float wv[32];
#pragma unroll
                for (int k = 0; k < 32; ++k) wv[k] = __builtin_nontemporal_load(w + (size_t)(k0 + k) * MODW);
#pragma unroll
                for (int k = 0; k < 32; ++k) { const int kk = wave * 128 + k0 + k; a0 += scs[kk] * wv[k]; a1 += scs[D + kk] * wv[k]; a2 += scs[2 * D + kk] * wv[k]; a3 += scs[3 * D + kk] * wv[k]; } }
            part[(wave * 64 + lane) * 4 + 0] = a0; part[(wave * 64 + lane) * 4 + 1] = a1; part[(wave * 64 + lane) * 4 + 2] = a2; part[(wave * 64 + lane) * 4 + 3] = a3;
            __syncthreads();
            if (tid < 192) { const int col = tid >> 2, b = tid & 3; float s = 0.f;
#pragma unroll
                for (int w8 = 0; w8 < 8; ++w8) s += part[(w8 * 64 + col) * 4 + b];
                const int n2 = bid * 48 + col, l2 = n2 / MODW, nn2 = n2 % MODW;
                mod[(l2 * 4 + b) * MODW + nn2] = s + a.in[3][l2 * MODW + nn2]; }
            __syncthreads();
        }
        if (gw < 512) { const int i = gw * 64 + lane; const int pos = i >> 3, f = i & 7;
            const float inv = exp2f(-(float)f * 0.125f * 18.931568569324174f); const float ang = (float)pos * inv; float sn, cs; sincosf(ang, &sn, &cs);
            rope[2 * i] = cs; rope[2 * i + 1] = sn; }
        if (bid == 255) { for (int c = tid; c < DRNN; c += NWAVES * 64) { float* tb = (float*)(ws + WS_SP8); tb[c] = a.in[15][c]; tb[1280 + c] = a.in[17][c]; tb[2560 + c] = -8.f * log1pf(__expf(-a.in[18][c])); } }
        {
            LAS float* scr = (LAS float*)(lds + wave * 16384);
            constexpr int I_AIN = 16 * 96, I_AOUT = 16 * 32, I_FG = 16 * 88, I_FD = 44 * 32, I_LIN = 16 * 80, I_LOUT = 20 * 32, I_LG = 2 * 4, I_MG = 16 * 112, I_MD = 56 * 32;
            int cum = 0;
#define CVT_LOOP(NIT, CALL) do { for (int r = (gw + NGW - (cum % NGW)) % NGW; r < (NIT); r += NGW) { CALL; } cum += (NIT); } while (0)
            CVT_LOOP(I_AIN, cvt_job(a.in[5], NIN, D, 3072, (u16*)(ws + WS_WAIN), 0, r, scr, lane));
            CVT_LOOP(I_AOUT, cvt_job(a.in[7], D, D, D, (u16*)(ws + WS_WAOUT), 0, r, scr, lane));
            CVT_LOOP(I_FG, cvt_job(a.in[8], DFF, D, DFF, (u16*)(ws + WS_WFGU), 1, r, scr, lane));
            CVT_LOOP(I_FG, cvt_job(a.in[9], DFF, D, DFF, (u16*)(ws + WS_WFGU), 2, r, scr, lane));
            CVT_LOOP(I_FD, cvt_job(a.in[10], D, DFF, D, (u16*)(ws + WS_WFDN), 0, r, scr, lane));
            CVT_LOOP(I_LIN, cvt_job(a.in[11], 2560, D, 2560, (u16*)(ws + WS_WLIN), 0, r, scr, lane));
            CVT_LOOP(I_LOUT, cvt_job(a.in[19], D, DRNN, D, (u16*)(ws + WS_WLOUT), 0, r, scr, lane));
            CVT_LOOP(10 * I_LG, cvt_job(a.in[14] + (size_t)(r / I_LG) * 16384, 128, 128, 128, (u16*)(ws + WS_WLG) + (size_t)(r / I_LG) * 256 * 128, 0, r % I_LG, scr, lane));
            CVT_LOOP(10 * I_LG, cvt_job(a.in[16] + (size_t)(r / I_LG) * 16384, 128, 128, 128, (u16*)(ws + WS_WLG) + (size_t)(r / I_LG) * 256 * 128 + 128 * 128, 0, r % I_LG, scr, lane));
#undef CVT_LOOP
            __syncthreads();
        }
    }
    SEAM(0);
    _Pragma("unroll") for (int rep_ = 0; rep_ < NREP(1); ++rep_) { if (rep_) xcd_barrier(bar);
    if (IN(1)) { PHASE_VARS RowP p{}; p.xres = x; p.y_mode = 0; p.g_pre = norm_g + 0 * D; p.sh = mod0 + 0 * D; p.sc = mod0 + 1 * D; p.hout = HA;
        p.extra = 1; p.wex = a.in[5]; p.wex_ld = NIN; p.wex_off = 3072; p.bex = a.in[6]; p.logf = logf; row_pass(p, bid, G, (LAS float*)lds); }
    }
    SEAM(1);
    _Pragma("unroll") for (int rep_ = 0; rep_ < NREP(2); ++rep_) { if (rep_) xcd_barrier(bar);
    if (IN(2)) { PHASE_VARS
        if (bid < 32) { LAS float* tot = (LAS float*)(lds + CTRL_OFF + 1024);
            const float* src = logf + (size_t)bid * S + tid * 8; float v[8]; float s = 0.f;
#pragma unroll
            for (int i = 0; i < 8; ++i) { s += src[i]; v[i] = s; }
            float inc = s;
#pragma unroll
            for (int o = 1; o < 64; o <<= 1) { const float up = __shfl_up(inc, o); if (lane >= o) inc += up; }
            if (lane == 63) tot[wave] = inc;
            __syncthreads();
            float base = inc - s;
#pragma unroll
            for (int w8 = 0; w8 < 8; ++w8) if (w8 < wave) base += tot[w8];
#pragma unroll
            for (int i = 0; i < 8; ++i) kbias[(size_t)bid * S + tid * 8 + i] = -(base + v[i]) * LOG2E;
            __syncthreads(); }
        pg8::DenseOrder So; So.init(HA, D, ws + WS_WAIN, M, 3072, D, G, bid);
        pg8::EpiQKV E{(u16*)(ws + WS_Q), (u16*)(ws + WS_K), (u16*)(ws + WS_V), rope, ksum, (unsigned*)(ws + WS_CTL) + CW_KN2};
        pg8::gemm_phase<pg8::EpiQKV, pg8::DenseOrder, false, true>(lds, D, D, So, E);
    }
    }
    SEAM(2);
    _Pragma("unroll") for (int rep_ = 0; rep_ < NREP(3); ++rep_) { if (rep_) xcd_barrier(bar);
    if (IN(3)) { PHASE_VARS
        const attn_body::AttnTensors AT{(const attn_body::bf16*)(ws + WS_Q), (const attn_body::bf16*)(ws + WS_K), (const attn_body::bf16*)(ws + WS_V), (attn_body::bf16*)(ws + WS_O)};
        attn_body::attn_phase<8>((char*)lds_raw, AT, ksum, kbias, (const unsigned*)(ws + WS_CTL) + CW_KN2, (int*)(ws + WS_CTL) + CW_AQ, (volatile LAS int*)(lds + CTRL_OFF + 64)); }
    }
    SEAM(3);
    _Pragma("unroll") for (int rep_ = 0; rep_ < NREP(4); ++rep_) { if (rep_) xcd_barrier(bar);
    if (IN(4)) { PHASE_VARS pg8::DenseOrder So; So.init(ws + WS_O, D, ws + WS_WAOUT, M, D, D, G, bid); pg8::EpiBf16 E{(u16*)Y, D};
        pg8::gemm_phase<pg8::EpiBf16, pg8::DenseOrder, false, false>(lds, D, D, So, E); }
    }
    SEAM(4);
    _Pragma("unroll") for (int rep_ = 0; rep_ < NREP(5); ++rep_) { if (rep_) xcd_barrier(bar);
    if (IN(5)) { PHASE_VARS RowP p{}; p.xres = x; p.y = Y; p.y_mode = 1; p.g_post = norm_g + 1 * D; p.gate = mod0 + 2 * D; p.xout = out;
        p.g_pre = norm_g + 2 * D; p.sh = mod0 + 3 * D; p.sc = mod0 + 4 * D; p.hout = HA; row_pass(p, bid, G, (LAS float*)lds); }
    }
    SEAM(5);
    _Pragma("unroll") for (int rep_ = 0; rep_ < NREP(6); ++rep_) { if (rep_) xcd_barrier(bar);
    if (IN(6)) { PHASE_VARS pg8::DenseOrder So; So.init(HA, D, ws + WS_WFGU, M, 2 * DFF, D, G, bid); pg8::EpiSwiglu E{(u16*)(ws + WS_HM), DFF};
        pg8::gemm_phase<pg8::EpiSwiglu, pg8::DenseOrder, false, true>(lds, D, D, So, E);
        if (bid >= 1408 - 5 * G) CONV_DRAIN(2, 0); }
    }
    SEAM(6);
    _Pragma("unroll") for (int rep_ = 0; rep_ < NREP(7); ++rep_) { if (rep_) xcd_barrier(bar);
    if (IN(7)) { PHASE_VARS pg8::DenseOrder So; So.init(ws + WS_HM, DFF, ws + WS_WFDN, M, D, DFF, G, bid); pg8::EpiBf16 E{(u16*)Y, D};
        pg8::gemm_phase<pg8::EpiBf16, pg8::DenseOrder, false, false>(lds, DFF, DFF, So, E); }
    }
    SEAM(7);
    if (IN(8)) { PHASE_VARS RowP p{}; p.xres = out; p.y = Y; p.y_mode = 1; p.g_post = norm_g + 3 * D; p.gate = mod0 + 5 * D; p.xout = out;
        p.g_pre = norm_g + 4 * D; p.sh = mod1 + 0 * D; p.sc = mod1 + 1 * D; p.hout = HA; row_pass(p, bid, G, (LAS float*)lds); }
    SEAM(8);
    _Pragma("unroll") for (int rep_ = 0; rep_ < NREP(9); ++rep_) { if (rep_) xcd_barrier(bar);
    if (IN(9)) { PHASE_VARS pg8::DenseOrder So; So.init(HA, D, ws + WS_WLIN, M, 2560, D, G, bid); pg8::EpiBf16 E{(u16*)(ws + WS_P2), 2560};
        pg8::gemm_phase<pg8::EpiBf16, pg8::DenseOrder, false, true>(lds, D, D, So, E);
        if (bid >= 640 - 2 * G) CONV_DRAIN(3, 0); }
    }
    SEAM(9);
    _Pragma("unroll") for (int rep_ = 0; rep_ < NREP(11); ++rep_) { if (rep_) xcd_barrier(bar);
    if (IN(11)) { PHASE_VARS
        if (bid < 160) lru::phase(lds, bid, a.in[12], a.in[13], (const u16*)(ws + WS_P2), (u16*)(ws + WS_YL), (const u16*)(ws + WS_WLG), (const float*)(ws + WS_SP8));
        else CONV_DRAIN(0, 3);
    }
    }
    SEAM(11);
    _Pragma("unroll") for (int rep_ = 0; rep_ < NREP(14); ++rep_) { if (rep_) xcd_barrier(bar);
    if (IN(14)) { PHASE_VARS pg8::DenseOrder So; So.init(ws + WS_YL, DRNN, ws + WS_WLOUT, M, D, DRNN, G, bid); pg8::EpiBf16 E{(u16*)Y, D};
        pg8::gemm_phase<pg8::EpiBf16, pg8::DenseOrder, false, false>(lds, DRNN, DRNN, So, E); }
    }
    SEAM(14);
    if (IN(15)) { PHASE_VARS RowP p{}; p.xres = out; p.y = Y; p.y_mode = 1; p.g_post = norm_g + 5 * D; p.gate = mod1 + 2 * D; p.xout = out;
        p.g_pre = norm_g + 6 * D; p.sh = mod1 + 3 * D; p.sc = mod1 + 4 * D; p.hout = HA;
        p.h8 = (unsigned char*)HA;
        p.extra = 2; p.wex = a.in[20]; p.wex_ld = 8; p.wex_off = 0; p.bex = a.in[21]; p.cnt = cnt; p.list_tw = ltw; p.list_g = lg; row_pass(p, bid, G, (LAS float*)lds);
        CONV_DRAIN(1 << 20, 1 << 20); }
    SEAM(15);
    _Pragma("unroll") for (int rep_ = 0; rep_ < NREP(16); ++rep_) { if (rep_) xcd_barrier(bar);
    if (IN(16)) { PHASE_VARS pg8::MoeOrder So; So.init(cnt, HA, ws + WS_WMGU, (size_t)7168 * 1024, 2 * DEXP, D / 2, G, bid, ltw, 1); pg8::EpiSwiglu8 E{(unsigned char*)(ws + WS_HMID), DEXP, (const float*)(ws + WS_SB)};
        pg8::gemm_phase<pg8::EpiSwiglu8, pg8::MoeOrder, true, true, true>(lds, D / 2, D / 2, So, E); }
    }
    SEAM(16);
    _Pragma("unroll") for (int rep_ = 0; rep_ < NREP(17); ++rep_) { if (rep_) xcd_barrier(bar);
    if (IN(17)) { PHASE_VARS pg8::MoeOrder So; So.init(cnt, ws + WS_HMID, ws + WS_WMDN, (size_t)1024 * 3584, D, DEXP / 2, G, bid, ltw, 0); pg8::EpiMoeDown E{(u16*)(ws + WS_YBUF), ltw, lg, (const float*)(ws + WS_SBD)};
        pg8::gemm_phase<pg8::EpiMoeDown, pg8::MoeOrder, false, true, true>(lds, DEXP / 2, DEXP / 2, So, E); }
    }
    SEAM(17);
    if (IN(18)) { PHASE_VARS RowP p{}; p.xres = out; p.y = (const float*)(ws + WS_YBUF); p.y_mode = 2; p.g_post = norm_g + 7 * D; p.gate = mod1 + 5 * D; p.xout = out; row_pass(p, bid, G, (LAS float*)lds); }
#undef IN
#undef SEAM
}

extern "C" void kernel_launch(void* const* d_in, const int* in_sizes, int n_in, void* d_out, int out_size, void* d_ws, size_t ws_size, hipStream_t stream) {
    static int grid = 0;
    if (grid == 0) {
        if (n_in != 25 || out_size != M * D || ws_size < WS_END) { fprintf(stderr, "kernel_launch: unexpected sizes (n_in %d out %d ws %zu)\n", n_in, out_size, ws_size); grid = -1; return; }
        int dev = 0, cus = 0;
        if (hipGetDevice(&dev) != hipSuccess || hipDeviceGetAttribute(&cus, hipDeviceAttributeMultiprocessorCount, dev) != hipSuccess) { grid = -1; return; }
        if (hipFuncSetAttribute((const void*)mega, hipFuncAttributeMaxDynamicSharedMemorySize, LDS_BYTES) != hipSuccess) { fprintf(stderr, "kernel_launch: hipFuncSetAttribute failed\n"); grid = -1; return; }
        (void)hipGetLastError();
        grid = cus;
    }
    if (grid < 0) return;
    char* ws = (char*)d_ws;
    (void)hipMemsetAsync(ws + WS_CTL, 0, 1 * MiB, stream);
    Args a{};
    for (int i = 0; i < 25; ++i) a.in[i] = (const float*)d_in[i];
    a.out = (float*)d_out; a.ws = ws;
#if defined(MK_PER_PHASE)
    for (int ph = 0; ph <= 18; ++ph) { a.ph_lo = ph; a.ph_hi = ph + 1; hipLaunchKernelGGL(mega, dim3(grid), dim3(NWAVES * 64), LDS_BYTES, stream, a); }
#else
    a.ph_lo = 0; a.ph_hi = 19;
    hipLaunchKernelGGL(mega, dim3(grid), dim3(NWAVES * 64), LDS_BYTES, stream, a);
#if defined(PROBE_PH)
    a.ph_lo = PROBE_PH; a.ph_hi = PROBE_PH + PROBE_N; a.li = 1;
    hipLaunchKernelGGL(mega, dim3(grid), dim3(NWAVES * 64), LDS_BYTES, stream, a);
#endif
#endif
}
```

```cpp
#include <hip/hip_runtime.h>
#include <cstdint>
#include <cstdio>
#include <cmath>

typedef unsigned short u16;
typedef float f32x4 __attribute__((ext_vector_type(4)));
typedef unsigned u32x4 __attribute__((ext_vector_type(4)));
typedef unsigned u32x2 __attribute__((ext_vector_type(2)));

constexpr int D = 1024, NB = 4, S = 4096, M = NB * S;
constexpr int NIN = 3080;
constexpr int DFF = 2816, DRNN = 1280, NE = 8, DEXP = 3584;
constexpr int MODW = 6 * D;
constexpr float EPS = 1e-6f;
constexpr float LOG2E = 1.4426950408889634f;
constexpr float C2 = 0.125f * LOG2E;

__device__ __forceinline__ u16 f2bf(float f) { unsigned u = __float_as_uint(f); return (u16)((u + 0x7fffu + ((u >> 16) & 1u)) >> 16); }
__device__ __forceinline__ float bf2f(u16 h) { return __uint_as_float(((unsigned)h) << 16); }
__device__ __forceinline__ unsigned pk2(float lo, float hi) { return (unsigned)f2bf(lo) | ((unsigned)f2bf(hi) << 16); }
__device__ __forceinline__ unsigned pk4_fp8(float a, float b, float c, float d) {
    a = __builtin_amdgcn_fmed3f(a, -448.f, 448.f); b = __builtin_amdgcn_fmed3f(b, -448.f, 448.f); c = __builtin_amdgcn_fmed3f(c, -448.f, 448.f); d = __builtin_amdgcn_fmed3f(d, -448.f, 448.f);
    unsigned w = 0u; w = __builtin_amdgcn_cvt_pk_fp8_f32(a, b, w, false); w = __builtin_amdgcn_cvt_pk_fp8_f32(c, d, w, true); return w; }
__device__ __forceinline__ float wave_sum(float v) {
#pragma unroll
    for (int o = 1; o < 64; o <<= 1) v += __shfl_xor(v, o);
    return v;
}
__device__ __forceinline__ float sigmoidf_(float x) { return 1.f / (1.f + __expf(-x)); }

struct RowP {
    const float* xres; const float* y; const float* g_post; const float* gate; float* xout;
    const float* g_pre; const float* sc; const float* sh; u16* hout;
    const float* wex; const float* bex;
    float* logf; int* cnt; int* list_tw; float* list_g; unsigned char* h8;
    int y_mode; int extra; int wex_ld; int wex_off;
};
__device__ __forceinline__ void row_pass(const RowP& p, int blk, int nblk, __attribute__((address_space(3))) float* wl) {
    const int lane = threadIdx.x & 63, wave = threadIdx.x >> 6, nw = blockDim.x >> 6;
    if (p.extra) {
        for (int idx = threadIdx.x; idx < 8 * D; idx += blockDim.x) { const int k = idx >> 3, o = idx & 7; wl[o * D + k] = p.wex[(size_t)k * p.wex_ld + p.wex_off + o]; }
        __syncthreads();
    }
    int nrec = wave;
    if (p.extra == 2) { if (threadIdx.x < 16) ((__attribute__((address_space(3))) int*)(wl + 8 * D))[threadIdx.x] = 0; __syncthreads(); }
    for (int m = blk * nw + wave; m < M; m += nblk * nw) {
        const int b = m / S, t = m % S;
        f32x4 xv[4];
#pragma unroll
        for (int j = 0; j < 4; ++j) xv[j] = __builtin_nontemporal_load((const f32x4*)(p.xres + (size_t)m * D + 256 * j + 4 * lane));
        if (p.y_mode) {
            f32x4 yv[4]; float ss = 0.f;
#pragma unroll
            for (int j = 0; j < 4; ++j) {
                if (p.y_mode == 1) { const u32x2 p0 = __builtin_nontemporal_load((const u32x2*)((const u16*)p.y + (size_t)m * D + 256 * j + 4 * lane));
                    yv[j] = (f32x4){__uint_as_float(p0.x << 16), __uint_as_float(p0.x & 0xffff0000u), __uint_as_float(p0.y << 16), __uint_as_float(p0.y & 0xffff0000u)}; }
                else { const u16* yb = (const u16*)p.y + (size_t)m * 2 * D + 256 * j + 4 * lane; const u32x2 p0 = __builtin_nontemporal_load((const u32x2*)yb), p1 = __builtin_nontemporal_load((const u32x2*)(yb + D));
                    yv[j] = (f32x4){__uint_as_float(p0.x << 16) + __uint_as_float(p1.x << 16), __uint_as_float(p0.x & 0xffff0000u) + __uint_as_float(p1.x & 0xffff0000u),
                                    __uint_as_float(p0.y << 16) + __uint_as_float(p1.y << 16), __uint_as_float(p0.y & 0xffff0000u) + __uint_as_float(p1.y & 0xffff0000u)}; }
                ss += yv[j].x * yv[j].x + yv[j].y * yv[j].y + yv[j].z * yv[j].z + yv[j].w * yv[j].w;
            }
            const float rstd = rsqrtf(wave_sum(ss) * (1.f / D) + EPS);
#pragma unroll
            for (int j = 0; j < 4; ++j) {
                const f32x4 g = *(const f32x4*)(p.g_post + 256 * j + 4 * lane), ga = *(const f32x4*)(p.gate + (size_t)b * MODW + 256 * j + 4 * lane);
                xv[j] = xv[j] + ga * (yv[j] * rstd * g);
            }
        }
        if (p.xout) {
#pragma unroll
            for (int j = 0; j < 4; ++j) __builtin_nontemporal_store(xv[j], (f32x4*)(p.xout + (size_t)m * D + 256 * j + 4 * lane));
        }
        if (p.g_pre) {
            float ss = 0.f;
#pragma unroll
            for (int j = 0; j < 4; ++j) ss += xv[j].x * xv[j].x + xv[j].y * xv[j].y + xv[j].z * xv[j].z + xv[j].w * xv[j].w;
            const float rstd = rsqrtf(wave_sum(ss) * (1.f / D) + EPS);
            f32x4 hv[4];
#pragma unroll
            for (int j = 0; j < 4; ++j) {
                const f32x4 g = *(const f32x4*)(p.g_pre + 256 * j + 4 * lane), s1 = *(const f32x4*)(p.sc + (size_t)b * MODW + 256 * j + 4 * lane), s0 = *(const f32x4*)(p.sh + (size_t)b * MODW + 256 * j + 4 * lane);
                hv[j] = xv[j] * rstd * g * (s1 + 1.0f) + s0;
                if (p.h8) __builtin_nontemporal_store(pk4_fp8(hv[j].x, hv[j].y, hv[j].z, hv[j].w), (unsigned*)(p.h8 + (size_t)m * D + 256 * j + 4 * lane));
                else { u32x2 w; w.x = pk2(hv[j].x, hv[j].y); w.y = pk2(hv[j].z, hv[j].w); __builtin_nontemporal_store(w, (u32x2*)(p.hout + (size_t)m * D + 256 * j + 4 * lane)); }
            }
            if (p.extra) {
                float dt[8];
#pragma unroll
                for (int o = 0; o < 8; ++o) dt[o] = 0.f;
#pragma unroll
                for (int j = 0; j < 4; ++j)
#pragma unroll
                    for (int o = 0; o < 8; ++o) { const f32x4 w4 = *(const __attribute__((address_space(3))) f32x4*)(wl + o * D + 256 * j + 4 * lane);
                        dt[o] += hv[j][0] * w4[0] + hv[j][1] * w4[1] + hv[j][2] * w4[2] + hv[j][3] * w4[3]; }
#pragma unroll
                for (int o = 0; o < 8; ++o) dt[o] = wave_sum(dt[o]) + p.bex[o];
                if (p.extra == 1) {
                    if (lane < 8) {
                        float xl = dt[0];
#pragma unroll
                        for (int o = 1; o < 8; ++o) xl = (lane == o) ? dt[o] : xl;
                        const float ls = xl > 0.f ? -log1pf(__expf(-xl)) : xl - log1pf(__expf(xl));
                        p.logf[((size_t)b * 8 + lane) * S + t] = ls;
                    }
                } else if (lane == 0) {
                    float v1 = -INFINITY, v2 = -INFINITY; int i1 = 0, i2 = 0;
#pragma unroll
                    for (int o = 0; o < 8; ++o) { const float g = dt[o]; if (g > v1) { v2 = v1; i2 = i1; v1 = g; i1 = o; } else if (g > v2) { v2 = g; i2 = o; } }
                    const float g1 = 1.f / (1.f + __expf(v2 - v1)), g2 = 1.f - g1;
                    __attribute__((address_space(3))) int* lc = (__attribute__((address_space(3))) int*)(wl + 8 * D); __attribute__((address_space(3))) float* rec = wl + 8 * D + 16 + nrec * 8;
                    const int lp1 = __hip_atomic_fetch_add(lc + i1, 1, __ATOMIC_RELAXED, __HIP_MEMORY_SCOPE_WORKGROUP), lp2 = __hip_atomic_fetch_add(lc + i2, 1, __ATOMIC_RELAXED, __HIP_MEMORY_SCOPE_WORKGROUP);
                    rec[0] = __int_as_float(m); rec[1] = __int_as_float(i1 | (i2 << 8)); rec[2] = g1; rec[3] = g2; rec[4] = __int_as_float(lp1); rec[5] = __int_as_float(lp2);
                }
                nrec += 8;
            }
        }
    }
    if (p.extra == 2) {
        __attribute__((address_space(3))) int* lc = (__attribute__((address_space(3))) int*)(wl + 8 * D);
        __syncthreads();
        if (threadIdx.x < 8) lc[8 + threadIdx.x] = atomicAdd(p.cnt + threadIdx.x, lc[threadIdx.x]);
        __syncthreads();
        const int nrows = (M - blk * nw + nblk * nw - 1) / (nblk * nw) * nw;
        for (int r = threadIdx.x; r < nrows; r += blockDim.x) { const __attribute__((address_space(3))) float* rec = wl + 8 * D + 16 + r * 8;
            const int m = __float_as_int(rec[0]), ii = __float_as_int(rec[1]), i1 = ii & 255, i2 = ii >> 8;
            const int p1 = lc[8 + i1] + __float_as_int(rec[4]), p2 = lc[8 + i2] + __float_as_int(rec[5]);
            p.list_tw[i1 * M + p1] = m * 2; p.list_g[i1 * M + p1] = rec[2]; p.list_tw[i2 * M + p2] = m * 2 + 1; p.list_g[i2 * M + p2] = rec[3]; }
    }
}
__device__ __forceinline__ float gelu_tanh(float x) { return 0.5f * x * (1.f + tanhf(0.7978845608028654f * (x + 0.044715f * x * x * x))); }
namespace pg8 {
#define PG8_LAS __attribute__((address_space(3)))
typedef unsigned short bf16_t;
typedef short bf16x8 __attribute__((ext_vector_type(8)));
typedef int i32x4_t __attribute__((ext_vector_type(4)));
constexpr int BM = 256, BK = 64, HALF = 128, HTB = HALF * BK * 2  , STAGE_BYTES = 8 * HTB, NXCD = 8, WGM = 8;

__host__ __device__ __forceinline__ int lds_byte(int r, int c) { const int st = (r >> 4) * 2 + (c >> 5), rr = r & 15, cc = c & 31, ob = rr * 64 + cc * 2; return st * 1024 + (ob ^ (((ob >> 9) & 1) << 5)); }
__host__ __device__ __forceinline__ void stage_rc(int b, int& R, int& C) { const int st = b / 1024, sb = b % 1024, swz = sb ^ (((sb >> 9) & 1) << 5); R = (st >> 1) * 16 + swz / 64; C = (st & 1) * 32 + (swz % 64) / 2; }
__host__ __device__ __forceinline__ int perm32(int rho) { const int n = rho >> 4, i = rho & 15; return 8 * (i >> 2) + 4 * n + (i & 3); }

struct Unit { int pm, pn; const char* A; const char* B; int e, rt; };

struct DenseOrder {
    int nM, nN, nwg, G, c; const char* A; const char* Bt; unsigned tstepA, tstepB, cstepA;
    __device__ void init(const void* A_, int lda, const void* Bt_, int M, int N, int K, int G_, int c_) { nM = M / BM; nN = N / BM; nwg = nM * nN; G = G_; c = c_; A = (const char*)A_; Bt = (const char*)Bt_; tstepA = (unsigned)BM * lda * 2; tstepB = (unsigned)BM * K * 2; cstepA = 0; }
    __device__ bool next(int i, Unit& u) const {
        const long L = (long)i * G + c; if (L >= nwg) return false;
        int wgid = (int)L; { const int q = nwg / NXCD, r = nwg % NXCD, xcd = wgid % NXCD, off = wgid / NXCD; wgid = (xcd < r ? xcd * (q + 1) : r * (q + 1) + (xcd - r) * q) + off; }
        const int nig = WGM * nN, gid = wgid / nig, fm = gid * WGM, gsz = (nM - fm) < WGM ? (nM - fm) : WGM;
        u.pm = fm + ((wgid % nig) % gsz); u.pn = (wgid % nig) / gsz; u.A = A + (size_t)u.pm * tstepA + (size_t)u.pn * cstepA; u.B = Bt + (size_t)u.pn * tstepB; u.e = 0; u.rt = 0; return true;
    }
    __device__ __forceinline__ unsigned grow(const Unit&, int) const { return 0u; }
};
struct MoeOrder {
    int tp[9]; int cnt[8]; int nN, G, c, total; const char* A; const char* Bt; size_t estrideB, tstepB, tstepA; const int* ltw; int K2; int gather;
    __device__ void init(const int* cntp, const void* A_, const void* Bt_, size_t estrideB_, int N, int K, int G_, int c_, const int* ltw_, int gather_) {
        int s = 0;
        for (int e = 0; e < 8; ++e) { cnt[e] = __builtin_amdgcn_readfirstlane(cntp[e]); tp[e] = s; s += (cnt[e] + 255) >> 8; }
        tp[8] = s; nN = N / BM; total = s * nN; G = G_; c = c_; A = (const char*)A_; Bt = (const char*)Bt_; estrideB = estrideB_; tstepB = (size_t)BM * K * 2; tstepA = (size_t)BM * K * 2; ltw = ltw_; K2 = K * 2; gather = gather_;
    }
    __device__ bool next(int i, Unit& u) const {
        const long L = (long)i * G + c; if (L >= total) return false;
        const int tg = (int)(L / nN); u.pn = (int)(L % nN); u.pm = tg;
        int e = 0, tpe = 0;
#pragma unroll
        for (int j = 1; j < 8; ++j) if (tg >= tp[j]) { e = j; tpe = tp[j]; }
        u.e = e; u.rt = tg - tpe;
        u.A = gather ? A : A + (size_t)tg * tstepA; u.B = Bt + (size_t)e * estrideB + (size_t)u.pn * tstepB; return true;
    }
    __device__ __forceinline__ int nvalid(const Unit& u) const { int n = 0;
#pragma unroll
        for (int j = 0; j < 8; ++j) n = (u.e == j) ? cnt[j] : n;
        n -= u.rt * 256; return n > 256 ? 256 : n; }
    __device__ __forceinline__ unsigned grow(const Unit& u, int rr) const {
        const int nv = nvalid(u); int tok = 0;
        if (rr < nv) tok = ltw[(size_t)u.e * 16384 + u.rt * 256 + rr] >> 1;
        return (unsigned)tok * (unsigned)K2;
    }
};

__device__ __forceinline__ unsigned cvt_pk_bf16(float lo, float hi) { unsigned r; asm volatile("v_cvt_pk_bf16_f32 %0, %1, %2" : "=v"(r) : "v"(lo), "v"(hi)); return r; }

template <class Epi, class Sched, bool GATHER, bool ALIGN_EPI, bool FP8 = false>
__device__ __forceinline__ void gemm_phase(PG8_LAS unsigned char* lds, const int K, const int lda, const Sched& S, const Epi& E) {
    const int tid = threadIdx.x, wid = __builtin_amdgcn_readfirstlane(tid >> 6), lane = tid & 63, wr = wid >> 2, wc = wid & 3, fr = lane & 15, fq = lane >> 4;
    const int nt = K / BK;
    unsigned voffA[2], voffB[2]; int RA[2], CA[2];
#pragma unroll
    for (int i = 0; i < 2; ++i) { int R, C; stage_rc(tid * 16 + i * 8192, R, C); const int Rb = Epi::PERM ? ((R & ~31) + perm32(R & 31)) : R;
        RA[i] = R; CA[i] = C; voffA[i] = (unsigned)(R * lda + C) * 2u; voffB[i] = (unsigned)(Rb * K + C) * 2u; }
    const size_t kstep = (size_t)(BK * 2);
    const size_t hstepB = (size_t)HALF * K * 2;
    const size_t hstepA = GATHER ? 0 : (size_t)HALF * lda * 2;
    const unsigned ldsw = (unsigned)wid * 1024u;
    const unsigned ldsa = (unsigned)__builtin_amdgcn_readfirstlane((int)((unsigned)(size_t)lds + ldsw));
    const int aoff = lds_byte(wr * 64 + fr, fq * 8), boff = lds_byte(wc * 32 + fr, fq * 8);
#define PG8_SA(b, h) (((b) * 2 + (h)) * HTB)
#define PG8_SB(b, h) ((4 + (b) * 2 + (h)) * HTB)
#define PG8_STAGE(bufoff, gbase, voff) do { _Pragma("unroll") for (int _i = 0; _i < 2; ++_i) { unsigned _keep; \
        asm volatile("s_mov_b32 %0, m0\n\ts_mov_b32 m0, %3\n\ts_nop 0\n\tglobal_load_lds_dwordx4 %1, %2\n\ts_mov_b32 m0, %0" : "=&s"(_keep) : "v"((voff)[_i]), "s"((const char*)(gbase)), "s"(ldsa + (unsigned)(bufoff) + (unsigned)(_i * 8192)) : "memory"); } } while (0)
#define PG8_LDA(dst, b, h) do { _Pragma("unroll") for (int m = 0; m < 4; ++m) _Pragma("unroll") for (int k = 0; k < 2; ++k) dst[m][k] = *(const PG8_LAS bf16x8*)(lds + PG8_SA(b, h) + aoff + m * 2048 + k * 1024); } while (0)
#define PG8_LDB(dst, b, h) do { _Pragma("unroll") for (int n = 0; n < 2; ++n) _Pragma("unroll") for (int k = 0; k < 2; ++k) dst[n][k] = *(const PG8_LAS bf16x8*)(lds + PG8_SB(b, h) + boff + n * 2048 + k * 1024); } while (0)
#define PG8_CAT(X) __builtin_shufflevector(__builtin_bit_cast(i32x4_t, (X)[0]), __builtin_bit_cast(i32x4_t, (X)[1]), 0, 1, 2, 3, 4, 5, 6, 7)
#define PG8_MMA(ai, bj, At, Bt) do { __builtin_amdgcn_s_setprio(1); _Pragma("unroll") for (int m = 0; m < 4; ++m) _Pragma("unroll") for (int n = 0; n < 2; ++n) { \
        if constexpr (FP8) asm volatile("v_mfma_scale_f32_16x16x128_f8f6f4 %0, %1, %2, %0, %3, %3 op_sel_hi:[0,0,0]" : "+v"(acc[ai][bj][m][n]) : "v"(PG8_CAT(Bt[n])), "v"(PG8_CAT(At[m])), "v"(0x7f7f7f7f));   \
        else { _Pragma("unroll") for (int k = 0; k < 2; ++k) acc[ai][bj][m][n] = __builtin_amdgcn_mfma_f32_16x16x32_bf16(Bt[n][k], At[m][k], acc[ai][bj][m][n], 0, 0, 0); } } \
        __builtin_amdgcn_s_setprio(0); } while (0)
#define PG8_WAIT_V(n) asm volatile("s_waitcnt vmcnt(" #n ")" ::: "memory")
#define PG8_WAIT_L(n) asm volatile("s_waitcnt lgkmcnt(" #n ")" ::: "memory")
#define PG8_BAR __builtin_amdgcn_s_barrier()
#define PG8_SCHED __builtin_amdgcn_sched_barrier(0)
    Unit cur, nxt; int ui = 0;
    if (!S.next(0, cur)) return;
    unsigned gc[2][2], gn[2][2];
#pragma unroll
    for (int h = 0; h < 2; ++h)
#pragma unroll
        for (int i = 0; i < 2; ++i) { gc[h][i] = GATHER ? S.grow(cur, h * HALF + RA[i]) + (unsigned)CA[i] * 2u : voffA[i]; gn[h][i] = gc[h][i]; }
    f32x4 acc[2][2][4][2];
#pragma unroll
    for (int a = 0; a < 2; ++a)
#pragma unroll
        for (int b = 0; b < 2; ++b)
#pragma unroll
            for (int m = 0; m < 4; ++m)
#pragma unroll
                for (int n = 0; n < 2; ++n) acc[a][b][m][n] = (f32x4){0.f, 0.f, 0.f, 0.f};
    bf16x8 At[4][2], B0[2][2], B1[2][2];
    const char* cA = cur.A; const char* cB = cur.B;
    PG8_STAGE(PG8_SB(0, 0), cB, voffB); PG8_STAGE(PG8_SB(0, 1), cB + hstepB, voffB); PG8_STAGE(PG8_SA(0, 0), cA, gc[0]); PG8_STAGE(PG8_SA(0, 1), cA + hstepA, gc[1]);
    if (wr == 1) PG8_BAR;
    PG8_WAIT_V(2); PG8_BAR;
    PG8_STAGE(PG8_SB(1, 0), cB + kstep, voffB); PG8_STAGE(PG8_SA(1, 0), cA + kstep, gc[0]); PG8_STAGE(PG8_SB(1, 1), cB + hstepB + kstep, voffB);
    PG8_WAIT_V(6); PG8_BAR;
    for (;;) {
        const bool has_next = S.next(ui + 1, nxt);
        const char* nA = has_next ? nxt.A : cA; const char* nB = has_next ? nxt.B : cB;
        if (GATHER) {
#pragma unroll
            for (int h = 0; h < 2; ++h)
#pragma unroll
                for (int i = 0; i < 2; ++i) gn[h][i] = has_next ? S.grow(nxt, h * HALF + RA[i]) + (unsigned)CA[i] * 2u : gc[h][i];
        }
        for (int t = 0; t < nt; t += 2) {
            const bool last = (t == nt - 2);
            const char* a1 = cA + (size_t)(t + 1) * kstep;
            const char* a2 = last ? nA : cA + (size_t)(t + 2) * kstep; const char* b2 = last ? nB : cB + (size_t)(t + 2) * kstep;
            const char* a3 = a2 + kstep; const char* b3 = b2 + kstep;
            unsigned g2[2][2];
#pragma unroll
            for (int h = 0; h < 2; ++h)
#pragma unroll
                for (int i = 0; i < 2; ++i) g2[h][i] = (GATHER && last) ? gn[h][i] : gc[h][i];
            PG8_LDB(B0, 0, 0); PG8_LDB(B1, 0, 1); PG8_SCHED; PG8_LDA(At, 0, 0); PG8_STAGE(PG8_SA(1, 1), a1 + hstepA, gc[1]);
            PG8_WAIT_V(8); PG8_WAIT_L(0); PG8_BAR; PG8_MMA(0, 0, At, B0); PG8_MMA(0, 1, At, B1); PG8_BAR; PG8_SCHED;
            PG8_LDA(At, 0, 1); PG8_STAGE(PG8_SB(0, 0), b2, voffB); PG8_STAGE(PG8_SB(0, 1), b2 + hstepB, voffB); PG8_STAGE(PG8_SA(0, 0), a2, g2[0]);
            PG8_WAIT_V(8); PG8_WAIT_L(0); PG8_BAR; PG8_MMA(1, 0, At, B0); PG8_MMA(1, 1, At, B1); PG8_BAR; PG8_SCHED;
            PG8_LDB(B0, 1, 0); PG8_LDB(B1, 1, 1); PG8_SCHED; PG8_LDA(At, 1, 0); PG8_STAGE(PG8_SA(0, 1), a2 + hstepA, g2[1]);
            PG8_WAIT_V(8); PG8_WAIT_L(0); PG8_BAR; PG8_MMA(0, 0, At, B0); PG8_MMA(0, 1, At, B1); PG8_BAR; PG8_SCHED;
            PG8_LDA(At, 1, 1); PG8_STAGE(PG8_SB(1, 0), b3, voffB); PG8_STAGE(PG8_SB(1, 1), b3 + hstepB, voffB); PG8_STAGE(PG8_SA(1, 0), a3, g2[0]);
            PG8_WAIT_V(8); PG8_WAIT_L(0); PG8_BAR; PG8_MMA(1, 0, At, B0); PG8_MMA(1, 1, At, B1); PG8_BAR; PG8_SCHED;
        }
        if constexpr (ALIGN_EPI) { if (wr == 0) PG8_BAR; }
        if constexpr (FP8) asm volatile("s_nop 15\n\ts_nop 7" ::: "memory");
        E(acc, cur, S, wr, wc, fr, fq);
        if (!has_next) break;
#pragma unroll
        for (int a = 0; a < 2; ++a)
#pragma unroll
            for (int b = 0; b < 2; ++b)
#pragma unroll
                for (int m = 0; m < 4; ++m)
#pragma unroll
                    for (int n = 0; n < 2; ++n) acc[a][b][m][n] = (f32x4){0.f, 0.f, 0.f, 0.f};
        cur = nxt; cA = nA; cB = nB; ++ui;
#pragma unroll
        for (int h = 0; h < 2; ++h)
#pragma unroll
            for (int i = 0; i < 2; ++i) gc[h][i] = gn[h][i];
        if constexpr (ALIGN_EPI) { if (wr == 1) PG8_BAR; }
    }
    PG8_WAIT_V(0);
    if constexpr (!ALIGN_EPI) { if (wr == 0) PG8_BAR; }
    PG8_BAR;
#undef PG8_SA
#undef PG8_SB
#undef PG8_STAGE
#undef PG8_LDA
#undef PG8_LDB
#undef PG8_MMA
#undef PG8_CAT
#undef PG8_WAIT_V
#undef PG8_WAIT_L
#undef PG8_BAR
#undef PG8_SCHED
}
}
namespace pg8 {
struct EpiF32 {
    static constexpr bool PERM = false;
    float* C; int ldc;
    template <class Sched> __device__ __forceinline__ void operator()(const f32x4 (&acc)[2][2][4][2], const Unit& u, const Sched&, int wr, int wc, int fr, int fq) const {
        const int row0 = u.pm * BM + wr * 64 + fr, col0 = u.pn * BM + wc * 32 + 4 * fq;
#pragma unroll
        for (int ai = 0; ai < 2; ++ai)
#pragma unroll
            for (int m = 0; m < 4; ++m) { float* rowp = C + (size_t)(row0 + ai * HALF + m * 16) * ldc + col0;
#pragma unroll
                for (int bj = 0; bj < 2; ++bj)
#pragma unroll
                    for (int n = 0; n < 2; ++n) *(f32x4*)(rowp + bj * HALF + n * 16) = acc[ai][bj][m][n]; }
    }
};
struct EpiBf16 {
    static constexpr bool PERM = true;
    u16* O; int ldc;
    template <class Sched> __device__ __forceinline__ void operator()(const f32x4 (&acc)[2][2][4][2], const Unit& u, const Sched&, int wr, int wc, int fr, int fq) const {
        const int row0 = u.pm * BM + wr * 64 + fr, col0 = u.pn * BM + wc * 32 + 8 * fq;
#pragma unroll
        for (int ai = 0; ai < 2; ++ai)
#pragma unroll
            for (int m = 0; m < 4; ++m) { u16* rowp = O + (size_t)(row0 + ai * HALF + m * 16) * ldc + col0;
#pragma unroll
                for (int bj = 0; bj < 2; ++bj) { const f32x4 v0 = acc[ai][bj][m][0], v1 = acc[ai][bj][m][1];
                    u32x4 w; w.x = cvt_pk_bf16(v0[0], v0[1]); w.y = cvt_pk_bf16(v0[2], v0[3]); w.z = cvt_pk_bf16(v1[0], v1[1]); w.w = cvt_pk_bf16(v1[2], v1[3]);
                    *(u32x4*)(rowp + bj * HALF) = w; } }
    }
};
__device__ __forceinline__ float silu_f(float v) { return v * __builtin_amdgcn_rcpf(1.f + __builtin_amdgcn_exp2f(-1.4426950408889634f * v)); }
struct EpiSwiglu {
    static constexpr bool PERM = true;
    u16* O; int ldc;
    template <class Sched> __device__ __forceinline__ void operator()(const f32x4 (&acc)[2][2][4][2], const Unit& u, const Sched&, int wr, int wc, int fr, int fq) const {
        const int row0 = u.pm * BM + wr * 64 + fr, col0 = u.pn * HALF + wc * 32 + 8 * fq;
#pragma unroll
        for (int ai = 0; ai < 2; ++ai)
#pragma unroll
            for (int m = 0; m < 4; ++m) { u16* rowp = O + (size_t)(row0 + ai * HALF + m * 16) * ldc + col0;
                f32x4 v0, v1;
#pragma unroll
                for (int i = 0; i < 4; ++i) { v0[i] = silu_f(acc[ai][0][m][0][i]) * acc[ai][1][m][0][i]; v1[i] = silu_f(acc[ai][0][m][1][i]) * acc[ai][1][m][1][i]; }
                u32x4 w; w.x = cvt_pk_bf16(v0[0], v0[1]); w.y = cvt_pk_bf16(v0[2], v0[3]); w.z = cvt_pk_bf16(v1[0], v1[1]); w.w = cvt_pk_bf16(v1[2], v1[3]);
                *(u32x4*)rowp = w; }
    }
};
struct EpiSwiglu8 {
    static constexpr bool PERM = true;
    unsigned char* O; int ldc; const float* isc;
    template <class Sched> __device__ __forceinline__ void operator()(const f32x4 (&acc)[2][2][4][2], const Unit& u, const Sched&, int wr, int wc, int fr, int fq) const {
        const int row0 = u.pm * BM + wr * 64 + fr, col0 = u.pn * HALF + wc * 32 + 8 * fq;
        const float* sp = isc + (size_t)u.e * 7168 + u.pn * BM + wc * 32 + 8 * fq;
        const f32x4 sg0 = *(const f32x4*)sp, sg1 = *(const f32x4*)(sp + 4), su0 = *(const f32x4*)(sp + HALF) * 2.f, su1 = *(const f32x4*)(sp + HALF + 4) * 2.f;
        const f32x4 se0 = sg0 * -1.4426950408889634f, se1 = sg1 * -1.4426950408889634f;
#pragma unroll
        for (int ai = 0; ai < 2; ++ai)
#pragma unroll
            for (int m = 0; m < 4; ++m) { unsigned char* rowp = O + (size_t)(row0 + ai * HALF + m * 16) * ldc + col0;
                f32x4 v0, v1;
#pragma unroll
                for (int i = 0; i < 4; ++i) { const float g0 = acc[ai][0][m][0][i], g1 = acc[ai][0][m][1][i];
                    v0[i] = (g0 * sg0[i]) * __builtin_amdgcn_rcpf(1.f + __builtin_amdgcn_exp2f(g0 * se0[i])) * (acc[ai][1][m][0][i] * su0[i]);
                    v1[i] = (g1 * sg1[i]) * __builtin_amdgcn_rcpf(1.f + __builtin_amdgcn_exp2f(g1 * se1[i])) * (acc[ai][1][m][1][i] * su1[i]); }
                u32x2 w; w.x = pk4_fp8(v0[0], v0[1], v0[2], v0[3]); w.y = pk4_fp8(v1[0], v1[1], v1[2], v1[3]);
                *(u32x2*)rowp = w; }
    }
};
struct EpiQKV {
    static constexpr bool PERM = true;
    u16* Q; u16* K; u16* V; const float* rope; float* ksum; unsigned* kn2;
    template <class Sched> __device__ __forceinline__ void operator()(f32x4 (&acc)[2][2][4][2], const Unit& u, const Sched&, int wr, int wc, int fr, int fq) const {
        const int part = u.pn >> 2, pq = u.pn & 3;
        u16* base = Q + (size_t)part * ((size_t)16384 * 1024);
        const int row0 = u.pm * BM + wr * 64 + fr;
        const bool ropew = (part < 2) && (pq < 2) && ((wc & 1) == 0);
        if (ropew) {
            const float sgn = fq == 0 ? -1.f : 1.f;
#pragma unroll
            for (int ai = 0; ai < 2; ++ai)
#pragma unroll
                for (int m = 0; m < 4; ++m) {
                    const int pos = (row0 + ai * HALF + m * 16) & 4095;
                    const f32x4 t0 = *(const f32x4*)(rope + pos * 16), t1 = *(const f32x4*)(rope + pos * 16 + 4), t2 = *(const f32x4*)(rope + pos * 16 + 8), t3 = *(const f32x4*)(rope + pos * 16 + 12);
                    const float cs[8] = {t0[0], t0[2], t1[0], t1[2], t2[0], t2[2], t3[0], t3[2]}, sn[8] = {t0[1], t0[3], t1[1], t1[3], t2[1], t2[3], t3[1], t3[3]};
#pragma unroll
                    for (int bj = 0; bj < 2; ++bj)
#pragma unroll
                        for (int n = 0; n < 2; ++n)
#pragma unroll
                            for (int i = 0; i < 4; ++i) {
                                const float mine = acc[ai][bj][m][n][i]; const float oth = __shfl_xor(mine, 16);
                                const float rot = mine * cs[4 * n + i] + sgn * oth * sn[4 * n + i];
                                acc[ai][bj][m][n][i] = fq < 2 ? rot : mine;
                            }
                }
        }
        if (part == 1 && pq < 2) {
            const int b = u.pm >> 4, blk = u.pm & 15;
#pragma unroll
            for (int bj = 0; bj < 2; ++bj)
#pragma unroll
                for (int n = 0; n < 2; ++n)
#pragma unroll
                    for (int i = 0; i < 4; ++i) {
                        float s = 0.f;
#pragma unroll
                        for (int ai = 0; ai < 2; ++ai)
#pragma unroll
                            for (int m = 0; m < 4; ++m) s += acc[ai][bj][m][n][i];
                        s += __shfl_xor(s, 1); s += __shfl_xor(s, 2); s += __shfl_xor(s, 4); s += __shfl_xor(s, 8);
                        if (fr == 0) { const int cc = pq * 256 + bj * HALF + wc * 32 + 8 * fq + 4 * n + i;
                            atomicAdd(ksum + ((size_t)(b * 8 + (cc >> 6)) * 16 + blk) * 64 + (cc & 63), s); }
                    }
        }
        if (part == 1 && pq >= 2) {
            const int b = u.pm >> 4;
#pragma unroll
            for (int bj = 0; bj < 2; ++bj) { float mx = 0.f;
#pragma unroll
                for (int ai = 0; ai < 2; ++ai)
#pragma unroll
                    for (int m = 0; m < 4; ++m) { const f32x4 v0 = acc[ai][bj][m][0], v1 = acc[ai][bj][m][1];
                        mx = __builtin_fmaxf(mx, (v0[0] * v0[0] + v0[1] * v0[1]) + (v0[2] * v0[2] + v0[3] * v0[3]) + (v1[0] * v1[0] + v1[1] * v1[1]) + (v1[2] * v1[2] + v1[3] * v1[3])); }
                mx = __builtin_fmaxf(mx, __shfl_xor(mx, 1)); mx = __builtin_fmaxf(mx, __shfl_xor(mx, 2)); mx = __builtin_fmaxf(mx, __shfl_xor(mx, 4)); mx = __builtin_fmaxf(mx, __shfl_xor(mx, 8));
                if (fr == 0) { const int hf = (pq - 2) * 4 + bj * 2 + (wc >> 1); atomicMax(kn2 + (b * 8 + hf) * 8 + (wc & 1) * 4 + fq, __float_as_uint(mx)); } }
        }
        const float sc = part == 0 ? C2 : 1.f;
        const int col0 = pq * BM + wc * 32 + 8 * fq;
#pragma unroll
        for (int ai = 0; ai < 2; ++ai)
#pragma unroll
            for (int m = 0; m < 4; ++m) { u16* rowp = base + (size_t)(row0 + ai * HALF + m * 16) * 1024 + col0;
#pragma unroll
                for (int bj = 0; bj < 2; ++bj) { const f32x4 v0 = acc[ai][bj][m][0] * sc, v1 = acc[ai][bj][m][1] * sc;
                    u32x4 w; w.x = cvt_pk_bf16(v0[0], v0[1]); w.y = cvt_pk_bf16(v0[2], v0[3]); w.z = cvt_pk_bf16(v1[0], v1[1]); w.w = cvt_pk_bf16(v1[2], v1[3]);
                    *(u32x4*)(rowp + bj * HALF) = w; } }
    }
};
struct EpiMoeDown {
    static constexpr bool PERM = true;
    u16* Y; const int* ltw; const float* lg; const float* isc;
    template <class Sched> __device__ __forceinline__ void operator()(const f32x4 (&acc)[2][2][4][2], const Unit& u, const Sched& S, int wr, int wc, int fr, int fq) const {
        const int nv = S.nvalid(u); const size_t lbase = (size_t)u.e * 16384 + u.rt * 256;
        const int col0 = u.pn * BM + wc * 32 + 8 * fq;
        const float* sp = isc + (size_t)u.e * 1024 + col0;
        f32x4 cs[2][2];
#pragma unroll
        for (int bj = 0; bj < 2; ++bj) { cs[bj][0] = *(const f32x4*)(sp + bj * HALF) * 0.5f; cs[bj][1] = *(const f32x4*)(sp + bj * HALF + 4) * 0.5f; }
#pragma unroll
        for (int ai = 0; ai < 2; ++ai)
#pragma unroll
            for (int m = 0; m < 4; ++m) { const int rr = ai * HALF + wr * 64 + m * 16 + fr;
                if (rr < nv) { const int tw = ltw[lbase + rr]; const float g = lg[lbase + rr]; u16* rowp = Y + (size_t)tw * 1024 + col0;
#pragma unroll
                    for (int bj = 0; bj < 2; ++bj) { const f32x4 v0 = acc[ai][bj][m][0] * cs[bj][0] * g, v1 = acc[ai][bj][m][1] * cs[bj][1] * g;
                        u32x4 w; w.x = cvt_pk_bf16(v0[0], v0[1]); w.y = cvt_pk_bf16(v0[2], v0[3]); w.z = cvt_pk_bf16(v1[0], v1[1]); w.w = cvt_pk_bf16(v1[2], v1[3]);
                        *(u32x4*)(rowp + bj * HALF) = w; } } }
    }
};
__device__ __forceinline__ float one_minus_exp(float t) { return t > -0.02f ? -t * (1.f + t * (0.5f + t * (0.16666667f + t * 0.041666667f))) : 1.f - __expf(t); }
struct EpiGates {
    static constexpr bool PERM = true;
    char* wsb; size_t o_la, o_xi, o_conv, o_tab;
    template <class Sched> __device__ __forceinline__ void operator()(f32x4 (&acc)[2][2][4][2], const Unit& u, const Sched&, int wr, int wc, int fr, int fq) const {
        const int row0 = u.pm * BM + wr * 64 + fr, ch0 = u.pn * HALF + wc * 32 + 8 * fq;
        u16* LA = (u16*)(wsb + o_la); u16* XI = (u16*)(wsb + o_xi); const u16* conv = (const u16*)(wsb + o_conv); const float* tab = (const float*)(wsb + o_tab) + ch0;
        asm volatile("" ::: "memory"); __builtin_amdgcn_sched_barrier(0);
        {
            float ba[8], sp8[8];
#pragma unroll
            for (int j = 0; j < 2; ++j) { const f32x4 t = *(const f32x4*)(tab + 4 * j), t2 = *(const f32x4*)(tab + 2 * 1280 + 4 * j); ba[4 * j] = t[0]; ba[4 * j + 1] = t[1]; ba[4 * j + 2] = t[2]; ba[4 * j + 3] = t[3]; sp8[4 * j] = t2[0]; sp8[4 * j + 1] = t2[1]; sp8[4 * j + 2] = t2[2]; sp8[4 * j + 3] = t2[3]; }
#pragma unroll
            for (int ai = 0; ai < 2; ++ai)
#pragma unroll
                for (int m = 0; m < 4; ++m)
#pragma unroll
                    for (int j = 0; j < 8; ++j) acc[ai][0][m][j >> 2][j & 3] = sp8[j] * __builtin_amdgcn_rcpf(1.f + __expf(-(acc[ai][0][m][j >> 2][j & 3] + ba[j])));
        }
        float bx[8];
#pragma unroll
        for (int j = 0; j < 2; ++j) { const f32x4 t = *(const f32x4*)(tab + 1280 + 4 * j); bx[4 * j] = t[0]; bx[4 * j + 1] = t[1]; bx[4 * j + 2] = t[2]; bx[4 * j + 3] = t[3]; }
#pragma unroll
        for (int ai = 0; ai < 2; ++ai)
#pragma unroll
            for (int m = 0; m < 4; ++m) { const size_t off = (size_t)(row0 + ai * HALF + m * 16) * 1280 + ch0;
                const u32x4 cv = *(const u32x4*)(conv + off);
                u32x4 wl, wx;
#pragma unroll
                for (int q = 0; q < 4; ++q) {
                    const float c0 = __uint_as_float(cv[q] << 16), c1 = __uint_as_float(cv[q] & 0xffff0000u);
                    const int j0 = 2 * q, j1 = 2 * q + 1;
                    const float la0 = acc[ai][0][m][j0 >> 2][j0 & 3], la1 = acc[ai][0][m][j1 >> 2][j1 & 3];
                    const float rx0 = acc[ai][1][m][j0 >> 2][j0 & 3] + bx[j0], rx1 = acc[ai][1][m][j1 >> 2][j1 & 3] + bx[j1];
                    const float x0 = __builtin_amdgcn_sqrtf(one_minus_exp(2.f * la0)) * (c0 * __builtin_amdgcn_rcpf(1.f + __expf(-rx0))), x1 = __builtin_amdgcn_sqrtf(one_minus_exp(2.f * la1)) * (c1 * __builtin_amdgcn_rcpf(1.f + __expf(-rx1)));
                    wl[q] = cvt_pk_bf16(la0, la1); wx[q] = cvt_pk_bf16(x0, x1);
                }
                *(u32x4*)(LA + off) = wl; *(u32x4*)(XI + off) = wx;
                asm volatile("" ::: "memory"); }
    }
};
}
#include <hip/hip_bf16.h>
namespace attn_body {
using bf16=__hip_bfloat16;
using bf16x8=__attribute__((ext_vector_type(8)))short;
using s16x4=__attribute__((ext_vector_type(4)))short;
using f32x16=__attribute__((ext_vector_type(16)))float;
using u32x4=__attribute__((ext_vector_type(4)))unsigned;
constexpr int BATCH=4,NHEAD=16,SEQ=4096,D=64,DM=NHEAD*D;
constexpr int NW=8,QBLK=32,QB=QBLK*NW,KVBLK=64,NQB=SEQ/QB;
constexpr int ATTN_PITCH=DM, ATTN_UNIT_ROWS=QB;
__device__ __forceinline__ int crow(int r,int hi){return (r&3)+8*(r>>2)+4*hi;}
#define SBAR() __builtin_amdgcn_sched_barrier(0)
__device__ __forceinline__ void cmask(f32x16&p0,f32x16&p1,int jb,int qrel,int hi){
  const float NEG=-INFINITY; int kb=64*jb+4*hi;
  #pragma unroll
  for(int r=0;r<16;++r){int kv=kb+(r&3)+8*(r>>2); if(kv>qrel)p0[r]=NEG; if(kv+32>qrel)p1[r]=NEG;}
}

constexpr int NSLOT=3, SLOTB=8192;
constexpr int LDS_K=0, LDS_V=NSLOT*SLOTB, LDS_WS=2*NSLOT*SLOTB, LDS_OST=LDS_WS+NW*64*4, LDS_KB=LDS_OST+NW*4096, LDS_BYTES=LDS_KB+16384;
constexpr float C2=0.125f*1.4426950408889634f;
__device__ __forceinline__ void glds16(const void*gsrc,unsigned lds_dst){unsigned keep;
  asm volatile("s_mov_b32 %0, m0\n\ts_mov_b32 m0, %2\n\ts_nop 0\n\tglobal_load_lds_dwordx4 %1, off\n\ts_mov_b32 m0, %0":"=&s"(keep):"v"(gsrc),"s"(lds_dst):"memory");}
__device__ __forceinline__ float max3f(float a,float b,float c){float r;asm("v_max3_f32 %0, %1, %2, %3":"=v"(r):"v"(a),"v"(b),"v"(c));return r;}
__device__ __forceinline__ float max2f(float a,float b){float r;asm("v_max_f32_e32 %0, %1, %2":"=v"(r):"v"(a),"v"(b));return r;}
__device__ __forceinline__ float fadd_s(float a,float b){float r;asm("v_add_f32_e32 %0, %1, %2":"=v"(r):"v"(a),"v"(b));return r;}
__device__ __forceinline__ float fsub_s(float a,float b){float r;asm("v_sub_f32_e32 %0, %1, %2":"=v"(r):"v"(a),"v"(b));return r;}
typedef float f32x2_t __attribute__((ext_vector_type(2))); typedef __bf16 bf16x2_t __attribute__((ext_vector_type(2)));
__device__ __forceinline__ unsigned cvtpk_s(float lo,float hi){f32x2_t v={lo,hi};bf16x2_t b=__builtin_convertvector(v,bf16x2_t);return __builtin_bit_cast(unsigned,b);}
#define WAIT_BAR(N) asm volatile("s_waitcnt vmcnt(" #N ") lgkmcnt(0)\n\ts_barrier":::"memory")

__device__ __forceinline__ void qkt(f32x16&p0,f32x16&p1,const char*Kslot,const bf16x8*qr,const f32x16&negm,int r32,int hi){
  const char*kb=Kslot+hi*1024+r32*16;
  #pragma unroll
  for(int d0=0;d0<4;++d0){
    const bf16x8 b0=*reinterpret_cast<const bf16x8*>(kb+d0*2048);
    const bf16x8 b1=*reinterpret_cast<const bf16x8*>(kb+d0*2048+512);
    if(d0==0){p0=__builtin_amdgcn_mfma_f32_32x32x16_bf16(b0,qr[0],negm,0,0,0);p1=__builtin_amdgcn_mfma_f32_32x32x16_bf16(b1,qr[0],negm,0,0,0);}
    else{p0=__builtin_amdgcn_mfma_f32_32x32x16_bf16(b0,qr[d0],p0,0,0,0);p1=__builtin_amdgcn_mfma_f32_32x32x16_bf16(b1,qr[d0],p1,0,0,0);}}
}
__device__ __forceinline__ void qkt_acc(f32x16&p0,f32x16&p1,const char*Kslot,const bf16x8*qr,int r32,int hi){
  const char*kb=Kslot+hi*1024+r32*16;
  #pragma unroll
  for(int d0=0;d0<4;++d0){
    const bf16x8 b0=*reinterpret_cast<const bf16x8*>(kb+d0*2048);
    const bf16x8 b1=*reinterpret_cast<const bf16x8*>(kb+d0*2048+512);
    p0=__builtin_amdgcn_mfma_f32_32x32x16_bf16(b0,qr[d0],p0,0,0,0);p1=__builtin_amdgcn_mfma_f32_32x32x16_bf16(b1,qr[d0],p1,0,0,0);}
}
typedef __attribute__((address_space(3))) const char* lds_cptr;
typedef short v4i16_t __attribute__((ext_vector_type(4)));
__device__ __forceinline__ void kload8(bf16x8*kf,lds_cptr kp){
  kf[0]=*(const __attribute__((address_space(3))) bf16x8*)(kp);      kf[1]=*(const __attribute__((address_space(3))) bf16x8*)(kp+512);
  kf[2]=*(const __attribute__((address_space(3))) bf16x8*)(kp+2048); kf[3]=*(const __attribute__((address_space(3))) bf16x8*)(kp+2560);
  kf[4]=*(const __attribute__((address_space(3))) bf16x8*)(kp+4096); kf[5]=*(const __attribute__((address_space(3))) bf16x8*)(kp+4608);
  kf[6]=*(const __attribute__((address_space(3))) bf16x8*)(kp+6144); kf[7]=*(const __attribute__((address_space(3))) bf16x8*)(kp+6656);
}
__device__ __forceinline__ void kload2(bf16x8*kf,lds_cptr kp,int j){ kf[2*j]=*(const __attribute__((address_space(3))) bf16x8*)(kp+j*2048); kf[2*j+1]=*(const __attribute__((address_space(3))) bf16x8*)(kp+j*2048+512); }
__device__ __forceinline__ s16x4 vtr(lds_cptr p){ return __builtin_bit_cast(s16x4,__builtin_amdgcn_ds_read_tr16_b64_v4i16((__attribute__((address_space(3))) v4i16_t*)p)); }
__device__ __forceinline__ float rowmax(const f32x16&p0,const f32x16&p1){
  float a=max3f(p0[0],p0[1],p1[0]),b=max3f(p0[2],p0[3],p1[1]);a=max3f(a,p1[2],p1[3]);
  #pragma unroll
  for(int r=4;r<16;r+=4){a=max3f(a,p0[r],p0[r+1]);b=max3f(b,p0[r+2],p0[r+3]);a=max3f(a,p1[r],p1[r+1]);b=max3f(b,p1[r+2],p1[r+3]);}
  const float m=max2f(a,b);
  auto rr=__builtin_amdgcn_permlane32_swap(__float_as_uint(m),__float_as_uint(m),false,false);
  return max2f(__uint_as_float(rr[0]),__uint_as_float(rr[1]));
}
__device__ __forceinline__ void pv(f32x16*o,int vb,bf16x8 pa0,bf16x8 pa1,bf16x8 pa2,bf16x8 pa3){
  #pragma unroll
  for(int d0=0;d0<2;++d0){s16x4 lo[4],hi[4];
    #pragma unroll
    for(int ks=0;ks<4;++ks){
      asm volatile("ds_read_b64_tr_b16 %0,%1 offset:%c2":"=&v"(lo[ks]):"v"(vb),"i"(d0*4096+ks*1024):"memory");
      asm volatile("ds_read_b64_tr_b16 %0,%1 offset:%c2":"=&v"(hi[ks]):"v"(vb),"i"(d0*4096+ks*1024+512):"memory");}
    asm volatile("s_waitcnt lgkmcnt(0)":::"memory");SBAR();
    #define PK(k) (bf16x8){lo[k][0],lo[k][1],lo[k][2],lo[k][3],hi[k][0],hi[k][1],hi[k][2],hi[k][3]}
    o[d0]=__builtin_amdgcn_mfma_f32_32x32x16_bf16(pa0,PK(0),o[d0],0,0,0);
    o[d0]=__builtin_amdgcn_mfma_f32_32x32x16_bf16(pa1,PK(1),o[d0],0,0,0);
    o[d0]=__builtin_amdgcn_mfma_f32_32x32x16_bf16(pa2,PK(2),o[d0],0,0,0);
    o[d0]=__builtin_amdgcn_mfma_f32_32x32x16_bf16(pa3,PK(3),o[d0],0,0,0);
    #undef PK
  }
}

#ifndef ATTN_STORE16
#define ATTN_STORE16(p,v) (*(u32x4*)(p)=(v))
#endif
template<int THRL,bool MOBA> __device__ __forceinline__ void attn_unit(int b,int h,int qb,const bf16*Q,const bf16*__restrict__ K,const bf16*__restrict__ V,bf16*O,char*shm,const float*aux,const unsigned*kn2){
  int tid_=threadIdx.x; asm volatile("":"+v"(tid_));
  const int tid=tid_,lane=tid&63,r32=lane&31,hi=lane>>5; const int wid=__builtin_amdgcn_readfirstlane(tid>>6);
  const long rowbase=(long)b*SEQ; const int q0=qb*QB;
  const bf16*Qw=Q+(rowbase+q0+wid*QBLK)*DM+h*D;
  const bf16*Kh=K+rowbase*DM+h*D,*Vh=V+rowbase*DM+h*D;
  const lds_cptr shm3=(lds_cptr)shm;
  const unsigned lds0=(unsigned)(uintptr_t)shm;
  float*wsf=(float*)(shm+LDS_WS)+wid*64;
  const bf16*ksrc=Kh+(long)lane*DM+wid*8;
  const bf16*vsrc=Vh+(long)(16*(wid&3)+(lane>>2))*DM+(wid>>2)*32+(lane&3)*8;
  const unsigned kdst=lds0+LDS_K+wid*1024, vdst=lds0+LDS_V+wid*1024;
  #define TA(t) (NTA-1-(t))
  #define DMA_K(t,slot) glds16(ksrc+(long)(TA(t))*KVBLK*DM,(unsigned)__builtin_amdgcn_readfirstlane(kdst+(slot)))
  #define DMA_V(t,slot) glds16(vsrc+(long)(TA(t))*KVBLK*DM,(unsigned)__builtin_amdgcn_readfirstlane(vdst+(slot)))
  const int vb0=(int)(lds0+LDS_V)+((lane>>4)&1)*32+(lane&3)*8+(4*hi+((lane&15)>>2))*64;
  const char*Kbase=shm+LDS_K; bf16x8 kf[8];
  const lds_cptr kp0=shm3+LDS_K+hi*1024+r32*16; const lds_cptr vp0=shm3+LDS_V+((lane>>4)&1)*32+(lane&3)*8+(4*hi+((lane&15)>>2))*64;
  const int NTA=(q0+QB)/KVBLK;
  int NT=NTA;
  typedef __attribute__((address_space(3))) const float* lds_fptr; typedef float f32x4_t __attribute__((ext_vector_type(4)));
  const lds_fptr kbl=(lds_fptr)(shm3+LDS_KB);
  if constexpr(MOBA){ if(qb>0){
      if(tid<qb*16){ const f32x4_t v=*(const __attribute__((address_space(1))) f32x4_t*)(aux+tid*4); *(__attribute__((address_space(3))) f32x4_t*)((__attribute__((address_space(3))) char*)shm3+LDS_KB+tid*16)=v; } } }
  else {
    glds16(aux+(wid*2)*256+lane*4,(unsigned)__builtin_amdgcn_readfirstlane(lds0+LDS_KB+(wid*2)*1024));
    glds16(aux+(wid*2+1)*256+lane*4,(unsigned)__builtin_amdgcn_readfirstlane(lds0+LDS_KB+(wid*2+1)*1024)); }
  DMA_K(0,0);DMA_V(0,0);DMA_K(1,SLOTB);
  bf16x8 qr[4];
  #pragma unroll
  for(int d0=0;d0<4;++d0)qr[d0]=*reinterpret_cast<const bf16x8*>(&Qw[(long)r32*DM+d0*16+hi*8]);
  float mhat=0.f,l_reg=0.f;f32x16 o[2];o[0]=f32x16{};o[1]=f32x16{};f32x16 negm=f32x16{};if constexpr(MOBA)asm volatile("":"+v"(negm));
  unsigned amask=0xffffffffu;
  const int qrel=wid*QBLK+r32;
  #define CMASK(P0,P1,t) do{ if((t)<4)cmask(P0,P1,3-(t),qrel,hi); }while(0)
  bool resc=false;
  #define START(P0,P1) do{ const float rm=rowmax(P0,P1); resc=false; \
    { const float dl=rm<-1e37f?0.f:rm; mhat=fadd_s(mhat,dl);     \
      _Pragma("unroll") for(int r=0;r<16;++r){P0[r]=fsub_s(P0[r],dl);P1[r]=fsub_s(P1[r],dl);} \
      if constexpr(MOBA){ _Pragma("unroll") for(int r=0;r<16;++r)negm[r]=-mhat; asm volatile("":"+v"(negm)); } } \
    _Pragma("unroll") for(int r=0;r<16;++r)P0[r]=__builtin_amdgcn_exp2f(P0[r]); }while(0)
  #define RESC() do{ if(resc){ asm volatile("s_waitcnt lgkmcnt(0)":::"memory"); \
      _Pragma("unroll") for(int d_=0;d_<2;++d_) _Pragma("unroll") for(int r=0;r<16;++r)o[d_][r]*=wsf[crow(r,hi)]; } }while(0)
  f32x16 pA0,pA1,pB0,pB1;
  int sl_prev=0,sl_cur=0,sl_next=SLOTB;
  #define ROT() do{sl_prev=sl_cur;sl_cur=sl_next;sl_next=(sl_next==(NSLOT-1)*SLOTB)?0:sl_next+SLOTB;}while(0)
  DMA_K(2,2*SLOTB);
  if constexpr(!MOBA){
    float s2=0.f;
    #pragma unroll
    for(int d0=0;d0<4;++d0){
      #pragma unroll
      for(int i=0;i<8;++i){ const float qv=__uint_as_float(((unsigned)(unsigned short)qr[d0][i])<<16); s2+=qv*qv; } }
    { auto rr=__builtin_amdgcn_permlane32_swap(__float_as_uint(s2),__float_as_uint(s2),false,false); s2=__uint_as_float(rr[0])+__uint_as_float(rr[1]); }
    #pragma unroll
    for(int o_=1;o_<32;o_<<=1)s2=__builtin_fmaxf(s2,__shfl_xor(s2,o_));
    if(lane==0)wsf[63]=s2; }
  WAIT_BAR(3);
  #define INITB(C0,C1,t) do{ const lds_fptr kbp_=kbl+TA(t)*64+4*hi; \
    _Pragma("unroll") for(int g_=0;g_<4;++g_){ const f32x4_t b0_=*(const __attribute__((address_space(3))) f32x4_t*)(kbp_+8*g_), b1_=*(const __attribute__((address_space(3))) f32x4_t*)(kbp_+32+8*g_); \
      _Pragma("unroll") for(int i_=0;i_<4;++i_){ C0[4*g_+i_]=b0_[i_]-mhat; C1[4*g_+i_]=b1_[i_]-mhat; } } }while(0)
  if constexpr(MOBA){
    if(qb>0){
      float qf[32];
      #pragma unroll
      for(int d0=0;d0<4;++d0){
        #pragma unroll
        for(int i=0;i<8;++i)qf[8*d0+i]=__uint_as_float(((unsigned)(unsigned short)qr[d0][i])<<16);}
      float v1=-INFINITY,v2=-INFINITY,v3=-INFINITY;int i1=-1,i2=-1,i3=-1;
      for(int j=0;j<qb;++j){ const lds_fptr kr=kbl+j*64+8*hi; float g=0.f;
        #pragma unroll
        for(int d0=0;d0<4;++d0){ const f32x4_t a_=*(const __attribute__((address_space(3))) f32x4_t*)(kr+16*d0), b_=*(const __attribute__((address_space(3))) f32x4_t*)(kr+16*d0+4);
          g+=qf[8*d0]*a_[0]+qf[8*d0+1]*a_[1]+qf[8*d0+2]*a_[2]+qf[8*d0+3]*a_[3]+qf[8*d0+4]*b_[0]+qf[8*d0+5]*b_[1]+qf[8*d0+6]*b_[2]+qf[8*d0+7]*b_[3]; }
        { auto rr=__builtin_amdgcn_permlane32_swap(__float_as_uint(g),__float_as_uint(g),false,false); g=__uint_as_float(rr[0])+__uint_as_float(rr[1]); }
        if(g>v1){v3=v2;i3=i2;v2=v1;i2=i1;v1=g;i1=j;} else if(g>v2){v3=v2;i3=i2;v2=g;i2=j;} else if(g>v3){v3=g;i3=j;} }
      amask=1u<<qb; if(i1>=0)amask|=1u<<i1; if(i2>=0)amask|=1u<<i2; if(i3>=0)amask|=1u<<i3; }
    qkt(pA0,pA1,Kbase,qr,negm,r32,hi);
  } else {
    float q2=0.f,k2=0.f;
    #pragma unroll
    for(int w_=0;w_<8;++w_){ q2=__builtin_fmaxf(q2,((const float*)(shm+LDS_WS))[w_*64+63]); k2+=__uint_as_float(kn2[w_]); }
    const float bnd=2.f*1.02f*__builtin_sqrtf(q2)*__builtin_sqrtf(k2)-kbl[q0]+64.f;
    const bool dead=(lane<NTA)&&(kbl[64*lane+63]+bnd<0.f);
    const int nskip=__builtin_popcountll(__ballot(dead));
    NT=NTA-nskip; NT=(NT+1)&~1; NT=NT<4?4:NT;
    INITB(pA0,pA1,0); qkt_acc(pA0,pA1,Kbase,qr,r32,hi); }
  asm volatile("s_nop 15\n\ts_nop 7":"+v"(pA0),"+v"(pA1));CMASK(pA0,pA1,0);
  START(pA0,pA1);
  _Pragma("unroll") for(int r=0;r<16;++r)pA1[r]=__builtin_amdgcn_exp2f(pA1[r]);
  WAIT_BAR(0);
  DMA_K(3,0);DMA_V(1,SLOTB);
  ROT();
  kload8(kf,kp0+sl_cur);
  WAIT_BAR(2);
  s16x4 vlo[8],vhi[8]; u32x4 pw0,pw1,pw2,pw3;
  #define PKW(P,B) cvtpk_s(P[B],P[B+1])
  #define PAF(k) __builtin_bit_cast(bf16x8,pw##k)
  #define VFR(i) (bf16x8){vlo[i][0],vlo[i][1],vlo[i][2],vlo[i][3],vhi[i][0],vhi[i][1],vhi[i][2],vhi[i][3]}
  #define PIN(x) asm volatile("":"+v"(x))
  #define MX3(a,b,c) __builtin_fmaxf(__builtin_fmaxf((a),(b)),(c))
  #define GAPA(MF,A0,A1,A2,A3,W0,W1,PW) do{ MF; sacc+=A0; sacc+=A1; sacc+=A2; sacc+=A3; PIN(sacc); W0; W1; PIN(PW); SBAR(); }while(0)
  #define EX(v) __builtin_amdgcn_exp2f(v)
  #define GAPB(MF,X,B) do{ MF; X[B]=EX(X[B]); X[B+1]=EX(X[B+1]); X[B+2]=EX(X[B+2]); X[B+3]=EX(X[B+3]); PIN(X); SBAR(); }while(0)
  #define VRD(i) do{ vlo[i]=vtr(vp_+(((i)>>2)*4096+((i)&3)*1024)); vhi[i]=vtr(vp_+(((i)>>2)*4096+((i)&3)*1024+512)); }while(0)
  #define KRD(G,j) do{ if(G){ kload2(kf,kp0+sl_next,j); SBAR(); } }while(0)
  #define CIN(X) (MOBA?negm:X)
  #define STEP(C0,C1,P0,P1,t,GK,GV,GL) do{ SBAR(); \
    if constexpr(!MOBA){ INITB(C0,C1,t); SBAR(); } \
    const lds_cptr vp_=vp0+sl_prev; \
    VRD(0); SBAR(); float sacc=(P0[0]+P0[1]); \
    GAPA(C0=__builtin_amdgcn_mfma_f32_32x32x16_bf16(kf[0],qr[0],CIN(C0),0,0,0), P0[2],P0[3],P0[4],P0[5],     pw0[0]=PKW(P0,0), pw0[1]=PKW(P0,2), pw0); \
    VRD(4); SBAR(); GAPA(C1=__builtin_amdgcn_mfma_f32_32x32x16_bf16(kf[1],qr[0],CIN(C1),0,0,0), P0[6],P0[7],P0[8],P0[9],     pw0[2]=PKW(P0,4), pw0[3]=PKW(P0,6), pw0); \
    VRD(1); SBAR(); GAPA(C0=__builtin_amdgcn_mfma_f32_32x32x16_bf16(kf[2],qr[1],C0,0,0,0),   P0[10],P0[11],P0[12],P0[13], pw1[0]=PKW(P0,8), pw1[1]=PKW(P0,10), pw1); \
    VRD(5); SBAR(); GAPA(C1=__builtin_amdgcn_mfma_f32_32x32x16_bf16(kf[3],qr[1],C1,0,0,0),   P0[14],P0[15],P1[0],P1[1],   pw1[2]=PKW(P0,12),pw1[3]=PKW(P0,14), pw1); \
    VRD(2); SBAR(); GAPA(C0=__builtin_amdgcn_mfma_f32_32x32x16_bf16(kf[4],qr[2],C0,0,0,0),   P1[2],P1[3],P1[4],P1[5],     pw2[0]=PKW(P1,0), pw2[1]=PKW(P1,2), pw2); \
    VRD(6); SBAR(); GAPA(C1=__builtin_amdgcn_mfma_f32_32x32x16_bf16(kf[5],qr[2],C1,0,0,0),   P1[6],P1[7],P1[8],P1[9],     pw2[2]=PKW(P1,4), pw2[3]=PKW(P1,6), pw2); \
    VRD(3); SBAR(); GAPA(C0=__builtin_amdgcn_mfma_f32_32x32x16_bf16(kf[6],qr[3],C0,0,0,0),   P1[10],P1[11],P1[12],P1[13], pw3[0]=PKW(P1,8), pw3[1]=PKW(P1,10), pw3); \
    VRD(7); SBAR(); GAPA(C1=__builtin_amdgcn_mfma_f32_32x32x16_bf16(kf[7],qr[3],C1,0,0,0),   P1[14],P1[15],0.f,0.f,       pw3[2]=PKW(P1,12),pw3[3]=PKW(P1,14), pw3); \
    if constexpr(MOBA){ const bool okp_=((amask>>(TA((t)-1)>>2))&1u)!=0u; l_reg+=okp_?sacc:0.f; \
      _Pragma("unroll") for(int i_=0;i_<4;++i_){ pw0[i_]=okp_?pw0[i_]:0u; pw1[i_]=okp_?pw1[i_]:0u; pw2[i_]=okp_?pw2[i_]:0u; pw3[i_]=okp_?pw3[i_]:0u; } } \
    else { l_reg+=sacc; } \
    if(GK){DMA_K((t)+3,sl_cur);} if(GV){DMA_V((t)+1,sl_next);} \
    CMASK(C0,C1,t); \
    { float a=MX3(C0[0],C0[1],C1[0]),b=MX3(C0[2],C0[3],C1[1]); a=MX3(a,C1[2],C1[3]); \
      _Pragma("unroll") for(int r=4;r<16;r+=4){a=MX3(a,C0[r],C0[r+1]);b=MX3(b,C0[r+2],C0[r+3]);a=MX3(a,C1[r],C1[r+1]);b=MX3(b,C1[r+2],C1[r+3]);} \
      float rm=__builtin_fmaxf(a,b); { auto rr=__builtin_amdgcn_permlane32_swap(__float_as_uint(rm),__float_as_uint(rm),false,false); rm=__builtin_fmaxf(__uint_as_float(rr[0]),__uint_as_float(rr[1])); } \
      resc=false; \
      if(__builtin_expect(__any(rm>(float)THRL),0)){ const float dl=__builtin_fmaxf(rm,0.f); mhat+=dl; \
        _Pragma("unroll") for(int r=0;r<16;++r){C0[r]-=dl;C1[r]-=dl;} \
        if constexpr(MOBA){ _Pragma("unroll") for(int r=0;r<16;++r)negm[r]=-mhat; asm volatile("":"+v"(negm)); } \
        const float f=__builtin_amdgcn_exp2f(-dl); l_reg*=f; if(hi==0)wsf[r32]=f; resc=true; } } \
    SBAR(); \
    GAPB(o[0]=__builtin_amdgcn_mfma_f32_32x32x16_bf16(PAF(0),VFR(0),o[0],0,0,0), C0,0); \
    GAPB(o[1]=__builtin_amdgcn_mfma_f32_32x32x16_bf16(PAF(0),VFR(4),o[1],0,0,0), C0,4); \
    KRD(GL,0); GAPB(o[0]=__builtin_amdgcn_mfma_f32_32x32x16_bf16(PAF(1),VFR(1),o[0],0,0,0), C0,8); \
    KRD(GL,1); GAPB(o[1]=__builtin_amdgcn_mfma_f32_32x32x16_bf16(PAF(1),VFR(5),o[1],0,0,0), C0,12); \
    KRD(GL,2); GAPB(o[0]=__builtin_amdgcn_mfma_f32_32x32x16_bf16(PAF(2),VFR(2),o[0],0,0,0), C1,0); \
    KRD(GL,3); GAPB(o[1]=__builtin_amdgcn_mfma_f32_32x32x16_bf16(PAF(2),VFR(6),o[1],0,0,0), C1,4); \
    GAPB(o[0]=__builtin_amdgcn_mfma_f32_32x32x16_bf16(PAF(3),VFR(3),o[0],0,0,0), C1,8); \
    GAPB(o[1]=__builtin_amdgcn_mfma_f32_32x32x16_bf16(PAF(3),VFR(7),o[1],0,0,0), C1,12); \
    }while(0)
  int t=1;
  for(;t+5<NT;t+=2){
    STEP(pB0,pB1,pA0,pA1,t,true,true,true);     WAIT_BAR(2); RESC(); ROT();
    STEP(pA0,pA1,pB0,pB1,t+1,true,true,true);   WAIT_BAR(2); RESC(); ROT();
  }
  #define ENDW(tt) do{ if((tt)+3<NT){WAIT_BAR(2);} else if((tt)+2<NT){WAIT_BAR(1);} else {WAIT_BAR(0);} }while(0)
  for(;t+1<NT;t+=2){
    STEP(pB0,pB1,pA0,pA1,t,(t+3<NT),(t+1<NT),(t+1<NT));       ENDW(t);   RESC(); ROT();
    STEP(pA0,pA1,pB0,pB1,t+1,(t+4<NT),(t+2<NT),(t+2<NT));     ENDW(t+1); RESC(); ROT();
  }
  STEP(pB0,pB1,pA0,pA1,NT-1,false,false,false); RESC();
  { float sacc=pB0[0]+pB0[1]; _Pragma("unroll") for(int r=2;r<16;++r)sacc+=pB0[r]; _Pragma("unroll") for(int r=0;r<16;++r)sacc+=pB1[r]; l_reg+=sacc;
    pw0=(u32x4){PKW(pB0,0),PKW(pB0,2),PKW(pB0,4),PKW(pB0,6)};pw1=(u32x4){PKW(pB0,8),PKW(pB0,10),PKW(pB0,12),PKW(pB0,14)};pw2=(u32x4){PKW(pB1,0),PKW(pB1,2),PKW(pB1,4),PKW(pB1,6)};pw3=(u32x4){PKW(pB1,8),PKW(pB1,10),PKW(pB1,12),PKW(pB1,14)};
    SBAR(); pv(o,vb0+sl_cur,PAF(0),PAF(1),PAF(2),PAF(3)); }
  #undef PKW
  #undef PAF
  #undef VFR
  #undef PIN
  #undef MX3
  #undef GAPA
  #undef GAPB
  #undef EX
  #undef VRD
  #undef KRD
  #undef STEP
  #undef CIN
  #undef INITB
  #undef ENDW
  {auto rr=__builtin_amdgcn_permlane32_swap(__float_as_uint(l_reg),__float_as_uint(l_reg),false,false);l_reg=__uint_as_float(rr[0])+__uint_as_float(rr[1]);}
  if(hi==0)wsf[32+r32]=l_reg;asm volatile("s_waitcnt lgkmcnt(0)":::"memory");
  float rli[16];
  #pragma unroll
  for(int r=0;r<16;++r)rli[r]=__builtin_amdgcn_rcpf(wsf[32+crow(r,hi)]);
  bf16*Ow=O+(rowbase+q0+wid*QBLK)*DM+h*D;
  { bf16*stg=(bf16*)(shm+LDS_OST)+wid*2048;
    #pragma unroll
    for(int r=0;r<16;++r){const int orow=crow(r,hi);
      #pragma unroll
      for(int d0=0;d0<2;++d0)stg[orow*64+d0*32+r32]=__float2bfloat16(o[d0][r]*rli[r]);}
    asm volatile("s_waitcnt lgkmcnt(0)":::"memory");
    #pragma unroll
    for(int i=0;i<4;++i){const int row=i*8+(lane>>3),ch=lane&7; const u32x4 v=*(const u32x4*)(stg+row*64+ch*8); ATTN_STORE16(Ow+(long)row*DM+ch*8,v);} }
  asm volatile("s_waitcnt lgkmcnt(0)\n\ts_barrier":::"memory");
  #undef DMA_K
  #undef DMA_V
  #undef TA
  #undef CMASK
  #undef START
  #undef RESC
  #undef ROT
}
constexpr int ATTN_LDS_BYTES=LDS_BYTES;
struct AttnTensors { const bf16* Q; const bf16* K; const bf16* V; bf16* O; };
struct AttnUnit { int b; int h; int qb; };
__device__ __forceinline__ void unit_of(int idx,AttnUnit&u){
  int grp=idx>>5; const int bh=idx&31; bool fox; int qb;
  if(grp<11){fox=false;qb=15-grp;} else if(grp<22){fox=true;qb=15-(grp-11);} else {grp-=22;fox=(grp&1)!=0;qb=4-(grp>>1);}
  u.b=bh>>3; u.h=(bh&7)+(fox?8:0); u.qb=qb;
}
template<int THRL=8> __device__ __forceinline__ void attn_phase(char*lds,const AttnTensors&T,const float*ksum,const float*kbias,const unsigned*kn2,int*qhead,volatile __attribute__((address_space(3))) int*slot){
  AttnUnit u;
  for(;;){
    if(threadIdx.x==0)slot[0]=atomicAdd(qhead,1);
    asm volatile("s_waitcnt vmcnt(0) lgkmcnt(0)\n\ts_barrier":::"memory");
    const int idx=slot[0];
    asm volatile("s_waitcnt lgkmcnt(0)\n\ts_barrier":::"memory");
    if(idx>=1024)break;
    unit_of(idx,u);
    if(u.h<8) attn_unit<THRL,true>(u.b,u.h,u.qb,T.Q,T.K,T.V,T.O,lds,ksum+(size_t)(u.b*8+u.h)*16*64,kn2);
    else attn_unit<THRL,false>(u.b,u.h,u.qb,T.Q,T.K,T.V,T.O,lds,kbias+(size_t)(u.b*8+(u.h-8))*SEQ,kn2+(u.b*8+(u.h-8))*8); }
}
#undef SBAR
#undef WAIT_BAR
}

constexpr size_t MiB = 1u << 20;
constexpr size_t WS_CTL = 0;
constexpr size_t WS_MOD = 1 * MiB;
constexpr size_t WS_ROPE = 1 * MiB + 256 * 1024;
constexpr size_t WS_LOGF = 1 * MiB + 512 * 1024;
constexpr size_t WS_KBIAS = 2 * MiB;
constexpr size_t WS_SP8 = 2 * MiB + 512 * 1024;
constexpr size_t WS_AGG = 3 * MiB;
constexpr size_t WS_LTW = 5 * MiB;
constexpr size_t WS_LG = 5 * MiB + 512 * 1024;
constexpr size_t WS_WMGU = 6 * MiB;
constexpr size_t WS_SB = 64 * MiB;
constexpr size_t WS_WMDN = 118 * MiB;
constexpr size_t WS_SBD = 65 * MiB;
constexpr size_t WS_WAIN = 174 * MiB;
constexpr size_t WS_WAOUT = 180 * MiB;
constexpr size_t WS_WFGU = 182 * MiB;
constexpr size_t WS_WFDN = 193 * MiB;
constexpr size_t WS_WLIN = 199 * MiB;
constexpr size_t WS_WLOUT = 204 * MiB;
constexpr size_t WS_WLG = 207 * MiB;
constexpr size_t WS_HA = 208 * MiB;
constexpr size_t WS_R = 240 * MiB;
constexpr size_t WS_Q = WS_R, WS_K = WS_R + 32 * MiB, WS_V = WS_R + 64 * MiB;
constexpr size_t WS_Y = WS_R + 96 * MiB;
constexpr size_t WS_O = WS_R + 128 * MiB;
constexpr size_t WS_HM = WS_R;
constexpr size_t WS_P2 = WS_R;
constexpr size_t WS_LA = WS_R + 80 * MiB;
constexpr size_t WS_XI = WS_R + 120 * MiB;
constexpr size_t WS_CONV = WS_R + 160 * MiB;
constexpr size_t WS_YL = WS_R + 200 * MiB;
constexpr size_t WS_HMID = WS_R;
constexpr size_t WS_YBUF = 174 * MiB;
constexpr size_t WS_END = 480 * MiB;
constexpr int CW_CNT = 64;
constexpr int CW_BAR = 4096;
constexpr int CW_KSUM = 65536;
constexpr int CW_AQ = 320;
constexpr int CW_CQG = 128, CW_CQD = 192;
constexpr int CW_KN2 = 98304;

constexpr int NWAVES = 8;
constexpr int RING_BYTES = 131072, CTRL_OFF = 139264, MISC_OFF = CTRL_OFF + 320, LDS_BYTES = 147456;

#define LAS __attribute__((address_space(3)))
#define GAS __attribute__((address_space(1)))
typedef GAS unsigned gu32;
#define LDS_WAIT() asm volatile("s_waitcnt lgkmcnt(0)" ::: "memory")

#define XB_TMO      128
#define XB_XCNT(j)  (256  + 64 * (j))
#define XB_XSUB(j)  (1280 + 64 * (j))
#define XB_XGEN(j)  (2304 + 64 * (j))
#define XB_TOP      3328
#define XB_TOPGEN   3392
#define XCD_BAR_WORDS 3456
#define XB_SPIN_CAP (1u << 18)

__device__ __forceinline__ unsigned xb_ld(unsigned* p)              { return __hip_atomic_load(p, __ATOMIC_RELAXED, __HIP_MEMORY_SCOPE_AGENT); }
__device__ __forceinline__ unsigned xb_add(unsigned* p, unsigned v) { return __hip_atomic_fetch_add(p, v, __ATOMIC_RELAXED, __HIP_MEMORY_SCOPE_AGENT); }
__device__ __forceinline__ unsigned xb_xcc_id() { return (unsigned)__builtin_amdgcn_s_getreg((3 << 11) | 20) & 0xFu; }
#define XB_SPIN(cond, bar) do { unsigned _sp = 0; while (cond) { __builtin_amdgcn_s_sleep(1); \
    if ((++_sp & 255u) == 0u) { if (xb_ld(&(bar)[XB_TMO])) break; if (_sp > XB_SPIN_CAP) { atomicAdd(&(bar)[XB_TMO], 1u); break; } } } } while (0)

struct XcdBarrier {
    unsigned* bar; unsigned x;
    volatile LAS unsigned* st;
};

__device__ __forceinline__ XcdBarrier xcd_barrier_post(unsigned* bar, volatile LAS unsigned* st) {
    XcdBarrier b; b.bar = bar; b.x = xb_xcc_id(); b.st = st;
    if (threadIdx.x == 0) (void)xb_add(&bar[XB_XCNT(b.x)], 1u);
    return b;
}
__device__ __forceinline__ void xcd_barrier_complete(unsigned* bar, unsigned x, unsigned& nloc, unsigned& nx) {
    const unsigned G = gridDim.x * gridDim.y * gridDim.z;
    unsigned sum, cnt, mine, sp = 0u;
    for (;;) {
        sum = 0u; cnt = 0u; mine = 0u;
#pragma unroll
        for (unsigned j = 0; j < 16; ++j) { const unsigned c = xb_ld(&bar[XB_XCNT(j)]); sum += c; cnt += (c > 0u) ? 1u : 0u; mine = (j == x) ? c : mine; }
        if (sum == G) break;
        __builtin_amdgcn_s_sleep(1);
        if ((++sp & 255u) == 0u) { if (xb_ld(&bar[XB_TMO])) break; if (sp > XB_SPIN_CAP) { atomicAdd(&bar[XB_TMO], 1u); break; } }
    }
    nloc = mine > 0u ? mine : 1u; nx = cnt > 0u ? cnt : 1u;
}

__device__ __forceinline__ void xcd_barrier(const XcdBarrier& b) {
    asm volatile("s_waitcnt vmcnt(0)" ::: "memory");
    __syncthreads();
    if (threadIdx.x == 0) {
        unsigned* bar = b.bar;
        __builtin_amdgcn_s_waitcnt(0);
        unsigned nloc = b.st[0], nx = b.st[1];
        if (nloc == 0u) { xcd_barrier_complete(bar, b.x, nloc, nx); b.st[0] = nloc; b.st[1] = nx; }
        const unsigned old = xb_add(&bar[XB_XSUB(b.x)], 1u);
        const unsigned gen = old / nloc;
        if (old + 1u == (gen + 1u) * nloc) {
            __builtin_amdgcn_fence(__ATOMIC_RELEASE, "agent");
            asm volatile("s_waitcnt vmcnt(0)" ::: "memory");
            const unsigned og = xb_add(&bar[XB_TOP], 1u);
            const unsigned tg = og / nx;
            if (og + 1u == (tg + 1u) * nx) xb_add(&bar[XB_TOPGEN], 1u);
            else XB_SPIN(xb_ld(&bar[XB_TOPGEN]) == tg, bar);
            __builtin_amdgcn_fence(__ATOMIC_ACQUIRE, "agent");
            xb_add(&bar[XB_XGEN(b.x)], 1u);
            asm volatile("s_waitcnt vmcnt(0)" ::: "memory");
        } else {
            XB_SPIN(xb_ld(&bar[XB_XGEN(b.x)]) == gen, bar);
            __builtin_amdgcn_fence(__ATOMIC_ACQUIRE, "agent");
            asm volatile("s_waitcnt vmcnt(0)" ::: "memory");
        }
    }
    __syncthreads();
}

__device__ __forceinline__ void cvt_item(const float* W, int ld, int K, int k0, int n0, u16* WT, int drow0, LAS float* scr, int lane) {
    float tv[32];
#pragma unroll
    for (int i = 0; i < 32; ++i) { const int kk = 2 * i + (lane >> 5); tv[i] = __builtin_nontemporal_load(W + (size_t)(k0 + kk) * ld + n0 + (lane & 31)); }
#pragma unroll
    for (int i = 0; i < 32; ++i) { const int kk = 2 * i + (lane >> 5); scr[kk * 33 + (lane & 31)] = tv[i]; }
    LDS_WAIT(); asm volatile("" ::: "memory");
    const int c = lane & 7;
#pragma unroll
    for (int j = 0; j < 4; ++j) { const int n = (lane >> 3) + 8 * j; const LAS float* s = scr + (8 * c) * 33 + n;
        u32x4 o; o.x = pk2(s[0 * 33], s[1 * 33]); o.y = pk2(s[2 * 33], s[3 * 33]); o.z = pk2(s[4 * 33], s[5 * 33]); o.w = pk2(s[6 * 33], s[7 * 33]);
        *(u32x4*)(WT + (size_t)(drow0 + n) * K + k0 + 8 * c) = o; }
    LDS_WAIT(); asm volatile("" ::: "memory");
}
__device__ __forceinline__ void cvt_job(const float* W, int ld, int K, int N, u16* WT, int mode, int r, LAS float* scr, int lane) {
    const int nblk = N / 32, kb = r / nblk, nb = r % nblk, n0 = nb * 32;
    const int drow0 = mode == 0 ? n0 : (n0 + (n0 >> 7) * 128 + (mode == 2 ? 128 : 0));
    cvt_item(W, ld, K, kb * 64, n0, WT, drow0, scr, lane);
}

__device__ __forceinline__ void cvt8_item(const float* W, int ld, int n0, unsigned char* WT, float* inv, int drow0, LAS float* t, int tid) {
    const int lane = tid & 63, wave = tid >> 6;
#pragma unroll
    for (int half = 0; half < 2; ++half) {
        float tv[32];
#pragma unroll
        for (int i = 0; i < 32; ++i) { const int kk = (half * 32 + i) * 16 + wave * 2 + (lane >> 5); tv[i] = __builtin_nontemporal_load(W + (size_t)kk * ld + n0 + (lane & 31)); }
#pragma unroll
        for (int i = 0; i < 32; ++i) { const int kk = (half * 32 + i) * 16 + wave * 2 + (lane >> 5); t[(lane & 31) * 1028 + kk] = tv[i]; }
    }
    __syncthreads();
#pragma unroll 1
    for (int r = 0; r < 4; ++r) { const int n = wave * 4 + r; const LAS float* row = t + n * 1028;
        f32x4 v[4]; float mx = 0.f;
#pragma unroll
        for (int j = 0; j < 4; ++j) { v[j] = *(const LAS f32x4*)(row + 256 * j + 4 * lane); mx = __builtin_fmaxf(mx, __builtin_fmaxf(__builtin_fmaxf(__builtin_fabsf(v[j][0]), __builtin_fabsf(v[j][1])), __builtin_fmaxf(__builtin_fabsf(v[j][2]), __builtin_fabsf(v[j][3])))); }
#pragma unroll
        for (int o = 1; o < 64; o <<= 1) mx = __builtin_fmaxf(mx, __shfl_xor(mx, o));
        const int e = (int)((__float_as_uint(mx) >> 23) & 0xffu) - 127;
        const bool ok = mx > 1e-30f && mx < 1e30f;
        const float sc = ok ? __uint_as_float((unsigned)(127 + 7 - e) << 23) : 1.f, isc = ok ? __uint_as_float((unsigned)(127 - 7 + e) << 23) : 1.f;
#pragma unroll
        for (int j = 0; j < 4; ++j) *(unsigned*)(WT + (size_t)(drow0 + n) * 1024 + 256 * j + 4 * lane) = pk4_fp8(v[j][0] * sc, v[j][1] * sc, v[j][2] * sc, v[j][3] * sc);
        if (lane == 0) inv[drow0 + n] = isc;
    }
    __syncthreads();
}

__device__ __forceinline__ void cvt8d_item(const float* W, int n0, unsigned char* WT, float* inv, LAS float* t, int tid) {
    const int lane = tid & 63, wave = tid >> 6;
    LAS float* red = t + 32 * 1028;
    float mx = 0.f;
    for (int i0 = 0; i0 < 224; i0 += 32) { float tv[32];
#pragma unroll
        for (int i = 0; i < 32; ++i) { const int kk = (i0 + i) * 16 + wave * 2 + (lane >> 5); tv[i] = W[(size_t)kk * 1024 + n0 + (lane & 31)]; }
#pragma unroll
        for (int i = 0; i < 32; ++i) mx = __builtin_fmaxf(mx, __builtin_fabsf(tv[i])); }
    mx = __builtin_fmaxf(mx, __shfl_xor(mx, 32));
    if (lane < 32) red[wave * 32 + lane] = mx;
    __syncthreads();
    if (tid < 32) { float m8 = 0.f;
#pragma unroll
        for (int w8 = 0; w8 < 8; ++w8) m8 = __builtin_fmaxf(m8, red[w8 * 32 + tid]);
        const int e = (int)((__float_as_uint(m8) >> 23) & 0xffu) - 127; const bool ok = m8 > 1e-30f && m8 < 1e30f;
        red[256 + tid] = ok ? __uint_as_float((unsigned)(127 + 7 - e) << 23) : 1.f; inv[n0 + tid] = ok ? __uint_as_float((unsigned)(127 - 7 + e) << 23) : 1.f; }
    __syncthreads();
#pragma unroll 1
    for (int k0 = 0; k0 < 3584; k0 += 1024) { const int nh = (k0 + 1024 <= 3584) ? 2 : 1;
        for (int half = 0; half < nh; ++half) { float tv[32];
#pragma unroll
            for (int i = 0; i < 32; ++i) { const int kk = (half * 32 + i) * 16 + wave * 2 + (lane >> 5); tv[i] = __builtin_nontemporal_load(W + (size_t)(k0 + kk) * 1024 + n0 + (lane & 31)); }
#pragma unroll
            for (int i = 0; i < 32; ++i) { const int kk = (half * 32 + i) * 16 + wave * 2 + (lane >> 5); t[(lane & 31) * 1028 + kk] = tv[i]; } }
        __syncthreads();
#pragma unroll 1
        for (int r = 0; r < 4; ++r) { const int n = wave * 4 + r; const LAS float* row = t + n * 1028; const float sc = red[256 + n];
#pragma unroll
            for (int j = 0; j < 4; ++j) if (j < 2 * nh) { const f32x4 v = *(const LAS f32x4*)(row + 256 * j + 4 * lane);
                *(unsigned*)(WT + (size_t)(n0 + n) * 3584 + k0 + 256 * j + 4 * lane) = pk4_fp8(v[0] * sc, v[1] * sc, v[2] * sc, v[3] * sc); } }
        __syncthreads();
    }
}


namespace lru {
typedef short bf16x8 __attribute__((ext_vector_type(8)));
typedef float f32x2 __attribute__((ext_vector_type(2)));
constexpr int AP = 272;
constexpr int L_AS = 0, L_BS = 256 * AP, L_GB = L_BS + 64 * AP, L_YS = L_GB + 256 * 64, L_WA = L_YS + 256 * 64, L_CW = L_WA + 8 * 32 * 8, L_END = L_CW + 5 * 128 * 4;
static_assert(L_END <= 131072, "LDS");
__device__ __forceinline__ float bfl(unsigned short v) { return __uint_as_float(((unsigned)v) << 16); }
__device__ __forceinline__ float gelu_fast(float x) { const float u2 = 1.5957691216057308f * (x + 0.044715f * x * x * x); return x - x * __builtin_amdgcn_rcpf(1.f + __expf(u2)); }
__device__ __forceinline__ void seg_apply(float& h, float A, float H) { h = __expf(A) * h + H; }
__device__ __forceinline__ void phase(LAS unsigned char* lds, int job, const float* cw, const float* cb, const u16* P2, u16* YL, const u16* WLG, const float* tab) {
    const int tid = threadIdx.x, lane = tid & 63, w = tid >> 6, l15 = lane & 15, g = lane >> 4;
    const int b = job / 40, n = (job % 40) >> 2, q = job & 3;
    const size_t row0 = (size_t)b * 4096;
    { const int r = tid >> 3, pc = tid & 7;
        const u16* src = WLG + ((size_t)n * 256 + (r < 32 ? 32 * q + r : 128 + 32 * q + (r - 32))) * 128 + pc * 16;
        const u32x4 v0 = *(const u32x4*)src, v1 = *(const u32x4*)(src + 8);
        *(LAS u32x4*)(lds + L_BS + r * AP + pc * 32) = v0; *(LAS u32x4*)(lds + L_BS + r * AP + pc * 32 + 16) = v1; }
    float ba[2], bx[2], sp[2];
#pragma unroll
    for (int chn = 0; chn < 2; ++chn) { const int c = 128 * n + 32 * q + 16 * chn + l15; ba[chn] = tab[c]; bx[chn] = tab[1280 + c]; sp[chn] = tab[2560 + c]; }
    u32x4 areg[11], gbreg[2];
    if (tid < 128) { LAS float* cwl = (LAS float*)(lds + L_CW); const int c = 128 * n + tid; cwl[tid] = cw[c]; cwl[128 + tid] = cw[1280 + c]; cwl[256 + tid] = cw[2560 + c]; cwl[384 + tid] = cw[3840 + c]; cwl[512 + tid] = cb[c]; }
    __syncthreads();
    const u16* aptr = P2 + (row0 + (tid >> 4) * 8) * 2560 + 1280 + 128 * n + (tid & 15) * 8;
    const u16* gptr = P2 + (row0 + (tid >> 2)) * 2560 + 128 * n + 32 * q + (tid & 3) * 8;
#define LRU_LOAD(t) do { _Pragma("unroll") for (int i = 0; i < 11; ++i) areg[i] = ((t) * 256 + (tid >> 4) * 8 + i >= 3) ? *(const u32x4*)(aptr + ((long)(t) * 256 + i - 3) * 2560) : (u32x4){0u, 0u, 0u, 0u}; \
        _Pragma("unroll") for (int i = 0; i < 2; ++i) gbreg[i] = *(const u32x4*)(gptr + ((size_t)(t) * 256 + 128 * i) * 2560); } while (0)
#define LRU_STASH() do { float cwr[4][8], cbr[8]; { const LAS float* cwl_ = (const LAS float*)(lds + L_CW) + (tid & 15) * 8; \
            _Pragma("unroll") for (int e_ = 0; e_ < 8; ++e_) { cwr[0][e_] = cwl_[e_]; cwr[1][e_] = cwl_[128 + e_]; cwr[2][e_] = cwl_[256 + e_]; cwr[3][e_] = cwl_[384 + e_]; cbr[e_] = cwl_[512 + e_]; } } \
        _Pragma("unroll") for (int i = 0; i < 8; ++i) { u32x4 o_; \
            _Pragma("unroll") for (int q_ = 0; q_ < 4; ++q_) { \
                const float lo_ = cbr[2 * q_] + cwr[0][2 * q_] * __uint_as_float(areg[i][q_] << 16) + cwr[1][2 * q_] * __uint_as_float(areg[i + 1][q_] << 16) + cwr[2][2 * q_] * __uint_as_float(areg[i + 2][q_] << 16) + cwr[3][2 * q_] * __uint_as_float(areg[i + 3][q_] << 16); \
                const float hi_ = cbr[2 * q_ + 1] + cwr[0][2 * q_ + 1] * __uint_as_float(areg[i][q_] & 0xffff0000u) + cwr[1][2 * q_ + 1] * __uint_as_float(areg[i + 1][q_] & 0xffff0000u) + cwr[2][2 * q_ + 1] * __uint_as_float(areg[i + 2][q_] & 0xffff0000u) + cwr[3][2 * q_ + 1] * __uint_as_float(areg[i + 3][q_] & 0xffff0000u); \
                o_[q_] = pk2(lo_, hi_); } \
            *(LAS u32x4*)(lds + L_AS + ((tid >> 4) * 8 + i) * AP + (tid & 15) * 16) = o_; } \
        _Pragma("unroll") for (int i = 0; i < 2; ++i) *(LAS u32x4*)(lds + L_GB + ((tid >> 2) + 128 * i) * 64 + (tid & 3) * 16) = gbreg[i]; } while (0)
    LRU_LOAD(0); LRU_STASH();
    __syncthreads();
    float hrun[2] = {0.f, 0.f};
    const int aoff = L_AS + (32 * w + l15) * AP + 16 * g, boff = L_BS + l15 * AP + 16 * g;
    for (int t = 0; t < 16; ++t) {
        if (t + 1 < 16) LRU_LOAD(t + 1);
        f32x4 acc[2][4];
#pragma unroll
        for (int m = 0; m < 2; ++m)
#pragma unroll
            for (int nn = 0; nn < 4; ++nn) acc[m][nn] = (f32x4){0.f, 0.f, 0.f, 0.f};
#pragma unroll
        for (int ks = 0; ks < 4; ++ks) {
            bf16x8 af[2], bfr[4];
#pragma unroll
            for (int m = 0; m < 2; ++m) af[m] = *(const LAS bf16x8*)(lds + aoff + 16 * m * AP + 64 * ks);
#pragma unroll
            for (int nn = 0; nn < 4; ++nn) bfr[nn] = *(const LAS bf16x8*)(lds + boff + 16 * nn * AP + 64 * ks);
#pragma unroll
            for (int m = 0; m < 2; ++m)
#pragma unroll
                for (int nn = 0; nn < 4; ++nn) acc[m][nn] = __builtin_amdgcn_mfma_f32_16x16x32_bf16(af[m], bfr[nn], acc[m][nn], 0, 0, 0);
        }
        float E[2][2][4], hl[2][2][4];
#pragma unroll
        for (int chn = 0; chn < 2; ++chn)
#pragma unroll
            for (int m = 0; m < 2; ++m) { float pe = 1.f, hh = 0.f;
#pragma unroll
                for (int r = 0; r < 4; ++r) { const int rt = 32 * w + 16 * m + 4 * g + r;
                    const float cv = bfl(*(const LAS unsigned short*)(lds + L_AS + rt * AP + (32 * q + 16 * chn + l15) * 2));
                    const float la = sp[chn] * __builtin_amdgcn_rcpf(1.f + __expf(-(acc[m][chn][r] + ba[chn])));
                    const float ig = __builtin_amdgcn_rcpf(1.f + __expf(-(acc[m][chn + 2][r] + bx[chn])));
                    const float av = __expf(la), t2 = 2.f * la;
                    const float om = t2 > -0.02f ? -t2 * (1.f + t2 * (0.5f + t2 * (0.16666667f + t2 * 0.041666667f))) : 1.f - av * av;
                    const float xi = __builtin_amdgcn_sqrtf(om) * (ig * cv);
                    pe *= av; hh = av * hh + xi; E[chn][m][r] = pe; hl[chn][m][r] = hh; } }
        float gE[2][2][4], gH[2][2][4];
#pragma unroll
        for (int chn = 0; chn < 2; ++chn)
#pragma unroll
            for (int m = 0; m < 2; ++m)
#pragma unroll
                for (int gg = 0; gg < 4; ++gg) { gE[chn][m][gg] = __shfl(E[chn][m][3], l15 + 16 * gg); gH[chn][m][gg] = __shfl(hl[chn][m][3], l15 + 16 * gg); }
        if (g == 0) {
#pragma unroll
            for (int chn = 0; chn < 2; ++chn) { float Ew = 1.f, Hw = 0.f;
#pragma unroll
                for (int m = 0; m < 2; ++m)
#pragma unroll
                    for (int gg = 0; gg < 4; ++gg) { Hw = gE[chn][m][gg] * Hw + gH[chn][m][gg]; Ew *= gE[chn][m][gg]; }
                *(LAS f32x2*)(lds + L_WA + (w * 32 + 16 * chn + l15) * 8) = (f32x2){Ew, Hw}; }
        }
        __syncthreads();
#pragma unroll
        for (int chn = 0; chn < 2; ++chn) {
            float hw = hrun[chn], hall = hrun[chn];
#pragma unroll
            for (int ww = 0; ww < 8; ++ww) { const f32x2 sg = *(const LAS f32x2*)(lds + L_WA + (ww * 32 + 16 * chn + l15) * 8); hall = sg[0] * hall + sg[1]; if (ww < w) hw = hall; }
            hrun[chn] = hall;
            float h0 = hw;
#pragma unroll
            for (int gg = 0; gg < 3; ++gg) if (gg < g) h0 = gE[chn][0][gg] * h0 + gH[chn][0][gg];
            float h1 = hw;
#pragma unroll
            for (int gg = 0; gg < 4; ++gg) h1 = gE[chn][0][gg] * h1 + gH[chn][0][gg];
#pragma unroll
            for (int gg = 0; gg < 3; ++gg) if (gg < g) h1 = gE[chn][1][gg] * h1 + gH[chn][1][gg];
#pragma unroll
            for (int m = 0; m < 2; ++m)
#pragma unroll
                for (int r = 0; r < 4; ++r) { const int rt = 32 * w + 16 * m + 4 * g + r; const int cc = 16 * chn + l15;
                    const float h = E[chn][m][r] * (m == 0 ? h0 : h1) + hl[chn][m][r];
                    const float gb = bfl(*(const LAS unsigned short*)(lds + L_GB + rt * 64 + cc * 2));
                    *(LAS unsigned short*)(lds + L_YS + rt * 64 + cc * 2) = f2bf(gelu_fast(gb) * h); }
        }
        __syncthreads();
#pragma unroll
        for (int i = 0; i < 2; ++i) { const int rr = (tid >> 2) + 128 * i; const u32x4 v = *(const LAS u32x4*)(lds + L_YS + rr * 64 + (tid & 3) * 16);
            *(u32x4*)(YL + (row0 + (size_t)t * 256 + rr) * 1280 + 128 * n + 32 * q + (tid & 3) * 8) = v; }
        if (t + 1 < 16) LRU_STASH();
        __syncthreads();
    }
#undef LRU_LOAD
#undef LRU_STASH
}
}

struct Args { const float* in[25]; float* out; char* ws; int ph_lo, ph_hi, li, pad; };

#define PHASE_VARS char* ws = a.ws; \
    const float* x = a.in[0]; const float* norm_g = a.in[4]; float* mod = (float*)(ws + WS_MOD); const float* mod0 = mod; const float* mod1 = mod + 4 * MODW; \
    float* rope = (float*)(ws + WS_ROPE); float* logf = (float*)(ws + WS_LOGF); float* kbias = (float*)(ws + WS_KBIAS); float* agg = (float*)(ws + WS_AGG); \
    int* ltw = (int*)(ws + WS_LTW); float* lg = (float*)(ws + WS_LG); int* cnt = (int*)(ws + WS_CTL) + CW_CNT; float* ksum = (float*)(ws + WS_CTL) + CW_KSUM; \
    u16* HA = (u16*)(ws + WS_HA); float* Y = (float*)(ws + WS_Y); float* out = a.out; \
    (void)x; (void)norm_g; (void)mod0; (void)mod1; (void)rope; (void)logf; (void)kbias; (void)agg; (void)ltw; (void)lg; (void)cnt; (void)ksum; (void)HA; (void)Y; (void)out;

__device__ __forceinline__ void conv_drain(const float* wg, const float* wu, const float* wd, char* ws, LAS unsigned char* lds, int ng, int nd) {
    const int tid = threadIdx.x; volatile LAS int* qs_ = (volatile LAS int*)(lds + CTRL_OFF + 64);
    for (int n_ = 0; n_ < nd; ++n_) { __syncthreads(); if (tid == 0) qs_[0] = atomicAdd((int*)(ws + WS_CTL) + CW_CQD, 1); __syncthreads(); const int it_ = qs_[0]; if (it_ >= 8 * 32) break;
        { const int e_ = it_ >> 5, n0_ = (it_ & 31) * 32; cvt8d_item(wd + (size_t)e_ * DEXP * D, n0_, (unsigned char*)(ws + WS_WMDN) + (size_t)e_ * 1024 * 3584, (float*)(ws + WS_SBD) + (size_t)e_ * 1024, (LAS float*)lds, tid); } }
    for (int n_ = 0; n_ < ng; ++n_) { __syncthreads(); if (tid == 0) qs_[0] = atomicAdd((int*)(ws + WS_CTL) + CW_CQG, 1); __syncthreads(); const int it_ = qs_[0]; if (it_ >= 16 * 112) break;
        { const int j_ = it_ / 112, nb_ = it_ % 112, e_ = j_ >> 1, which_ = j_ & 1, n0_ = nb_ * 32;
          cvt8_item((which_ ? wu : wg) + (size_t)e_ * D * DEXP, DEXP, n0_, (unsigned char*)(ws + WS_WMGU) + (size_t)e_ * 7168 * 1024, (float*)(ws + WS_SB) + (size_t)e_ * 7168, n0_ + (n0_ >> 7) * 128 + which_ * 128, (LAS float*)lds, tid); } }
}
#define CONV_DRAIN(NG, ND) conv_drain(a.in[22], a.in[23], a.in[24], ws, lds, (NG), (ND))
__global__ void __launch_bounds__(NWAVES * 64, 2) mega(Args a) {
    extern __shared__ __attribute__((aligned(16))) unsigned char lds_raw[];
    LAS unsigned char* lds = (LAS unsigned char*)lds_raw;
    volatile LAS unsigned* MISC = (volatile LAS unsigned*)(lds + MISC_OFF);
    const int tid = threadIdx.x, lane = tid & 63, wave = __builtin_amdgcn_readfirstlane(tid >> 6);
    const int G = gridDim.x, bid = blockIdx.x;
    unsigned* ctl = (unsigned*)(a.ws + WS_CTL);
    for (int u = tid; u < (LDS_BYTES - CTRL_OFF) / 4; u += NWAVES * 64) ((LAS unsigned*)(lds + CTRL_OFF))[u] = 0u;
    __syncthreads();
    const int lo = a.ph_lo, hi = a.ph_hi;
    const bool multi = (hi - lo) > 1;
    XcdBarrier bar; bar.bar = ctl + CW_BAR + a.li * XCD_BAR_WORDS; bar.x = 0; bar.st = nullptr;
    if (multi) bar = xcd_barrier_post(ctl + CW_BAR + a.li * XCD_BAR_WORDS, MISC + 8);
#ifndef PHMASK
#define PHMASK 0x7ffff
#endif
#define IN(k) ((((PHMASK) >> (k)) & 1) && lo <= (k) && (k) < hi)
#define SEAM(k) do { if (IN(k) && IN((k) + 1)) xcd_barrier(bar); } while (0)
#ifndef REPEAT_MASK
#define REPEAT_MASK 0
#endif
#define NREP(k) ((((REPEAT_MASK) >> (k)) & 1) ? 2 : 1)
    const int gw = bid * NWAVES + wave, NGW = G * NWAVES;

    if (IN(0)) { PHASE_VARS
        {
            LAS float* scs = (LAS float*)lds; LAS float* part = (LAS float*)(lds + 16384);
            const float* c = a.in[1];
            for (int i = tid; i < NB * D; i += NWAVES * 64) { const float v = c[i]; scs[i] = v / (1.f + __expf(-v)); }
            __syncthreads();
            const int n = bid * 48 + (lane < 48 ? lane : 47), l = n / MODW, nn = n % MODW;
            const float* w = a.in[2] + (size_t)l * D * MODW + nn + (size_t)(wave * 128) * MODW;
            float a0 = 0.f, a1 = 0.f, a2 = 0.f, a3 = 0.f;
            for (int k0 = 0; k0 < 128; k0 += 32) { float wv[32];
#pragma unroll
                for (int k = 0; k < 32; ++k) wv[k] = __builtin_nontemporal_load(w + (size_t)(k0 + k) * MODW);
#pragma unroll
                for (int k = 0; k < 32; ++k) { const int kk = wave * 128 + k0 + k; a0 += scs[kk] * wv[k]; a1 += scs[D + kk] * wv[k]; a2 += scs[2 * D + kk] * wv[k]; a3 += scs[3 * D + kk] * wv[k]; } }
            part[(wave * 64 + lane) * 4 + 0] = a0; part[(wave * 64 + lane) * 4 + 1] = a1; part[(wave * 64 + lane) * 4 + 2] = a2; part[(wave * 64 + lane) * 4 + 3] = a3;
            __syncthreads();
            if (tid < 192) { const int col = tid >> 2, b = tid & 3; float s = 0.f;
#pragma unroll
                for (int w8 = 0; w8 < 8; ++w8) s += part[(w8 * 64 + col) * 4 + b];
                const int n2 = bid * 48 + col, l2 = n2 / MODW, nn2 = n2 % MODW;
                mod[(l2 * 4 + b) * MODW + nn2] = s + a.in[3][l2 * MODW + nn2]; }
            __syncthreads();
        }
        if (gw < 512) { const int i = gw * 64 + lane; const int pos = i >> 3, f = i & 7;
            const float inv = exp2f(-(float)f * 0.125f * 18.931568569324174f); const float ang = (float)pos * inv; float sn, cs; sincosf(ang, &sn, &cs);
            rope[2 * i] = cs; rope[2 * i + 1] = sn; }
        if (bid == 255) { for (int c = tid; c < DRNN; c += NWAVES * 64) { float* tb = (float*)(ws + WS_SP8); tb[c] = a.in[15][c]; tb[1280 + c] = a.in[17][c]; tb[2560 + c] = -8.f * log1pf(__expf(-a.in[18][c])); } }
        {
            LAS float* scr = (LAS float*)(lds + wave * 16384);
            constexpr int I_AIN = 16 * 96, I_AOUT = 16 * 32, I_FG = 16 * 88, I_FD = 44 * 32, I_LIN = 16 * 80, I_LOUT = 20 * 32, I_LG = 2 * 4, I_MG = 16 * 112, I_MD = 56 * 32;
            int cum = 0;
#define CVT_LOOP(NIT, CALL) do { for (int r = (gw + NGW - (cum % NGW)) % NGW; r < (NIT); r += NGW) { CALL; } cum += (NIT); } while (0)
            CVT_LOOP(I_AIN, cvt_job(a.in[5], NIN, D, 3072, (u16*)(ws + WS_WAIN), 0, r, scr, lane));
            CVT_LOOP(I_AOUT, cvt_job(a.in[7], D, D, D, (u16*)(ws + WS_WAOUT), 0, r, scr, lane));
            CVT_LOOP(I_FG, cvt_job(a.in[8], DFF, D, DFF, (u16*)(ws + WS_WFGU), 1, r, scr, lane));
            CVT_LOOP(I_FG, cvt_job(a.in[9], DFF, D, DFF, (u16*)(ws + WS_WFGU), 2, r, scr, lane));
            CVT_LOOP(I_FD, cvt_job(a.in[10], D, DFF, D, (u16*)(ws + WS_WFDN), 0, r, scr, lane));
            CVT_LOOP(I_LIN, cvt_job(a.in[11], 2560, D, 2560, (u16*)(ws + WS_WLIN), 0, r, scr, lane));
            CVT_LOOP(I_LOUT, cvt_job(a.in[19], D, DRNN, D, (u16*)(ws + WS_WLOUT), 0, r, scr, lane));
            CVT_LOOP(10 * I_LG, cvt_job(a.in[14] + (size_t)(r / I_LG) * 16384, 128, 128, 128, (u16*)(ws + WS_WLG) + (size_t)(r / I_LG) * 256 * 128, 0, r % I_LG, scr, lane));
            CVT_LOOP(10 * I_LG, cvt_job(a.in[16] + (size_t)(r / I_LG) * 16384, 128, 128, 128, (u16*)(ws + WS_WLG) + (size_t)(r / I_LG) * 256 * 128 + 128 * 128, 0, r % I_LG, scr, lane));
#undef CVT_LOOP
            __syncthreads();
        }
    }
    SEAM(0);
    _Pragma("unroll") for (int rep_ = 0; rep_ < NREP(1); ++rep_) { if (rep_) xcd_barrier(bar);
    if (IN(1)) { PHASE_VARS RowP p{}; p.xres = x; p.y_mode = 0; p.g_pre = norm_g + 0 * D; p.sh = mod0 + 0 * D; p.sc = mod0 + 1 * D; p.hout = HA;
        p.extra = 1; p.wex = a.in[5]; p.wex_ld = NIN; p.wex_off = 3072; p.bex = a.in[6]; p.logf = logf; row_pass(p, bid, G, (LAS float*)lds); }
    }
    SEAM(1);
    _Pragma("unroll") for (int rep_ = 0; rep_ < NREP(2); ++rep_) { if (rep_) xcd_barrier(bar);
    if (IN(2)) { PHASE_VARS
        if (bid < 32) { LAS float* tot = (LAS float*)(lds + CTRL_OFF + 1024);
            const float* src = logf + (size_t)bid * S + tid * 8; float v[8]; float s = 0.f;
#pragma unroll
            for (int i = 0; i < 8; ++i) { s += src[i]; v[i] = s; }
            float inc = s;
#pragma unroll
            for (int o = 1; o < 64; o <<= 1) { const float up = __shfl_up(inc, o); if (lane >= o) inc += up; }
            if (lane == 63) tot[wave] = inc;
            __syncthreads();
            float base = inc - s;
#pragma unroll
            for (int w8 = 0; w8 < 8; ++w8) if (w8 < wave) base += tot[w8];
#pragma unroll
            for (int i = 0; i < 8; ++i) kbias[(size_t)bid * S + tid * 8 + i] = -(base + v[i]) * LOG2E;
            __syncthreads(); }
        pg8::DenseOrder So; So.init(HA, D, ws + WS_WAIN, M, 3072, D, G, bid);
        pg8::EpiQKV E{(u16*)(ws + WS_Q), (u16*)(ws + WS_K), (u16*)(ws + WS_V), rope, ksum, (unsigned*)(ws + WS_CTL) + CW_KN2};
        pg8::gemm_phase<pg8::EpiQKV, pg8::DenseOrder, false, true>(lds, D, D, So, E);
    }
    }
    SEAM(2);
    _Pragma("unroll") for (int rep_ = 0; rep_ < NREP(3); ++rep_) { if (rep_) xcd_barrier(bar);
    if (IN(3)) { PHASE_VARS
        const attn_body::AttnTensors AT{(const attn_body::bf16*)(ws + WS_Q), (const attn_body::bf16*)(ws + WS_K), (const attn_body::bf16*)(ws + WS_V), (attn_body::bf16*)(ws + WS_O)};
        attn_body::attn_phase<8>((char*)lds_raw, AT, ksum, kbias, (const unsigned*)(ws + WS_CTL) + CW_KN2, (int*)(ws + WS_CTL) + CW_AQ, (volatile LAS int*)(lds + CTRL_OFF + 64)); }
    }
    SEAM(3);
    _Pragma("unroll") for (int rep_ = 0; rep_ < NREP(4); ++rep_) { if (rep_) xcd_barrier(bar);
    if (IN(4)) { PHASE_VARS pg8::DenseOrder So; So.init(ws + WS_O, D, ws + WS_WAOUT, M, D, D, G, bid); pg8::EpiBf16 E{(u16*)Y, D};
        pg8::gemm_phase<pg8::EpiBf16, pg8::DenseOrder, false, false>(lds, D, D, So, E); }
    }
    SEAM(4);
    _Pragma("unroll") for (int rep_ = 0; rep_ < NREP(5); ++rep_) { if (rep_) xcd_barrier(bar);
    if (IN(5)) { PHASE_VARS RowP p{}; p.xres = x; p.y = Y; p.y_mode = 1; p.g_post = norm_g + 1 * D; p.gate = mod0 + 2 * D; p.xout = out;
        p.g_pre = norm_g + 2 * D; p.sh = mod0 + 3 * D; p.sc = mod0 + 4 * D; p.hout = HA; row_pass(p, bid, G, (LAS float*)lds); }
    }
    SEAM(5);
    _Pragma("unroll") for (int rep_ = 0; rep_ < NREP(6); ++rep_) { if (rep_) xcd_barrier(bar);
    if (IN(6)) { PHASE_VARS pg8::DenseOrder So; So.init(HA, D, ws + WS_WFGU, M, 2 * DFF, D, G, bid); pg8::EpiSwiglu E{(u16*)(ws + WS_HM), DFF};
        pg8::gemm_phase<pg8::EpiSwiglu, pg8::DenseOrder, false, true>(lds, D, D, So, E);
        if (bid >= 1408 - 5 * G) CONV_DRAIN(2, 0); }
    }
    SEAM(6);
    _Pragma("unroll") for (int rep_ = 0; rep_ < NREP(7); ++rep_) { if (rep_) xcd_barrier(bar);
    if (IN(7)) { PHASE_VARS pg8::DenseOrder So; So.init(ws + WS_HM, DFF, ws + WS_WFDN, M, D, DFF, G, bid); pg8::EpiBf16 E{(u16*)Y, D};
        pg8::gemm_phase<pg8::EpiBf16, pg8::DenseOrder, false, false>(lds, DFF, DFF, So, E); }
    }
    SEAM(7);
    if (IN(8)) { PHASE_VARS RowP p{}; p.xres = out; p.y = Y; p.y_mode = 1; p.g_post = norm_g + 3 * D; p.gate = mod0 + 5 * D; p.xout = out;
        p.g_pre = norm_g + 4 * D; p.sh = mod1 + 0 * D; p.sc = mod1 + 1 * D; p.hout = HA; row_pass(p, bid, G, (LAS float*)lds); }
    SEAM(8);
    _Pragma("unroll") for (int rep_ = 0; rep_ < NREP(9); ++rep_) { if (rep_) xcd_barrier(bar);
    if (IN(9)) { PHASE_VARS pg8::DenseOrder So; So.init(HA, D, ws + WS_WLIN, M, 2560, D, G, bid); pg8::EpiBf16 E{(u16*)(ws + WS_P2), 2560};
        pg8::gemm_phase<pg8::EpiBf16, pg8::DenseOrder, false, true>(lds, D, D, So, E);
        if (bid >= 640 - 2 * G) CONV_DRAIN(3, 0); }
    }
    SEAM(9);
    _Pragma("unroll") for (int rep_ = 0; rep_ < NREP(11); ++rep_) { if (rep_) xcd_barrier(bar);
    if (IN(11)) { PHASE_VARS
        if (bid < 160) lru::phase(lds, bid, a.in[12], a.in[13], (const u16*)(ws + WS_P2), (u16*)(ws + WS_YL), (const u16*)(ws + WS_WLG), (const float*)(ws + WS_SP8));
        else CONV_DRAIN(0, 3);
    }
    }
    SEAM(11);
    _Pragma("unroll") for (int rep_ = 0; rep_ < NREP(14); ++rep_) { if (rep_) xcd_barrier(bar);
    if (IN(14)) { PHASE_VARS pg8::DenseOrder So; So.init(ws + WS_YL, DRNN, ws + WS_WLOUT, M, D, DRNN, G, bid); pg8::EpiBf16 E{(u16*)Y, D};
        pg8::gemm_phase<pg8::EpiBf16, pg8::DenseOrder, false, false>(lds, DRNN, DRNN, So, E); }
    }
    SEAM(14);
    if (IN(15)) { PHASE_VARS RowP p{}; p.xres = out; p.y = Y; p.y_mode = 1; p.g_post = norm_g + 5 * D; p.gate = mod1 + 2 * D; p.xout = out;
        p.g_pre = norm_g + 6 * D; p.sh = mod1 + 3 * D; p.sc = mod1 + 4 * D; p.hout = HA;
        p.h8 = (unsigned char*)HA;
        p.extra = 2; p.wex = a.in[20]; p.wex_ld = 8; p.wex_off = 0; p.bex = a.in[21]; p.cnt = cnt; p.list_tw = ltw; p.list_g = lg; row_pass(p, bid, G, (LAS float*)lds);
        CONV_DRAIN(1 << 20, 1 << 20); }
    SEAM(15);
    _Pragma("unroll") for (int rep_ = 0; rep_ < NREP(16); ++rep_) { if (rep_) xcd_barrier(bar);
    if (IN(16)) { PHASE_VARS pg8::MoeOrder So; So.init(cnt, HA, ws + WS_WMGU, (size_t)7168 * 1024, 2 * DEXP, D / 2, G, bid, ltw, 1); pg8::EpiSwiglu8 E{(unsigned char*)(ws + WS_HMID), DEXP, (const float*)(ws + WS_SB)};
        pg8::gemm_phase<pg8::EpiSwiglu8, pg8::MoeOrder, true, true, true>(lds, D / 2, D / 2, So, E); }
    }
    SEAM(16);
    _Pragma("unroll") for (int rep_ = 0; rep_ < NREP(17); ++rep_) { if (rep_) xcd_barrier(bar);
    if (IN(17)) { PHASE_VARS pg8::MoeOrder So; So.init(cnt, ws + WS_HMID, ws + WS_WMDN, (size_t)1024 * 3584, D, DEXP / 2, G, bid, ltw, 0); pg8::EpiMoeDown E{(u16*)(ws + WS_YBUF), ltw, lg, (const float*)(ws + WS_SBD)};
        pg8::gemm_phase<pg8::EpiMoeDown, pg8::MoeOrder, false, true, true>(lds, DEXP / 2, DEXP / 2, So, E); }
    }
    SEAM(17);
    if (IN(18)) { PHASE_VARS RowP p{}; p.xres = out; p.y = (const float*)(ws + WS_YBUF); p.y_mode = 2; p.g_post = norm_g + 7 * D; p.gate = mod1 + 5 * D; p.xout = out; row_pass(p, bid, G, (LAS float*)lds); }
#undef IN
#undef SEAM
}

extern "C" void kernel_launch(void* const* d_in, const int* in_sizes, int n_in, void* d_out, int out_size, void* d_ws, size_t ws_size, hipStream_t stream) {
    static int grid = 0;
    if (grid == 0) {
        if (n_in != 25 || out_size != M * D || ws_size < WS_END) { fprintf(stderr, "kernel_launch: unexpected sizes (n_in %d out %d ws %zu)\n", n_in, out_size, ws_size); grid = -1; return; }
        int dev = 0, cus = 0;
        if (hipGetDevice(&dev) != hipSuccess || hipDeviceGetAttribute(&cus, hipDeviceAttributeMultiprocessorCount, dev) != hipSuccess) { grid = -1; return; }
        if (hipFuncSetAttribute((const void*)mega, hipFuncAttributeMaxDynamicSharedMemorySize, LDS_BYTES) != hipSuccess) { fprintf(stderr, "kernel_launch: hipFuncSetAttribute failed\n"); grid = -1; return; }
        (void)hipGetLastError();
        grid = cus;
    }
    if (grid < 0) return;
    char* ws = (char*)d_ws;
    (void)hipMemsetAsync(ws + WS_CTL, 0, 1 * MiB, stream);
    Args a{};
    for (int i = 0; i < 25; ++i) a.in[i] = (const float*)d_in[i];
    a.out = (float*)d_out; a.ws = ws;
#if defined(MK_PER_PHASE)
    for (int ph = 0; ph <= 18; ++ph) { a.ph_lo = ph; a.ph_hi = ph + 1; hipLaunchKernelGGL(mega, dim3(grid), dim3(NWAVES * 64), LDS_BYTES, stream, a); }
#else
    a.ph_lo = 0; a.ph_hi = 19;
    hipLaunchKernelGGL(mega, dim3(grid), dim3(NWAVES * 64), LDS_BYTES, stream, a);
#if defined(PROBE_PH)
    a.ph_lo = PROBE_PH; a.ph_hi = PROBE_PH + PROBE_N; a.li = 1;
    hipLaunchKernelGGL(mega, dim3(grid), dim3(NWAVES * 64), LDS_BYTES, stream, a);
#endif
#endif
}
```

```cpp
#include <hip/hip_runtime.h>
#include <cstdint>
#include <cstdio>
#include <cmath>

typedef unsigned short u16;
typedef float f32x4 __attribute__((ext_vector_type(4)));
typedef unsigned u32x4 __attribute__((ext_vector_type(4)));
typedef unsigned u32x2 __attribute__((ext_vector_type(2)));

constexpr int D = 1024, NB = 4, S = 4096, M = NB * S;
constexpr int NIN = 3080;
constexpr int DFF = 2816, DRNN = 1280, NE = 8, DEXP = 3584;
constexpr int MODW = 6 * D;
constexpr float EPS = 1e-6f;
constexpr float LOG2E = 1.4426950408889634f;
constexpr float C2 = 0.125f * LOG2E;

__device__ __forceinline__ u16 f2bf(float f) { unsigned u = __float_as_uint(f); return (u16)((u + 0x7fffu + ((u >> 16) & 1u)) >> 16); }
__device__ __forceinline__ float bf2f(u16 h) { return __uint_as_float(((unsigned)h) << 16); }
__device__ __forceinline__ unsigned pk2(float lo, float hi) { return (unsigned)f2bf(lo) | ((unsigned)f2bf(hi) << 16); }
__device__ __forceinline__ unsigned pk4_fp8(float a, float b, float c, float d) {
    a = __builtin_amdgcn_fmed3f(a, -448.f, 448.f); b = __builtin_amdgcn_fmed3f(b, -448.f, 448.f); c = __builtin_amdgcn_fmed3f(c, -448.f, 448.f); d = __builtin_amdgcn_fmed3f(d, -448.f, 448.f);
    unsigned w = 0u; w = __builtin_amdgcn_cvt_pk_fp8_f32(a, b, w, false); w = __builtin_amdgcn_cvt_pk_fp8_f32(c, d, w, true); return w; }
__device__ __forceinline__ float wave_sum(float v) {
#pragma unroll
    for (int o = 1; o < 64; o <<= 1) v += __shfl_xor(v, o);
    return v;
}
__device__ __forceinline__ float sigmoidf_(float x) { return 1.f / (1.f + __expf(-x)); }

struct RowP {
    const float* xres; const float* y; const float* g_post; const float* gate; float* xout;
    const float* g_pre; const float* sc; const float* sh; u16* hout;
    const float* wex; const float* bex;
    float* logf; int* cnt; int* list_tw; float* list_g; unsigned char* h8;
    int y_mode; int extra; int wex_ld; int wex_off;
};
__device__ __forceinline__ void row_pass(const RowP& p, int blk, int nblk, __attribute__((address_space(3))) float* wl) {
    const int lane = threadIdx.x & 63, wave = threadIdx.x >> 6, nw = blockDim.x >> 6;
    if (p.extra) {
        for (int idx = threadIdx.x; idx < 8 * D; idx += blockDim.x) { const int k = idx >> 3, o = idx & 7; wl[o * D + k] = p.wex[(size_t)k * p.wex_ld + p.wex_off + o]; }
        __syncthreads();
    }
    int nrec = wave;
    if (p.extra == 2) { if (threadIdx.x < 16) ((__attribute__((address_space(3))) int*)(wl + 8 * D))[threadIdx.x] = 0; __syncthreads(); }
    for (int m = blk * nw + wave; m < M; m += nblk * nw) {
        const int b = m / S, t = m % S;
        f32x4 xv[4];
#pragma unroll
        for (int j = 0; j < 4; ++j) xv[j] = __builtin_nontemporal_load((const f32x4*)(p.xres + (size_t)m * D + 256 * j + 4 * lane));
        if (p.y_mode) {
            f32x4 yv[4]; float ss = 0.f;
#pragma unroll
            for (int j = 0; j < 4; ++j) {
                if (p.y_mode == 1) { const u32x2 p0 = __builtin_nontemporal_load((const u32x2*)((const u16*)p.y + (size_t)m * D + 256 * j + 4 * lane));
                    yv[j] = (f32x4){__uint_as_float(p0.x << 16), __uint_as_float(p0.x & 0xffff0000u), __uint_as_float(p0.y << 16), __uint_as_float(p0.y & 0xffff0000u)}; }
                else { const u16* yb = (const u16*)p.y + (size_t)m * 2 * D + 256 * j + 4 * lane; const u32x2 p0 = __builtin_nontemporal_load((const u32x2*)yb), p1 = __builtin_nontemporal_load((const u32x2*)(yb + D));
                    yv[j] = (f32x4){__uint_as_float(p0.x << 16) + __uint_as_float(p1.x << 16), __uint_as_float(p0.x & 0xffff0000u) + __uint_as_float(p1.x & 0xffff0000u),
                                    __uint_as_float(p0.y << 16) + __uint_as_float(p1.y << 16), __uint_as_float(p0.y & 0xffff0000u) + __uint_as_float(p1.y & 0xffff0000u)}; }
                ss += yv[j].x * yv[j].x + yv[j].y * yv[j].y + yv[j].z * yv[j].z + yv[j].w * yv[j].w;
            }
            const float rstd = rsqrtf(wave_sum(ss) * (1.f / D) + EPS);
#pragma unroll
            for (int j = 0; j < 4; ++j) {
                const f32x4 g = *(const f32x4*)(p.g_post + 256 * j + 4 * lane), ga = *(const f32x4*)(p.gate + (size_t)b * MODW + 256 * j + 4 * lane);
                xv[j] = xv[j] + ga * (yv[j] * rstd * g);
            }
        }
        if (p.xout) {
#pragma unroll
            for (int j = 0; j < 4; ++j) __builtin_nontemporal_store(xv[j], (f32x4*)(p.xout + (size_t)m * D + 256 * j + 4 * lane));
        }
        if (p.g_pre) {
            float ss = 0.f;
#pragma unroll
            for (int j = 0; j < 4; ++j) ss += xv[j].x * xv[j].x + xv[j].y * xv[j].y + xv[j].z * xv[j].z + xv[j].w * xv[j].w;
            const float rstd = rsqrtf(wave_sum(ss) * (1.f / D) + EPS);
            f32x4 hv[4];
#pragma unroll
            for (int j = 0; j < 4; ++j) {
                const f32x4 g = *(const f32x4*)(p.g_pre + 256 * j + 4 * lane), s1 = *(const f32x4*)(p.sc + (size_t)b * MODW + 256 * j + 4 * lane), s0 = *(const f32x4*)(p.sh + (size_t)b * MODW + 256 * j + 4 * lane);
                hv[j] = xv[j] * rstd * g * (s1 + 1.0f) + s0;
                if (p.h8) __builtin_nontemporal_store(pk4_fp8(hv[j].x, hv[j].y, hv[j].z, hv[j].w), (unsigned*)(p.h8 + (size_t)m * D + 256 * j + 4 * lane));
                else { u32x2 w; w.x = pk2(hv[j].x, hv[j].y); w.y = pk2(hv[j].z, hv[j].w); __builtin_nontemporal_store(w, (u32x2*)(p.hout + (size_t)m * D + 256 * j + 4 * lane)); }
            }
            if (p.extra) {
                float dt[8];
#pragma unroll
                for (int o = 0; o < 8; ++o) dt[o] = 0.f;
#pragma unroll
                for (int j = 0; j < 4; ++j)
#pragma unroll
                    for (int o = 0; o < 8; ++o) { const f32x4 w4 = *(const __attribute__((address_space(3))) f32x4*)(wl + o * D + 256 * j + 4 * lane);
                        dt[o] += hv[j][0] * w4[0] + hv[j][1] * w4[1] + hv[j][2] * w4[2] + hv[j][3] * w4[3]; }
#pragma unroll
                for (int o = 0; o < 8; ++o) dt[o] = wave_sum(dt[o]) + p.bex[o];
                if (p.extra == 1) {
                    if (lane < 8) {
                        float xl = dt[0];
#pragma unroll
                        for (int o = 1; o < 8; ++o) xl = (lane == o) ? dt[o] : xl;
                        const float ls = xl > 0.f ? -log1pf(__expf(-xl)) : xl - log1pf(__expf(xl));
                        p.logf[((size_t)b * 8 + lane) * S + t] = ls;
                    }
                } else if (lane == 0) {
                    float v1 = -INFINITY, v2 = -INFINITY; int i1 = 0, i2 = 0;
#pragma unroll
                    for (int o = 0; o < 8; ++o) { const float g = dt[o]; if (g > v1) { v2 = v1; i2 = i1; v1 = g; i1 = o; } else if (g > v2) { v2 = g; i2 = o; } }
                    const float g1 = 1.f / (1.f + __expf(v2 - v1)), g2 = 1.f - g1;
                    __attribute__((address_space(3))) int* lc = (__attribute__((address_space(3))) int*)(wl + 8 * D); __attribute__((address_space(3))) float* rec = wl + 8 * D + 16 + nrec * 8;
                    const int lp1 = __hip_atomic_fetch_add(lc + i1, 1, __ATOMIC_RELAXED, __HIP_MEMORY_SCOPE_WORKGROUP), lp2 = __hip_atomic_fetch_add(lc + i2, 1, __ATOMIC_RELAXED, __HIP_MEMORY_SCOPE_WORKGROUP);
                    rec[0] = __int_as_float(m); rec[1] = __int_as_float(i1 | (i2 << 8)); rec[2] = g1; rec[3] = g2; rec[4] = __int_as_float(lp1); rec[5] = __int_as_float(lp2);
                }
                nrec += 8;
            }
        }
    }
    if (p.extra == 2) {
        __attribute__((address_space(3))) int* lc = (__attribute__((address_space(3))) int*)(wl + 8 * D);
        __syncthreads();
        if (threadIdx.x < 8) lc[8 + threadIdx.x] = atomicAdd(p.cnt + threadIdx.x, lc[threadIdx.x]);
        __syncthreads();
        const int nrows = (M - blk * nw + nblk * nw - 1) / (nblk * nw) * nw;
        for (int r = threadIdx.x; r < nrows; r += blockDim.x) { const __attribute__((address_space(3))) float* rec = wl + 8 * D + 16 + r * 8;
            const int m = __float_as_int(rec[0]), ii = __float_as_int(rec[1]), i1 = ii & 255, i2 = ii >> 8;
            const int p1 = lc[8 + i1] + __float_as_int(rec[4]), p2 = lc[8 + i2] + __float_as_int(rec[5]);
            p.list_tw[i1 * M + p1] = m * 2; p.list_g[i1 * M + p1] = rec[2]; p.list_tw[i2 * M + p2] = m * 2 + 1; p.list_g[i2 * M + p2] = rec[3]; }
    }
}
__device__ __forceinline__ float gelu_tanh(float x) { return 0.5f * x * (1.f + tanhf(0.7978845608028654f * (x + 0.044715f * x * x * x))); }
namespace pg8 {
#define PG8_LAS __attribute__((address_space(3)))
typedef unsigned short bf16_t;
typedef short bf16x8 __attribute__((ext_vector_type(8)));
typedef int i32x4_t __attribute__((ext_vector_type(4)));
constexpr int BM = 256, BK = 64, HALF = 128, HTB = HALF * BK * 2  , STAGE_BYTES = 8 * HTB, NXCD = 8, WGM = 8;

__host__ __device__ __forceinline__ int lds_byte(int r, int c) { const int st = (r >> 4) * 2 + (c >> 5), rr = r & 15, cc = c & 31, ob = rr * 64 + cc * 2; return st * 1024 + (ob ^ (((ob >> 9) & 1) << 5)); }
__host__ __device__ __forceinline__ void stage_rc(int b, int& R, int& C) { const int st = b / 1024, sb = b % 1024, swz = sb ^ (((sb >> 9) & 1) << 5); R = (st >> 1) * 16 + swz / 64; C = (st & 1) * 32 + (swz % 64) / 2; }
__host__ __device__ __forceinline__ int perm32(int rho) { const int n = rho >> 4, i = rho & 15; return 8 * (i >> 2) + 4 * n + (i & 3); }

struct Unit { int pm, pn; const char* A; const char* B; int e, rt; };

struct DenseOrder {
    int nM, nN, nwg, G, c; const char* A; const char* Bt; unsigned tstepA, tstepB, cstepA;
    __device__ void init(const void* A_, int lda, const void* Bt_, int M, int N, int K, int G_, int c_) { nM = M / BM; nN = N / BM; nwg = nM * nN; G = G_; c = c_; A = (const char*)A_; Bt = (const char*)Bt_; tstepA = (unsigned)BM * lda * 2; tstepB = (unsigned)BM * K * 2; cstepA = 0; }
    __device__ bool next(int i, Unit& u) const {
        const long L = (long)i * G + c; if (L >= nwg) return false;
        int wgid = (int)L; { const int q = nwg / NXCD, r = nwg % NXCD, xcd = wgid % NXCD, off = wgid / NXCD; wgid = (xcd < r ? xcd * (q + 1) : r * (q + 1) + (xcd - r) * q) + off; }
        const int nig = WGM * nN, gid = wgid / nig, fm = gid * WGM, gsz = (nM - fm) < WGM ? (nM - fm) : WGM;
        u.pm = fm + ((wgid % nig) % gsz); u.pn = (wgid % nig) / gsz; u.A = A + (size_t)u.pm * tstepA + (size_t)u.pn * cstepA; u.B = Bt + (size_t)u.pn * tstepB; u.e = 0; u.rt = 0; return true;
    }
    __device__ __forceinline__ unsigned grow(const Unit&, int) const { return 0u; }
};
struct MoeOrder {
    int tp[9]; int cnt[8]; int nN, G, c, total; const char* A; const char* Bt; size_t estrideB, tstepB, tstepA; const int* ltw; int K2; int gather;
    __device__ void init(const int* cntp, const void* A_, const void* Bt_, size_t estrideB_, int N, int K, int G_, int c_, const int* ltw_, int gather_) {
        int s = 0;
        for (int e = 0; e < 8; ++e) { cnt[e] = __builtin_amdgcn_readfirstlane(cntp[e]); tp[e] = s; s += (cnt[e] + 255) >> 8; }
        tp[8] = s; nN = N / BM; total = s * nN; G = G_; c = c_; A = (const char*)A_; Bt = (const char*)Bt_; estrideB = estrideB_; tstepB = (size_t)BM * K * 2; tstepA = (size_t)BM * K * 2; ltw = ltw_; K2 = K * 2; gather = gather_;
    }
    __device__ bool next(int i, Unit& u) const {
        const long L = (long)i * G + c; if (L >= total) return false;
        const int tg = (int)(L / nN); u.pn = (int)(L % nN); u.pm = tg;
        int e = 0, tpe = 0;
#pragma unroll
        for (int j = 1; j < 8; ++j) if (tg >= tp[j]) { e = j; tpe = tp[j]; }
        u.e = e; u.rt = tg - tpe;
        u.A = gather ? A : A + (size_t)tg * tstepA; u.B = Bt + (size_t)e * estrideB + (size_t)u.pn * tstepB; return true;
    }
    __device__ __forceinline__ int nvalid(const Unit& u) const { int n = 0;
#pragma unroll
        for (int j = 0; j < 8; ++j) n = (u.e == j) ? cnt[j] : n;
        n -= u.rt * 256; return n > 256 ? 256 : n; }
    __device__ __forceinline__ unsigned grow(const Unit& u, int rr) const {
        const int nv = nvalid(u); int tok = 0;
        if (rr < nv) tok = ltw[(size_t)u.e * 16384 + u.rt * 256 + rr] >> 1;
        return (unsigned)tok * (unsigned)K2;
    }
};

__device__ __forceinline__ unsigned cvt_pk_bf16(float lo, float hi) { unsigned r; asm volatile("v_cvt_pk_bf16_f32 %0, %1, %2" : "=v"(r) : "v"(lo), "v"(hi)); return r; }

template <class Epi, class Sched, bool GATHER, bool ALIGN_EPI, bool FP8 = false>
__device__ __forceinline__ void gemm_phase(PG8_LAS unsigned char* lds, const int K, const int lda, const Sched& S, const Epi& E) {
    const int tid = threadIdx.x, wid = __builtin_amdgcn_readfirstlane(tid >> 6), lane = tid & 63, wr = wid >> 2, wc = wid & 3, fr = lane & 15, fq = lane >> 4;
    const int nt = K / BK;
    unsigned voffA[2], voffB[2]; int RA[2], CA[2];
#pragma unroll
    for (int i = 0; i < 2; ++i) { int R, C; stage_rc(tid * 16 + i * 8192, R, C); const int Rb = Epi::PERM ? ((R & ~31) + perm32(R & 31)) : R;
        RA[i] = R; CA[i] = C; voffA[i] = (unsigned)(R * lda + C) * 2u; voffB[i] = (unsigned)(Rb * K + C) * 2u; }
    const size_t kstep = (size_t)(BK * 2);
    const size_t hstepB = (size_t)HALF * K * 2;
    const size_t hstepA = GATHER ? 0 : (size_t)HALF * lda * 2;
    const unsigned ldsw = (unsigned)wid * 1024u;
    const unsigned ldsa = (unsigned)__builtin_amdgcn_readfirstlane((int)((unsigned)(size_t)lds + ldsw));
    const int aoff = lds_byte(wr * 64 + fr, fq * 8), boff = lds_byte(wc * 32 + fr, fq * 8);
#define PG8_SA(b, h) (((b) * 2 + (h)) * HTB)
#define PG8_SB(b, h) ((4 + (b) * 2 + (h)) * HTB)
#define PG8_STAGE(bufoff, gbase, voff) do { _Pragma("unroll") for (int _i = 0; _i < 2; ++_i) { unsigned _keep; \
        asm volatile("s_mov_b32 %0, m0\n\ts_mov_b32 m0, %3\n\ts_nop 0\n\tglobal_load_lds_dwordx4 %1, %2\n\ts_mov_b32 m0, %0" : "=&s"(_keep) : "v"((voff)[_i]), "s"((const char*)(gbase)), "s"(ldsa + (unsigned)(bufoff) + (unsigned)(_i * 8192)) : "memory"); } } while (0)
#define PG8_LDA(dst, b, h) do { _Pragma("unroll") for (int m = 0; m < 4; ++m) _Pragma("unroll") for (int k = 0; k < 2; ++k) dst[m][k] = *(const PG8_LAS bf16x8*)(lds + PG8_SA(b, h) + aoff + m * 2048 + k * 1024); } while (0)
#define PG8_LDB(dst, b, h) do { _Pragma("unroll") for (int n = 0; n < 2; ++n) _Pragma("unroll") for (int k = 0; k < 2; ++k) dst[n][k] = *(const PG8_LAS bf16x8*)(lds + PG8_SB(b, h) + boff + n * 2048 + k * 1024); } while (0)
#define PG8_CAT(X) __builtin_shufflevector(__builtin_bit_cast(i32x4_t, (X)[0]), __builtin_bit_cast(i32x4_t, (X)[1]), 0, 1, 2, 3, 4, 5, 6, 7)
#define PG8_MMA(ai, bj, At, Bt) do { __builtin_amdgcn_s_setprio(1); _Pragma("unroll") for (int m = 0; m < 4; ++m) _Pragma("unroll") for (int n = 0; n < 2; ++n) { \
        if constexpr (FP8) asm volatile("v_mfma_scale_f32_16x16x128_f8f6f4 %0, %1, %2, %0, %3, %3 op_sel_hi:[0,0,0]" : "+v"(acc[ai][bj][m][n]) : "v"(PG8_CAT(Bt[n])), "v"(PG8_CAT(At[m])), "v"(0x7f7f7f7f));   \
        else { _Pragma("unroll") for (int k = 0; k < 2; ++k) acc[ai][bj][m][n] = __builtin_amdgcn_mfma_f32_16x16x32_bf16(Bt[n][k], At[m][k], acc[ai][bj][m][n], 0, 0, 0); } } \
        __builtin_amdgcn_s_setprio(0); } while (0)
#define PG8_WAIT_V(n) asm volatile("s_waitcnt vmcnt(" #n ")" ::: "memory")
#define PG8_WAIT_L(n) asm volatile("s_waitcnt lgkmcnt(" #n ")" ::: "memory")
#define PG8_BAR __builtin_amdgcn_s_barrier()
#define PG8_SCHED __builtin_amdgcn_sched_barrier(0)
    Unit cur, nxt; int ui = 0;
    if (!S.next(0, cur)) return;
    unsigned gc[2][2], gn[2][2];
#pragma unroll
    for (int h = 0; h < 2; ++h)
#pragma unroll
        for (int i = 0; i < 2; ++i) { gc[h][i] = GATHER ? S.grow(cur, h * HALF + RA[i]) + (unsigned)CA[i] * 2u : voffA[i]; gn[h][i] = gc[h][i]; }
    f32x4 acc[2][2][4][2];
#pragma unroll
    for (int a = 0; a < 2; ++a)
#pragma unroll
        for (int b = 0; b < 2; ++b)
#pragma unroll
            for (int m = 0; m < 4; ++m)
#pragma unroll
                for (int n = 0; n < 2; ++n) acc[a][b][m][n] = (f32x4){0.f, 0.f, 0.f, 0.f};
    bf16x8 At[4][2], B0[2][2], B1[2][2];
    const char* cA = cur.A; const char* cB = cur.B;
    PG8_STAGE(PG8_SB(0, 0), cB, voffB); PG8_STAGE(PG8_SB(0, 1), cB + hstepB, voffB); PG8_STAGE(PG8_SA(0, 0), cA, gc[0]); PG8_STAGE(PG8_SA(0, 1), cA + hstepA, gc[1]);
    if (wr == 1) PG8_BAR;
    PG8_WAIT_V(2); PG8_BAR;
    PG8_STAGE(PG8_SB(1, 0), cB + kstep, voffB); PG8_STAGE(PG8_SA(1, 0), cA + kstep, gc[0]); PG8_STAGE(PG8_SB(1, 1), cB + hstepB + kstep, voffB);
    PG8_WAIT_V(6); PG8_BAR;
    for (;;) {
        const bool has_next = S.next(ui + 1, nxt);
        const char* nA = has_next ? nxt.A : cA; const char* nB = has_next ? nxt.B : cB;
        if (GATHER) {
#pragma unroll
            for (int h = 0; h < 2; ++h)
#pragma unroll
                for (int i = 0; i < 2; ++i) gn[h][i] = has_next ? S.grow(nxt, h * HALF + RA[i]) + (unsigned)CA[i] * 2u : gc[h][i];
        }
        for (int t = 0; t < nt; t += 2) {
            const bool last = (t == nt - 2);
            const char* a1 = cA + (size_t)(t + 1) * kstep;
            const char* a2 = last ? nA : cA + (size_t)(t + 2) * kstep; const char* b2 = last ? nB : cB + (size_t)(t + 2) * kstep;
            const char* a3 = a2 + kstep; const char* b3 = b2 + kstep;
            unsigned g2[2][2];
#pragma unroll
            for (int h = 0; h < 2; ++h)
#pragma unroll
                for (int i = 0; i < 2; ++i) g2[h][i] = (GATHER && last) ? gn[h][i] : gc[h][i];
            PG8_LDB(B0, 0, 0); PG8_LDB(B1, 0, 1); PG8_SCHED; PG8_LDA(At, 0, 0); PG8_STAGE(PG8_SA(1, 1), a1 + hstepA, gc[1]);
            PG8_WAIT_V(8); PG8_WAIT_L(0); PG8_BAR; PG8_MMA(0, 0, At, B0); PG8_MMA(0, 1, At, B1); PG8_BAR; PG8_SCHED;
            PG8_LDA(At, 0, 1); PG8_STAGE(PG8_SB(0, 0), b2, voffB); PG8_STAGE(PG8_SB(0, 1), b2 + hstepB, voffB); PG8_STAGE(PG8_SA(0, 0), a2, g2[0]);
            PG8_WAIT_V(8); PG8_WAIT_L(0); PG8_BAR; PG8_MMA(1, 0, At, B0); PG8_MMA(1, 1, At, B1); PG8_BAR; PG8_SCHED;
            PG8_LDB(B0, 1, 0); PG8_LDB(B1, 1, 1); PG8_SCHED; PG8_LDA(At, 1, 0); PG8_STAGE(PG8_SA(0, 1), a2 + hstepA, g2[1]);
            PG8_WAIT_V(8); PG8_WAIT_L(0); PG8_BAR; PG8_MMA(0, 0, At, B0); PG8_MMA(0, 1, At, B1); PG8_BAR; PG8_SCHED;
            PG8_LDA(At, 1, 1); PG8_STAGE(PG8_SB(1, 0), b3, voffB); PG8_STAGE(PG8_SB(1, 1), b3 + hstepB, voffB); PG8_STAGE(PG8_SA(1, 0), a3, g2[0]);
            PG8_WAIT_V(8); PG8_WAIT_L(0); PG8_BAR; PG8_MMA(1, 0, At, B0); PG8_MMA(1, 1, At, B1); PG8_BAR; PG8_SCHED;
        }
        if constexpr (ALIGN_EPI) { if (wr == 0) PG8_BAR; }
        if constexpr (FP8) asm volatile("s_nop 15\n\ts_nop 7" ::: "memory");
        E(acc, cur, S, wr, wc, fr, fq);
        if (!has_next) break;
#pragma unroll
        for (int a = 0; a < 2; ++a)
#pragma unroll
            for (int b = 0; b < 2; ++b)
#pragma unroll
                for (int m = 0; m < 4; ++m)
#pragma unroll
                    for (int n = 0; n < 2; ++n) acc[a][b][m][n] = (f32x4){0.f, 0.f, 0.f, 0.f};
        cur = nxt; cA = nA; cB = nB; ++ui;
#pragma unroll
        for (int h = 0; h < 2; ++h)
#pragma unroll
            for (int i = 0; i < 2; ++i) gc[h][i] = gn[h][i];
        if constexpr (ALIGN_EPI) { if (wr == 1) PG8_BAR; }
    }
    PG8_WAIT_V(0);
    if constexpr (!ALIGN_EPI) { if (wr == 0) PG8_BAR; }
    PG8_BAR;
#undef PG8_SA
#undef PG8_SB
#undef PG8_STAGE
#undef PG8_LDA
#undef PG8_LDB
#undef PG8_MMA
#undef PG8_CAT
#undef PG8_WAIT_V
#undef PG8_WAIT_L
#undef PG8_BAR
#undef PG8_SCHED
}
}
namespace pg8 {
struct EpiF32 {
    static constexpr bool PERM = false;
    float* C; int ldc;
    template <class Sched> __device__ __forceinline__ void operator()(const f32x4 (&acc)[2][2][4][2], const Unit& u, const Sched&, int wr, int wc, int fr, int fq) const {
        const int row0 = u.pm * BM + wr * 64 + fr, col0 = u.pn * BM + wc * 32 + 4 * fq;
#pragma unroll
        for (int ai = 0; ai < 2; ++ai)
#pragma unroll
            for (int m = 0; m < 4; ++m) { float* rowp = C + (size_t)(row0 + ai * HALF + m * 16) * ldc + col0;
#pragma unroll
                for (int bj = 0; bj < 2; ++bj)
#pragma unroll
                    for (int n = 0; n < 2; ++n) *(f32x4*)(rowp + bj * HALF + n * 16) = acc[ai][bj][m][n]; }
    }
};
struct EpiBf16 {
    static constexpr bool PERM = true;
    u16* O; int ldc;
    template <class Sched> __device__ __forceinline__ void operator()(const f32x4 (&acc)[2][2][4][2], const Unit& u, const Sched&, int wr, int wc, int fr, int fq) const {
        const int row0 = u.pm * BM + wr * 64 + fr, col0 = u.pn * BM + wc * 32 + 8 * fq;
#pragma unroll
        for (int ai = 0; ai < 2; ++ai)
#pragma unroll
            for (int m = 0; m < 4; ++m) { u16* rowp = O + (size_t)(row0 + ai * HALF + m * 16) * ldc + col0;
#pragma unroll
                for (int bj = 0; bj < 2; ++bj) { const f32x4 v0 = acc[ai][bj][m][0], v1 = acc[ai][bj][m][1];
                    u32x4 w; w.x = cvt_pk_bf16(v0[0], v0[1]); w.y = cvt_pk_bf16(v0[2], v0[3]); w.z = cvt_pk_bf16(v1[0], v1[1]); w.w = cvt_pk_bf16(v1[2], v1[3]);
                    *(u32x4*)(rowp + bj * HALF) = w; } }
    }
};
__device__ __forceinline__ float silu_f(float v) { return v * __builtin_amdgcn_rcpf(1.f + __builtin_amdgcn_exp2f(-1.4426950408889634f * v)); }
struct EpiSwiglu {
    static constexpr bool PERM = true;
    u16* O; int ldc;
    template <class Sched> __device__ __forceinline__ void operator()(const f32x4 (&acc)[2][2][4][2], const Unit& u, const Sched&, int wr, int wc, int fr, int fq) const {
        const int row0 = u.pm * BM + wr * 64 + fr, col0 = u.pn * HALF + wc * 32 + 8 * fq;
#pragma unroll
        for (int ai = 0; ai < 2; ++ai)
#pragma unroll
            for (int m = 0; m < 4; ++m) { u16* rowp = O + (size_t)(row0 + ai * HALF + m * 16) * ldc + col0;
                f32x4 v0, v1;
#pragma unroll
                for (int i = 0; i < 4; ++i) { v0[i] = silu_f(acc[ai][0][m][0][i]) * acc[ai][1][m][0][i]; v1[i] = silu_f(acc[ai][0][m][1][i]) * acc[ai][1][m][1][i]; }
                u32x4 w; w.x = cvt_pk_bf16(v0[0], v0[1]); w.y = cvt_pk_bf16(v0[2], v0[3]); w.z = cvt_pk_bf16(v1[0], v1[1]); w.w = cvt_pk_bf16(v1[2], v1[3]);
                *(u32x4*)rowp = w; }
    }
};
struct EpiSwiglu8 {
    static constexpr bool PERM = true;
    unsigned char* O; int ldc; const float* isc;
    template <class Sched> __device__ __forceinline__ void operator()(const f32x4 (&acc)[2][2][4][2], const Unit& u, const Sched&, int wr, int wc, int fr, int fq) const {
        const int row0 = u.pm * BM + wr * 64 + fr, col0 = u.pn * HALF + wc * 32 + 8 * fq;
        const float* sp = isc + (size_t)u.e * 7168 + u.pn * BM + wc * 32 + 8 * fq;
        const f32x4 sg0 = *(const f32x4*)sp, sg1 = *(const f32x4*)(sp + 4), su0 = *(const f32x4*)(sp + HALF) * 2.f, su1 = *(const f32x4*)(sp + HALF + 4) * 2.f;
        const f32x4 se0 = sg0 * -1.4426950408889634f, se1 = sg1 * -1.4426950408889634f;
#pragma unroll
        for (int ai = 0; ai < 2; ++ai)
#pragma unroll
            for (int m = 0; m < 4; ++m) { unsigned char* rowp = O + (size_t)(row0 + ai * HALF + m * 16) * ldc + col0;
                f32x4 v0, v1;
#pragma unroll
                for (int i = 0; i < 4; ++i) { const float g0 = acc[ai][0][m][0][i], g1 = acc[ai][0][m][1][i];
                    v0[i] = (g0 * sg0[i]) * __builtin_amdgcn_rcpf(1.f + __builtin_amdgcn_exp2f(g0 * se0[i])) * (acc[ai][1][m][0][i] * su0[i]);
                    v1[i] = (g1 * sg1[i]) * __builtin_amdgcn_rcpf(1.f + __builtin_amdgcn_exp2f(g1 * se1[i])) * (acc[ai][1][m][1][i] * su1[i]); }
                u32x2 w; w.x = pk4_fp8(v0[0], v0[1], v0[2], v0[3]); w.y = pk4_fp8(v1[0], v1[1], v1[2], v1[3]);
                *(u32x2*)rowp = w; }
    }
};
struct EpiQKV {
    static constexpr bool PERM = true;
    u16* Q; u16* K; u16* V; const float* rope; float* ksum; unsigned* kn2;
    template <class Sched> __device__ __forceinline__ void operator()(f32x4 (&acc)[2][2][4][2], const Unit& u, const Sched&, int wr, int wc, int fr, int fq) const {
        const int part = u.pn >> 2, pq = u.pn & 3;
        u16* base = Q + (size_t)part * ((size_t)16384 * 1024);
        const int row0 = u.pm * BM + wr * 64 + fr;
        const bool ropew = (part < 2) && (pq < 2) && ((wc & 1) == 0);
        if (ropew) {
            const float sgn = fq == 0 ? -1.f : 1.f;
#pragma unroll
            for (int ai = 0; ai < 2; ++ai)
#pragma unroll
                for (int m = 0; m < 4; ++m) {
                    const int pos = (row0 + ai * HALF + m * 16) & 4095;
                    const f32x4 t0 = *(const f32x4*)(rope + pos * 16), t1 = *(const f32x4*)(rope + pos * 16 + 4), t2 = *(const f32x4*)(rope + pos * 16 + 8), t3 = *(const f32x4*)(rope + pos * 16 + 12);
                    const float cs[8] = {t0[0], t0[2], t1[0], t1[2], t2[0], t2[2], t3[0], t3[2]}, sn[8] = {t0[1], t0[3], t1[1], t1[3], t2[1], t2[3], t3[1], t3[3]};
#pragma unroll
                    for (int bj = 0; bj < 2; ++bj)
#pragma unroll
                        for (int n = 0; n < 2; ++n)
#pragma unroll
                            for (int i = 0; i < 4; ++i) {
                                const float mine = acc[ai][bj][m][n][i]; const auto rr_ = __builtin_amdgcn_permlane16_swap(__float_as_uint(mine), __float_as_uint(mine), false, false); const float oth = __uint_as_float((fq & 1) ? rr_[0] : rr_[1]);
                                const float rot = mine * cs[4 * n + i] + sgn * oth * sn[4 * n + i];
                                acc[ai][bj][m][n][i] = fq < 2 ? rot : mine;
                            }
                }
        }
        if (part == 1 && pq < 2) {
            const int b = u.pm >> 4, blk = u.pm & 15;
#pragma unroll
            for (int bj = 0; bj < 2; ++bj)
#pragma unroll
                for (int n = 0; n < 2; ++n)
#pragma unroll
                    for (int i = 0; i < 4; ++i) {
                        float s = 0.f;
#pragma unroll
                        for (int ai = 0; ai < 2; ++ai)
#pragma unroll
                            for (int m = 0; m < 4; ++m) s += acc[ai][bj][m][n][i];
                        s += __shfl_xor(s, 1); s += __shfl_xor(s, 2); s += __shfl_xor(s, 4); s += __shfl_xor(s, 8);
                        if (fr == 0) { const int cc = pq * 256 + bj * HALF + wc * 32 + 8 * fq + 4 * n + i;
                            atomicAdd(ksum + ((size_t)(b * 8 + (cc >> 6)) * 16 + blk) * 64 + (cc & 63), s); }
                    }
        }
        if (part == 1 && pq >= 2) {
            const int b = u.pm >> 4;
#pragma unroll
            for (int bj = 0; bj < 2; ++bj) { float mx = 0.f;
#pragma unroll
                for (int ai = 0; ai < 2; ++ai)
#pragma unroll
                    for (int m = 0; m < 4; ++m) { const f32x4 v0 = acc[ai][bj][m][0], v1 = acc[ai][bj][m][1];
                        mx = __builtin_fmaxf(mx, (v0[0] * v0[0] + v0[1] * v0[1]) + (v0[2] * v0[2] + v0[3] * v0[3]) + (v1[0] * v1[0] + v1[1] * v1[1]) + (v1[2] * v1[2] + v1[3] * v1[3])); }
                mx = __builtin_fmaxf(mx, __shfl_xor(mx, 1)); mx = __builtin_fmaxf(mx, __shfl_xor(mx, 2)); mx = __builtin_fmaxf(mx, __shfl_xor(mx, 4)); mx = __builtin_fmaxf(mx, __shfl_xor(mx, 8));
                if (fr == 0) { const int hf = (pq - 2) * 4 + bj * 2 + (wc >> 1); atomicMax(kn2 + (b * 8 + hf) * 8 + (wc & 1) * 4 + fq, __float_as_uint(mx)); } }
        }
        const float sc = part == 0 ? C2 : 1.f;
        const int col0 = pq * BM + wc * 32 + 8 * fq;
#pragma unroll
        for (int ai = 0; ai < 2; ++ai)
#pragma unroll
            for (int m = 0; m < 4; ++m) { u16* rowp = base + (size_t)(row0 + ai * HALF + m * 16) * 1024 + col0;
#pragma unroll
                for (int bj = 0; bj < 2; ++bj) { const f32x4 v0 = acc[ai][bj][m][0] * sc, v1 = acc[ai][bj][m][1] * sc;
                    u32x4 w; w.x = cvt_pk_bf16(v0[0], v0[1]); w.y = cvt_pk_bf16(v0[2], v0[3]); w.z = cvt_pk_bf16(v1[0], v1[1]); w.w = cvt_pk_bf16(v1[2], v1[3]);
                    *(u32x4*)(rowp + bj * HALF) = w; } }
    }
};
struct EpiMoeDown {
    static constexpr bool PERM = true;
    u16* Y; const int* ltw; const float* lg; const float* isc;
    template <class Sched> __device__ __forceinline__ void operator()(const f32x4 (&acc)[2][2][4][2], const Unit& u, const Sched& S, int wr, int wc, int fr, int fq) const {
        const int nv = S.nvalid(u); const size_t lbase = (size_t)u.e * 16384 + u.rt * 256;
        const int col0 = u.pn * BM + wc * 32 + 8 * fq;
        const float* sp = isc + (size_t)u.e * 1024 + col0;
        f32x4 cs[2][2];
#pragma unroll
        for (int bj = 0; bj < 2; ++bj) { cs[bj][0] = *(const f32x4*)(sp + bj * HALF) * 0.5f; cs[bj][1] = *(const f32x4*)(sp + bj * HALF + 4) * 0.5f; }
#pragma unroll
        for (int ai = 0; ai < 2; ++ai)
#pragma unroll
            for (int m = 0; m < 4; ++m) { const int rr = ai * HALF + wr * 64 + m * 16 + fr;
                if (rr < nv) { const int tw = ltw[lbase + rr]; const float g = lg[lbase + rr]; u16* rowp = Y + (size_t)tw * 1024 + col0;
#pragma unroll
                    for (int bj = 0; bj < 2; ++bj) { const f32x4 v0 = acc[ai][bj][m][0] * cs[bj][0] * g, v1 = acc[ai][bj][m][1] * cs[bj][1] * g;
                        u32x4 w; w.x = cvt_pk_bf16(v0[0], v0[1]); w.y = cvt_pk_bf16(v0[2], v0[3]); w.z = cvt_pk_bf16(v1[0], v1[1]); w.w = cvt_pk_bf16(v1[2], v1[3]);
                        *(u32x4*)(rowp + bj * HALF) = w; } } }
    }
};
__device__ __forceinline__ float one_minus_exp(float t) { return t > -0.02f ? -t * (1.f + t * (0.5f + t * (0.16666667f + t * 0.041666667f))) : 1.f - __expf(t); }
struct EpiGates {
    static constexpr bool PERM = true;
    char* wsb; size_t o_la, o_xi, o_conv, o_tab;
    template <class Sched> __device__ __forceinline__ void operator()(f32x4 (&acc)[2][2][4][2], const Unit& u, const Sched&, int wr, int wc, int fr, int fq) const {
        const int row0 = u.pm * BM + wr * 64 + fr, ch0 = u.pn * HALF + wc * 32 + 8 * fq;
        u16* LA = (u16*)(wsb + o_la); u16* XI = (u16*)(wsb + o_xi); const u16* conv = (const u16*)(wsb + o_conv); const float* tab = (const float*)(wsb + o_tab) + ch0;
        asm volatile("" ::: "memory"); __builtin_amdgcn_sched_barrier(0);
        {
            float ba[8], sp8[8];
#pragma unroll
            for (int j = 0; j < 2; ++j) { const f32x4 t = *(const f32x4*)(tab + 4 * j), t2 = *(const f32x4*)(tab + 2 * 1280 + 4 * j); ba[4 * j] = t[0]; ba[4 * j + 1] = t[1]; ba[4 * j + 2] = t[2]; ba[4 * j + 3] = t[3]; sp8[4 * j] = t2[0]; sp8[4 * j + 1] = t2[1]; sp8[4 * j + 2] = t2[2]; sp8[4 * j + 3] = t2[3]; }
#pragma unroll
            for (int ai = 0; ai < 2; ++ai)
#pragma unroll
                for (int m = 0; m < 4; ++m)
#pragma unroll
                    for (int j = 0; j < 8; ++j) acc[ai][0][m][j >> 2][j & 3] = sp8[j] * __builtin_amdgcn_rcpf(1.f + __expf(-(acc[ai][0][m][j >> 2][j & 3] + ba[j])));
        }
        float bx[8];
#pragma unroll
        for (int j = 0; j < 2; ++j) { const f32x4 t = *(const f32x4*)(tab + 1280 + 4 * j); bx[4 * j] = t[0]; bx[4 * j + 1] = t[1]; bx[4 * j + 2] = t[2]; bx[4 * j + 3] = t[3]; }
#pragma unroll
        for (int ai = 0; ai < 2; ++ai)
#pragma unroll
            for (int m = 0; m < 4; ++m) { const size_t off = (size_t)(row0 + ai * HALF + m * 16) * 1280 + ch0;
                const u32x4 cv = *(const u32x4*)(conv + off);
                u32x4 wl, wx;
#pragma unroll
                for (int q = 0; q < 4; ++q) {
                    const float c0 = __uint_as_float(cv[q] << 16), c1 = __uint_as_float(cv[q] & 0xffff0000u);
                    const int j0 = 2 * q, j1 = 2 * q + 1;
                    const float la0 = acc[ai][0][m][j0 >> 2][j0 & 3], la1 = acc[ai][0][m][j1 >> 2][j1 & 3];
                    const float rx0 = acc[ai][1][m][j0 >> 2][j0 & 3] + bx[j0], rx1 = acc[ai][1][m][j1 >> 2][j1 & 3] + bx[j1];
                    const float x0 = __builtin_amdgcn_sqrtf(one_minus_exp(2.f * la0)) * (c0 * __builtin_amdgcn_rcpf(1.f + __expf(-rx0))), x1 = __builtin_amdgcn_sqrtf(one_minus_exp(2.f * la1)) * (c1 * __builtin_amdgcn_rcpf(1.f + __expf(-rx1)));
                    wl[q] = cvt_pk_bf16(la0, la1); wx[q] = cvt_pk_bf16(x0, x1);
                }
                *(u32x4*)(LA + off) = wl; *(u32x4*)(XI + off) = wx;
                asm volatile("" ::: "memory"); }
    }
};
}
#include <hip/hip_bf16.h>
namespace attn_body {
using bf16=__hip_bfloat16;
using bf16x8=__attribute__((ext_vector_type(8)))short;
using s16x4=__attribute__((ext_vector_type(4)))short;
using f32x16=__attribute__((ext_vector_type(16)))float;
using u32x4=__attribute__((ext_vector_type(4)))unsigned;
constexpr int BATCH=4,NHEAD=16,SEQ=4096,D=64,DM=NHEAD*D;
constexpr int NW=8,QBLK=32,QB=QBLK*NW,KVBLK=64,NQB=SEQ/QB;
constexpr int ATTN_PITCH=DM, ATTN_UNIT_ROWS=QB;
__device__ __forceinline__ int crow(int r,int hi){return (r&3)+8*(r>>2)+4*hi;}
#define SBAR() __builtin_amdgcn_sched_barrier(0)
__device__ __forceinline__ void cmask(f32x16&p0,f32x16&p1,int jb,int qrel,int hi){
  const float NEG=-INFINITY; int kb=64*jb+4*hi;
  #pragma unroll
  for(int r=0;r<16;++r){int kv=kb+(r&3)+8*(r>>2); if(kv>qrel)p0[r]=NEG; if(kv+32>qrel)p1[r]=NEG;}
}

constexpr int NSLOT=3, SLOTB=8192;
constexpr int LDS_K=0, LDS_V=NSLOT*SLOTB, LDS_WS=2*NSLOT*SLOTB, LDS_OST=LDS_WS+NW*64*4, LDS_KB=LDS_OST+NW*4096, LDS_BYTES=LDS_KB+16384;
constexpr float C2=0.125f*1.4426950408889634f;
__device__ __forceinline__ void glds16(const void*gsrc,unsigned lds_dst){unsigned keep;
  asm volatile("s_mov_b32 %0, m0\n\ts_mov_b32 m0, %2\n\ts_nop 0\n\tglobal_load_lds_dwordx4 %1, off\n\ts_mov_b32 m0, %0":"=&s"(keep):"v"(gsrc),"s"(lds_dst):"memory");}
__device__ __forceinline__ float max3f(float a,float b,float c){float r;asm("v_max3_f32 %0, %1, %2, %3":"=v"(r):"v"(a),"v"(b),"v"(c));return r;}
__device__ __forceinline__ float max2f(float a,float b){float r;asm("v_max_f32_e32 %0, %1, %2":"=v"(r):"v"(a),"v"(b));return r;}
__device__ __forceinline__ float fadd_s(float a,float b){float r;asm("v_add_f32_e32 %0, %1, %2":"=v"(r):"v"(a),"v"(b));return r;}
__device__ __forceinline__ float fsub_s(float a,float b){float r;asm("v_sub_f32_e32 %0, %1, %2":"=v"(r):"v"(a),"v"(b));return r;}
typedef float f32x2_t __attribute__((ext_vector_type(2))); typedef __bf16 bf16x2_t __attribute__((ext_vector_type(2)));
__device__ __forceinline__ unsigned cvtpk_s(float lo,float hi){f32x2_t v={lo,hi};bf16x2_t b=__builtin_convertvector(v,bf16x2_t);return __builtin_bit_cast(unsigned,b);}
#define WAIT_BAR(N) asm volatile("s_waitcnt vmcnt(" #N ") lgkmcnt(0)\n\ts_barrier":::"memory")

__device__ __forceinline__ void qkt(f32x16&p0,f32x16&p1,const char*Kslot,const bf16x8*qr,const f32x16&negm,int r32,int hi){
  const char*kb=Kslot+hi*1024+r32*16;
  #pragma unroll
  for(int d0=0;d0<4;++d0){
    const bf16x8 b0=*reinterpret_cast<const bf16x8*>(kb+d0*2048);
    const bf16x8 b1=*reinterpret_cast<const bf16x8*>(kb+d0*2048+512);
    if(d0==0){p0=__builtin_amdgcn_mfma_f32_32x32x16_bf16(b0,qr[0],negm,0,0,0);p1=__builtin_amdgcn_mfma_f32_32x32x16_bf16(b1,qr[0],negm,0,0,0);}
    else{p0=__builtin_amdgcn_mfma_f32_32x32x16_bf16(b0,qr[d0],p0,0,0,0);p1=__builtin_amdgcn_mfma_f32_32x32x16_bf16(b1,qr[d0],p1,0,0,0);}}
}
__device__ __forceinline__ void qkt_acc(f32x16&p0,f32x16&p1,const char*Kslot,const bf16x8*qr,int r32,int hi){
  const char*kb=Kslot+hi*1024+r32*16;
  #pragma unroll
  for(int d0=0;d0<4;++d0){
    const bf16x8 b0=*reinterpret_cast<const bf16x8*>(kb+d0*2048);
    const bf16x8 b1=*reinterpret_cast<const bf16x8*>(kb+d0*2048+512);
    p0=__builtin_amdgcn_mfma_f32_32x32x16_bf16(b0,qr[d0],p0,0,0,0);p1=__builtin_amdgcn_mfma_f32_32x32x16_bf16(b1,qr[d0],p1,0,0,0);}
}
typedef __attribute__((address_space(3))) const char* lds_cptr;
typedef short v4i16_t __attribute__((ext_vector_type(4)));
__device__ __forceinline__ void kload8(bf16x8*kf,lds_cptr kp){
  kf[0]=*(const __attribute__((address_space(3))) bf16x8*)(kp);      kf[1]=*(const __attribute__((address_space(3))) bf16x8*)(kp+512);
  kf[2]=*(const __attribute__((address_space(3))) bf16x8*)(kp+2048); kf[3]=*(const __attribute__((address_space(3))) bf16x8*)(kp+2560);
  kf[4]=*(const __attribute__((address_space(3))) bf16x8*)(kp+4096); kf[5]=*(const __attribute__((address_space(3))) bf16x8*)(kp+4608);
  kf[6]=*(const __attribute__((address_space(3))) bf16x8*)(kp+6144); kf[7]=*(const __attribute__((address_space(3))) bf16x8*)(kp+6656);
}
__device__ __forceinline__ void kload2(bf16x8*kf,lds_cptr kp,int j){ kf[2*j]=*(const __attribute__((address_space(3))) bf16x8*)(kp+j*2048); kf[2*j+1]=*(const __attribute__((address_space(3))) bf16x8*)(kp+j*2048+512); }
__device__ __forceinline__ s16x4 vtr(lds_cptr p){ return __builtin_bit_cast(s16x4,__builtin_amdgcn_ds_read_tr16_b64_v4i16((__attribute__((address_space(3))) v4i16_t*)p)); }
__device__ __forceinline__ float rowmax(const f32x16&p0,const f32x16&p1){
  float a=max3f(p0[0],p0[1],p1[0]),b=max3f(p0[2],p0[3],p1[1]);a=max3f(a,p1[2],p1[3]);
  #pragma unroll
  for(int r=4;r<16;r+=4){a=max3f(a,p0[r],p0[r+1]);b=max3f(b,p0[r+2],p0[r+3]);a=max3f(a,p1[r],p1[r+1]);b=max3f(b,p1[r+2],p1[r+3]);}
  const float m=max2f(a,b);
  auto rr=__builtin_amdgcn_permlane32_swap(__float_as_uint(m),__float_as_uint(m),false,false);
  return max2f(__uint_as_float(rr[0]),__uint_as_float(rr[1]));
}
__device__ __forceinline__ void pv(f32x16*o,int vb,bf16x8 pa0,bf16x8 pa1,bf16x8 pa2,bf16x8 pa3){
  #pragma unroll
  for(int d0=0;d0<2;++d0){s16x4 lo[4],hi[4];
    #pragma unroll
    for(int ks=0;ks<4;++ks){
      asm volatile("ds_read_b64_tr_b16 %0,%1 offset:%c2":"=&v"(lo[ks]):"v"(vb),"i"(d0*4096+ks*1024):"memory");
      asm volatile("ds_read_b64_tr_b16 %0,%1 offset:%c2":"=&v"(hi[ks]):"v"(vb),"i"(d0*4096+ks*1024+512):"memory");}
    asm volatile("s_waitcnt lgkmcnt(0)":::"memory");SBAR();
    #define PK(k) (bf16x8){lo[k][0],lo[k][1],lo[k][2],lo[k][3],hi[k][0],hi[k][1],hi[k][2],hi[k][3]}
    o[d0]=__builtin_amdgcn_mfma_f32_32x32x16_bf16(pa0,PK(0),o[d0],0,0,0);
    o[d0]=__builtin_amdgcn_mfma_f32_32x32x16_bf16(pa1,PK(1),o[d0],0,0,0);
    o[d0]=__builtin_amdgcn_mfma_f32_32x32x16_bf16(pa2,PK(2),o[d0],0,0,0);
    o[d0]=__builtin_amdgcn_mfma_f32_32x32x16_bf16(pa3,PK(3),o[d0],0,0,0);
    #undef PK
  }
}

#ifndef ATTN_STORE16
#define ATTN_STORE16(p,v) (*(u32x4*)(p)=(v))
#endif
template<int THRL,bool MOBA> __device__ __forceinline__ void attn_unit(int b,int h,int qb,const bf16*Q,const bf16*__restrict__ K,const bf16*__restrict__ V,bf16*O,char*shm,const float*aux,const unsigned*kn2){
  int tid_=threadIdx.x; asm volatile("":"+v"(tid_));
  const int tid=tid_,lane=tid&63,r32=lane&31,hi=lane>>5; const int wid=__builtin_amdgcn_readfirstlane(tid>>6);
  const long rowbase=(long)b*SEQ; const int q0=qb*QB;
  const bf16*Qw=Q+(rowbase+q0+wid*QBLK)*DM+h*D;
  const bf16*Kh=K+rowbase*DM+h*D,*Vh=V+rowbase*DM+h*D;
  const lds_cptr shm3=(lds_cptr)shm;
  const unsigned lds0=(unsigned)(uintptr_t)shm;
  float*wsf=(float*)(shm+LDS_WS)+wid*64;
  const bf16*ksrc=Kh+(long)lane*DM+wid*8;
  const bf16*vsrc=Vh+(long)(16*(wid&3)+(lane>>2))*DM+(wid>>2)*32+(lane&3)*8;
  const unsigned kdst=lds0+LDS_K+wid*1024, vdst=lds0+LDS_V+wid*1024;
  #define TA(t) (NTA-1-(t))
  #define DMA_K(t,slot) glds16(ksrc+(long)(TA(t))*KVBLK*DM,(unsigned)__builtin_amdgcn_readfirstlane(kdst+(slot)))
  #define DMA_V(t,slot) glds16(vsrc+(long)(TA(t))*KVBLK*DM,(unsigned)__builtin_amdgcn_readfirstlane(vdst+(slot)))
  const int vb0=(int)(lds0+LDS_V)+((lane>>4)&1)*32+(lane&3)*8+(4*hi+((lane&15)>>2))*64;
  const char*Kbase=shm+LDS_K; bf16x8 kf[8];
  const lds_cptr kp0=shm3+LDS_K+hi*1024+r32*16; const lds_cptr vp0=shm3+LDS_V+((lane>>4)&1)*32+(lane&3)*8+(4*hi+((lane&15)>>2))*64;
  const int NTA=(q0+QB)/KVBLK;
  int NT=NTA;
  typedef __attribute__((address_space(3))) const float* lds_fptr; typedef float f32x4_t __attribute__((ext_vector_type(4)));
  const lds_fptr kbl=(lds_fptr)(shm3+LDS_KB);
  if constexpr(MOBA){ if(qb>0){
      if(tid<qb*16){ const f32x4_t v=*(const __attribute__((address_space(1))) f32x4_t*)(aux+tid*4); *(__attribute__((address_space(3))) f32x4_t*)((__attribute__((address_space(3))) char*)shm3+LDS_KB+tid*16)=v; } } }
  else {
    glds16(aux+(wid*2)*256+lane*4,(unsigned)__builtin_amdgcn_readfirstlane(lds0+LDS_KB+(wid*2)*1024));
    glds16(aux+(wid*2+1)*256+lane*4,(unsigned)__builtin_amdgcn_readfirstlane(lds0+LDS_KB+(wid*2+1)*1024)); }
  DMA_K(0,0);DMA_V(0,0);DMA_K(1,SLOTB);
  bf16x8 qr[4];
  #pragma unroll
  for(int d0=0;d0<4;++d0)qr[d0]=*reinterpret_cast<const bf16x8*>(&Qw[(long)r32*DM+d0*16+hi*8]);
  float mhat=0.f,l_reg=0.f;f32x16 o[2];o[0]=f32x16{};o[1]=f32x16{};f32x16 negm=f32x16{};if constexpr(MOBA)asm volatile("":"+v"(negm));
  unsigned amask=0xffffffffu;
  const int qrel=wid*QBLK+r32;
  #define CMASK(P0,P1,t) do{ if((t)<4)cmask(P0,P1,3-(t),qrel,hi); }while(0)
  bool resc=false;
  #define START(P0,P1) do{ const float rm=rowmax(P0,P1); resc=false; \
    { const float dl=rm<-1e37f?0.f:rm; mhat=fadd_s(mhat,dl);     \
      _Pragma("unroll") for(int r=0;r<16;++r){P0[r]=fsub_s(P0[r],dl);P1[r]=fsub_s(P1[r],dl);} \
      if constexpr(MOBA){ _Pragma("unroll") for(int r=0;r<16;++r)negm[r]=-mhat; asm volatile("":"+v"(negm)); } } \
    _Pragma("unroll") for(int r=0;r<16;++r)P0[r]=__builtin_amdgcn_exp2f(P0[r]); }while(0)
  #define RESC() do{ if(resc){ asm volatile("s_waitcnt lgkmcnt(0)":::"memory"); \
      _Pragma("unroll") for(int d_=0;d_<2;++d_) _Pragma("unroll") for(int r=0;r<16;++r)o[d_][r]*=wsf[crow(r,hi)]; } }while(0)
  f32x16 pA0,pA1,pB0,pB1;
  int sl_prev=0,sl_cur=0,sl_next=SLOTB;
  #define ROT() do{sl_prev=sl_cur;sl_cur=sl_next;sl_next=(sl_next==(NSLOT-1)*SLOTB)?0:sl_next+SLOTB;}while(0)
  DMA_K(2,2*SLOTB);
  if constexpr(!MOBA){
    float s2=0.f;
    #pragma unroll
    for(int d0=0;d0<4;++d0){
      #pragma unroll
      for(int i=0;i<8;++i){ const float qv=__uint_as_float(((unsigned)(unsigned short)qr[d0][i])<<16); s2+=qv*qv; } }
    { auto rr=__builtin_amdgcn_permlane32_swap(__float_as_uint(s2),__float_as_uint(s2),false,false); s2=__uint_as_float(rr[0])+__uint_as_float(rr[1]); }
    #pragma unroll
    for(int o_=1;o_<32;o_<<=1)s2=__builtin_fmaxf(s2,__shfl_xor(s2,o_));
    if(lane==0)wsf[63]=s2; }
  WAIT_BAR(3);
  #define INITB(C0,C1,t) do{ const lds_fptr kbp_=kbl+TA(t)*64+4*hi; \
    _Pragma("unroll") for(int g_=0;g_<4;++g_){ const f32x4_t b0_=*(const __attribute__((address_space(3))) f32x4_t*)(kbp_+8*g_), b1_=*(const __attribute__((address_space(3))) f32x4_t*)(kbp_+32+8*g_); \
      _Pragma("unroll") for(int i_=0;i_<4;++i_){ C0[4*g_+i_]=b0_[i_]-mhat; C1[4*g_+i_]=b1_[i_]-mhat; } } }while(0)
  if constexpr(MOBA){
    if(qb>0){
      float qf[32];
      #pragma unroll
      for(int d0=0;d0<4;++d0){
        #pragma unroll
        for(int i=0;i<8;++i)qf[8*d0+i]=__uint_as_float(((unsigned)(unsigned short)qr[d0][i])<<16);}
      float v1=-INFINITY,v2=-INFINITY,v3=-INFINITY;int i1=-1,i2=-1,i3=-1;
      for(int j=0;j<qb;++j){ const lds_fptr kr=kbl+j*64+8*hi; float g=0.f;
        #pragma unroll
        for(int d0=0;d0<4;++d0){ const f32x4_t a_=*(const __attribute__((address_space(3))) f32x4_t*)(kr+16*d0), b_=*(const __attribute__((address_space(3))) f32x4_t*)(kr+16*d0+4);
          g+=qf[8*d0]*a_[0]+qf[8*d0+1]*a_[1]+qf[8*d0+2]*a_[2]+qf[8*d0+3]*a_[3]+qf[8*d0+4]*b_[0]+qf[8*d0+5]*b_[1]+qf[8*d0+6]*b_[2]+qf[8*d0+7]*b_[3]; }
        { auto rr=__builtin_amdgcn_permlane32_swap(__float_as_uint(g),__float_as_uint(g),false,false); g=__uint_as_float(rr[0])+__uint_as_float(rr[1]); }
        if(g>v1){v3=v2;i3=i2;v2=v1;i2=i1;v1=g;i1=j;} else if(g>v2){v3=v2;i3=i2;v2=g;i2=j;} else if(g>v3){v3=g;i3=j;} }
      amask=1u<<qb; if(i1>=0)amask|=1u<<i1; if(i2>=0)amask|=1u<<i2; if(i3>=0)amask|=1u<<i3; }
    qkt(pA0,pA1,Kbase,qr,negm,r32,hi);
  } else {
    float q2=0.f,k2=0.f;
    #pragma unroll
    for(int w_=0;w_<8;++w_){ q2=__builtin_fmaxf(q2,((const float*)(shm+LDS_WS))[w_*64+63]); k2+=__uint_as_float(kn2[w_]); }
    const float bnd=2.f*1.02f*__builtin_sqrtf(q2)*__builtin_sqrtf(k2)-kbl[q0]+64.f;
    const bool dead=(lane<NTA)&&(kbl[64*lane+63]+bnd<0.f);
    const int nskip=__builtin_popcountll(__ballot(dead));
    NT=NTA-nskip; NT=(NT+1)&~1; NT=NT<4?4:NT;
    INITB(pA0,pA1,0); qkt_acc(pA0,pA1,Kbase,qr,r32,hi); }
  asm volatile("s_nop 15\n\ts_nop 7":"+v"(pA0),"+v"(pA1));CMASK(pA0,pA1,0);
  START(pA0,pA1);
  _Pragma("unroll") for(int r=0;r<16;++r)pA1[r]=__builtin_amdgcn_exp2f(pA1[r]);
  WAIT_BAR(0);
  DMA_K(3,0);DMA_V(1,SLOTB);
  ROT();
  kload8(kf,kp0+sl_cur);
  WAIT_BAR(2);
  s16x4 vlo[8],vhi[8]; u32x4 pw0,pw1,pw2,pw3;
  #define PKW(P,B) cvtpk_s(P[B],P[B+1])
  #define PAF(k) __builtin_bit_cast(bf16x8,pw##k)
  #define VFR(i) (bf16x8){vlo[i][0],vlo[i][1],vlo[i][2],vlo[i][3],vhi[i][0],vhi[i][1],vhi[i][2],vhi[i][3]}
  #define PIN(x) asm volatile("":"+v"(x))
  #define MX3(a,b,c) __builtin_fmaxf(__builtin_fmaxf((a),(b)),(c))
  #define GAPA(MF,A0,A1,A2,A3,W0,W1,PW) do{ MF; sacc+=A0; sacc+=A1; sacc+=A2; sacc+=A3; PIN(sacc); W0; W1; PIN(PW); SBAR(); }while(0)
  #define EX(v) __builtin_amdgcn_exp2f(v)
  #define GAPB(MF,X,B) do{ MF; X[B]=EX(X[B]); X[B+1]=EX(X[B+1]); X[B+2]=EX(X[B+2]); X[B+3]=EX(X[B+3]); PIN(X); SBAR(); }while(0)
  #define VRD(i) do{ vlo[i]=vtr(vp_+(((i)>>2)*4096+((i)&3)*1024)); vhi[i]=vtr(vp_+(((i)>>2)*4096+((i)&3)*1024+512)); }while(0)
  #define KRD(G,j) do{ if(G){ kload2(kf,kp0+sl_next,j); SBAR(); } }while(0)
  #define CIN(X) (MOBA?negm:X)
  #define STEP(C0,C1,P0,P1,t,GK,GV,GL) do{ SBAR(); \
    if constexpr(!MOBA){ INITB(C0,C1,t); SBAR(); } \
    const lds_cptr vp_=vp0+sl_prev; \
    VRD(0); SBAR(); float sacc=(P0[0]+P0[1]); \
    GAPA(C0=__builtin_amdgcn_mfma_f32_32x32x16_bf16(kf[0],qr[0],CIN(C0),0,0,0), P0[2],P0[3],P0[4],P0[5],     pw0[0]=PKW(P0,0), pw0[1]=PKW(P0,2), pw0); \
    VRD(4); SBAR(); GAPA(C1=__builtin_amdgcn_mfma_f32_32x32x16_bf16(kf[1],qr[0],CIN(C1),0,0,0), P0[6],P0[7],P0[8],P0[9],     pw0[2]=PKW(P0,4), pw0[3]=PKW(P0,6), pw0); \
    VRD(1); SBAR(); GAPA(C0=__builtin_amdgcn_mfma_f32_32x32x16_bf16(kf[2],qr[1],C0,0,0,0),   P0[10],P0[11],P0[12],P0[13], pw1[0]=PKW(P0,8), pw1[1]=PKW(P0,10), pw1); \
    VRD(5); SBAR(); GAPA(C1=__builtin_amdgcn_mfma_f32_32x32x16_bf16(kf[3],qr[1],C1,0,0,0),   P0[14],P0[15],P1[0],P1[1],   pw1[2]=PKW(P0,12),pw1[3]=PKW(P0,14), pw1); \
    VRD(2); SBAR(); GAPA(C0=__builtin_amdgcn_mfma_f32_32x32x16_bf16(kf[4],qr[2],C0,0,0,0),   P1[2],P1[3],P1[4],P1[5],     pw2[0]=PKW(P1,0), pw2[1]=PKW(P1,2), pw2); \
    VRD(6); SBAR(); GAPA(C1=__builtin_amdgcn_mfma_f32_32x32x16_bf16(kf[5],qr[2],C1,0,0,0),   P1[6],P1[7],P1[8],P1[9],     pw2[2]=PKW(P1,4), pw2[3]=PKW(P1,6), pw2); \
    VRD(3); SBAR(); GAPA(C0=__builtin_amdgcn_mfma_f32_32x32x16_bf16(kf[6],qr[3],C0,0,0,0),   P1[10],P1[11],P1[12],P1[13], pw3[0]=PKW(P1,8), pw3[1]=PKW(P1,10), pw3); \
    VRD(7); SBAR(); GAPA(C1=__builtin_amdgcn_mfma_f32_32x32x16_bf16(kf[7],qr[3],C1,0,0,0),   P1[14],P1[15],0.f,0.f,       pw3[2]=PKW(P1,12),pw3[3]=PKW(P1,14), pw3); \
    if constexpr(MOBA){ const bool okp_=((amask>>(TA((t)-1)>>2))&1u)!=0u; l_reg+=okp_?sacc:0.f; \
      _Pragma("unroll") for(int i_=0;i_<4;++i_){ pw0[i_]=okp_?pw0[i_]:0u; pw1[i_]=okp_?pw1[i_]:0u; pw2[i_]=okp_?pw2[i_]:0u; pw3[i_]=okp_?pw3[i_]:0u; } } \
    else { l_reg+=sacc; } \
    if(GK){DMA_K((t)+3,sl_cur);} if(GV){DMA_V((t)+1,sl_next);} \
    CMASK(C0,C1,t); \
    { float a=MX3(C0[0],C0[1],C1[0]),b=MX3(C0[2],C0[3],C1[1]); a=MX3(a,C1[2],C1[3]); \
      _Pragma("unroll") for(int r=4;r<16;r+=4){a=MX3(a,C0[r],C0[r+1]);b=MX3(b,C0[r+2],C0[r+3]);a=MX3(a,C1[r],C1[r+1]);b=MX3(b,C1[r+2],C1[r+3]);} \
      float rm=__builtin_fmaxf(a,b); { auto rr=__builtin_amdgcn_permlane32_swap(__float_as_uint(rm),__float_as_uint(rm),false,false); rm=__builtin_fmaxf(__uint_as_float(rr[0]),__uint_as_float(rr[1])); } \
      resc=false; \
      if(__builtin_expect(__any(rm>(float)THRL),0)){ const float dl=__builtin_fmaxf(rm,0.f); mhat+=dl; \
        _Pragma("unroll") for(int r=0;r<16;++r){C0[r]-=dl;C1[r]-=dl;} \
        if constexpr(MOBA){ _Pragma("unroll") for(int r=0;r<16;++r)negm[r]=-mhat; asm volatile("":"+v"(negm)); } \
        const float f=__builtin_amdgcn_exp2f(-dl); l_reg*=f; if(hi==0)wsf[r32]=f; resc=true; } } \
    SBAR(); \
    GAPB(o[0]=__builtin_amdgcn_mfma_f32_32x32x16_bf16(PAF(0),VFR(0),o[0],0,0,0), C0,0); \
    GAPB(o[1]=__builtin_amdgcn_mfma_f32_32x32x16_bf16(PAF(0),VFR(4),o[1],0,0,0), C0,4); \
    KRD(GL,0); GAPB(o[0]=__builtin_amdgcn_mfma_f32_32x32x16_bf16(PAF(1),VFR(1),o[0],0,0,0), C0,8); \
    KRD(GL,1); GAPB(o[1]=__builtin_amdgcn_mfma_f32_32x32x16_bf16(PAF(1),VFR(5),o[1],0,0,0), C0,12); \
    KRD(GL,2); GAPB(o[0]=__builtin_amdgcn_mfma_f32_32x32x16_bf16(PAF(2),VFR(2),o[0],0,0,0), C1,0); \
    KRD(GL,3); GAPB(o[1]=__builtin_amdgcn_mfma_f32_32x32x16_bf16(PAF(2),VFR(6),o[1],0,0,0), C1,4); \
    GAPB(o[0]=__builtin_amdgcn_mfma_f32_32x32x16_bf16(PAF(3),VFR(3),o[0],0,0,0), C1,8); \
    GAPB(o[1]=__builtin_amdgcn_mfma_f32_32x32x16_bf16(PAF(3),VFR(7),o[1],0,0,0), C1,12); \
    }while(0)
  int t=1;
  for(;t+5<NT;t+=2){
    STEP(pB0,pB1,pA0,pA1,t,true,true,true);     WAIT_BAR(2); RESC(); ROT();
    STEP(pA0,pA1,pB0,pB1,t+1,true,true,true);   WAIT_BAR(2); RESC(); ROT();
  }
  #define ENDW(tt) do{ if((tt)+3<NT){WAIT_BAR(2);} else if((tt)+2<NT){WAIT_BAR(1);} else {WAIT_BAR(0);} }while(0)
  for(;t+1<NT;t+=2){
    STEP(pB0,pB1,pA0,pA1,t,(t+3<NT),(t+1<NT),(t+1<NT));       ENDW(t);   RESC(); ROT();
    STEP(pA0,pA1,pB0,pB1,t+1,(t+4<NT),(t+2<NT),(t+2<NT));     ENDW(t+1); RESC(); ROT();
  }
  STEP(pB0,pB1,pA0,pA1,NT-1,false,false,false); RESC();
  { float sacc=pB0[0]+pB0[1]; _Pragma("unroll") for(int r=2;r<16;++r)sacc+=pB0[r]; _Pragma("unroll") for(int r=0;r<16;++r)sacc+=pB1[r]; l_reg+=sacc;
    pw0=(u32x4){PKW(pB0,0),PKW(pB0,2),PKW(pB0,4),PKW(pB0,6)};pw1=(u32x4){PKW(pB0,8),PKW(pB0,10),PKW(pB0,12),PKW(pB0,14)};pw2=(u32x4){PKW(pB1,0),PKW(pB1,2),PKW(pB1,4),PKW(pB1,6)};pw3=(u32x4){PKW(pB1,8),PKW(pB1,10),PKW(pB1,12),PKW(pB1,14)};
    SBAR(); pv(o,vb0+sl_cur,PAF(0),PAF(1),PAF(2),PAF(3)); }
  #undef PKW
  #undef PAF
  #undef VFR
  #undef PIN
  #undef MX3
  #undef GAPA
  #undef GAPB
  #undef EX
  #undef VRD
  #undef KRD
  #undef STEP
  #undef CIN
  #undef INITB
  #undef ENDW
  {auto rr=__builtin_amdgcn_permlane32_swap(__float_as_uint(l_reg),__float_as_uint(l_reg),false,false);l_reg=__uint_as_float(rr[0])+__uint_as_float(rr[1]);}
  if(hi==0)wsf[32+r32]=l_reg;asm volatile("s_waitcnt lgkmcnt(0)":::"memory");
  float rli[16];
  #pragma unroll
  for(int r=0;r<16;++r)rli[r]=__builtin_amdgcn_rcpf(wsf[32+crow(r,hi)]);
  bf16*Ow=O+(rowbase+q0+wid*QBLK)*DM+h*D;
  { bf16*stg=(bf16*)(shm+LDS_OST)+wid*2048;
    #pragma unroll
    for(int r=0;r<16;++r){const int orow=crow(r,hi);
      #pragma unroll
      for(int d0=0;d0<2;++d0)stg[orow*64+d0*32+r32]=__float2bfloat16(o[d0][r]*rli[r]);}
    asm volatile("s_waitcnt lgkmcnt(0)":::"memory");
    #pragma unroll
    for(int i=0;i<4;++i){const int row=i*8+(lane>>3),ch=lane&7; const u32x4 v=*(const u32x4*)(stg+row*64+ch*8); ATTN_STORE16(Ow+(long)row*DM+ch*8,v);} }
  asm volatile("s_waitcnt lgkmcnt(0)\n\ts_barrier":::"memory");
  #undef DMA_K
  #undef DMA_V
  #undef TA
  #undef CMASK
  #undef START
  #undef RESC
  #undef ROT
}
constexpr int ATTN_LDS_BYTES=LDS_BYTES;
struct AttnTensors { const bf16* Q; const bf16* K; const bf16* V; bf16* O; };
struct AttnUnit { int b; int h; int qb; };
__device__ __forceinline__ void unit_of(int idx,AttnUnit&u){
  int grp=idx>>5; const int bh=idx&31; bool fox; int qb;
  if(grp<11){fox=false;qb=15-grp;} else if(grp<22){fox=true;qb=15-(grp-11);} else {grp-=22;fox=(grp&1)!=0;qb=4-(grp>>1);}
  u.b=bh>>3; u.h=(bh&7)+(fox?8:0); u.qb=qb;
}
template<int THRL=8> __device__ __forceinline__ void attn_phase(char*lds,const AttnTensors&T,const float*ksum,const float*kbias,const unsigned*kn2,int*qhead,volatile __attribute__((address_space(3))) int*slot){
  AttnUnit u;
  for(;;){
    if(threadIdx.x==0)slot[0]=atomicAdd(qhead,1);
    asm volatile("s_waitcnt vmcnt(0) lgkmcnt(0)\n\ts_barrier":::"memory");
    const int idx=slot[0];
    asm volatile("s_waitcnt lgkmcnt(0)\n\ts_barrier":::"memory");
    if(idx>=1024)break;
    unit_of(idx,u);
    if(u.h<8) attn_unit<THRL,true>(u.b,u.h,u.qb,T.Q,T.K,T.V,T.O,lds,ksum+(size_t)(u.b*8+u.h)*16*64,kn2);
    else attn_unit<THRL,false>(u.b,u.h,u.qb,T.Q,T.K,T.V,T.O,lds,kbias+(size_t)(u.b*8+(u.h-8))*SEQ,kn2+(u.b*8+(u.h-8))*8); }
}
#undef SBAR
#undef WAIT_BAR
}

constexpr size_t MiB = 1u << 20;
constexpr size_t WS_CTL = 0;
constexpr size_t WS_MOD = 1 * MiB;
constexpr size_t WS_ROPE = 1 * MiB + 256 * 1024;
constexpr size_t WS_LOGF = 1 * MiB + 512 * 1024;
constexpr size_t WS_KBIAS = 2 * MiB;
constexpr size_t WS_SP8 = 2 * MiB + 512 * 1024;
constexpr size_t WS_AGG = 3 * MiB;
constexpr size_t WS_LTW = 5 * MiB;
constexpr size_t WS_LG = 5 * MiB + 512 * 1024;
constexpr size_t WS_WMGU = 6 * MiB;
constexpr size_t WS_SB = 64 * MiB;
constexpr size_t WS_WMDN = 118 * MiB;
constexpr size_t WS_SBD = 65 * MiB;
constexpr size_t WS_WAIN = 174 * MiB;
constexpr size_t WS_WAOUT = 180 * MiB;
constexpr size_t WS_WFGU = 182 * MiB;
constexpr size_t WS_WFDN = 193 * MiB;
constexpr size_t WS_WLIN = 199 * MiB;
constexpr size_t WS_WLOUT = 204 * MiB;
constexpr size_t WS_WLG = 207 * MiB;
constexpr size_t WS_HA = 208 * MiB;
constexpr size_t WS_R = 240 * MiB;
constexpr size_t WS_Q = WS_R, WS_K = WS_R + 32 * MiB, WS_V = WS_R + 64 * MiB;
constexpr size_t WS_Y = WS_R + 96 * MiB;
constexpr size_t WS_O = WS_R + 128 * MiB;
constexpr size_t WS_HM = WS_R;
constexpr size_t WS_P2 = WS_R;
constexpr size_t WS_LA = WS_R + 80 * MiB;
constexpr size_t WS_XI = WS_R + 120 * MiB;
constexpr size_t WS_CONV = WS_R + 160 * MiB;
constexpr size_t WS_YL = WS_R + 200 * MiB;
constexpr size_t WS_HMID = WS_R;
constexpr size_t WS_YBUF = 174 * MiB;
constexpr size_t WS_END = 480 * MiB;
constexpr int CW_CNT = 64;
constexpr int CW_BAR = 4096;
constexpr int CW_KSUM = 65536;
constexpr int CW_AQ = 320;
constexpr int CW_CQG = 128, CW_CQD = 192;
constexpr int CW_KN2 = 98304;

constexpr int NWAVES = 8;
constexpr int RING_BYTES = 131072, CTRL_OFF = 139264, MISC_OFF = CTRL_OFF + 320, LDS_BYTES = 147456;

#define LAS __attribute__((address_space(3)))
#define GAS __attribute__((address_space(1)))
typedef GAS unsigned gu32;
#define LDS_WAIT() asm volatile("s_waitcnt lgkmcnt(0)" ::: "memory")

#define XB_TMO      128
#define XB_XCNT(j)  (256  + 64 * (j))
#define XB_XSUB(j)  (1280 + 64 * (j))
#define XB_XGEN(j)  (2304 + 64 * (j))
#define XB_TOP      3328
#define XB_TOPGEN   3392
#define XCD_BAR_WORDS 3456
#define XB_SPIN_CAP (1u << 18)

__device__ __forceinline__ unsigned xb_ld(unsigned* p)              { return __hip_atomic_load(p, __ATOMIC_RELAXED, __HIP_MEMORY_SCOPE_AGENT); }
__device__ __forceinline__ unsigned xb_add(unsigned* p, unsigned v) { return __hip_atomic_fetch_add(p, v, __ATOMIC_RELAXED, __HIP_MEMORY_SCOPE_AGENT); }
__device__ __forceinline__ unsigned xb_xcc_id() { return (unsigned)__builtin_amdgcn_s_getreg((3 << 11) | 20) & 0xFu; }
#define XB_SPIN(cond, bar) do { unsigned _sp = 0; while (cond) { __builtin_amdgcn_s_sleep(1); \
    if ((++_sp & 255u) == 0u) { if (xb_ld(&(bar)[XB_TMO])) break; if (_sp > XB_SPIN_CAP) { atomicAdd(&(bar)[XB_TMO], 1u); break; } } } } while (0)

struct XcdBarrier {
    unsigned* bar; unsigned x;
    volatile LAS unsigned* st;
};

__device__ __forceinline__ XcdBarrier xcd_barrier_post(unsigned* bar, volatile LAS unsigned* st) {
    XcdBarrier b; b.bar = bar; b.x = xb_xcc_id(); b.st = st;
    if (threadIdx.x == 0) (void)xb_add(&bar[XB_XCNT(b.x)], 1u);
    return b;
}
__device__ __forceinline__ void xcd_barrier_complete(unsigned* bar, unsigned x, unsigned& nloc, unsigned& nx) {
    const unsigned G = gridDim.x * gridDim.y * gridDim.z;
    unsigned sum, cnt, mine, sp = 0u;
    for (;;) {
        sum = 0u; cnt = 0u; mine = 0u;
#pragma unroll
        for (unsigned j = 0; j < 16; ++j) { const unsigned c = xb_ld(&bar[XB_XCNT(j)]); sum += c; cnt += (c > 0u) ? 1u : 0u; mine = (j == x) ? c : mine; }
        if (sum == G) break;
        __builtin_amdgcn_s_sleep(1);
        if ((++sp & 255u) == 0u) { if (xb_ld(&bar[XB_TMO])) break; if (sp > XB_SPIN_CAP) { atomicAdd(&bar[XB_TMO], 1u); break; } }
    }
    nloc = mine > 0u ? mine : 1u; nx = cnt > 0u ? cnt : 1u;
}

__device__ __forceinline__ void xcd_barrier(const XcdBarrier& b) {
    asm volatile("s_waitcnt vmcnt(0)" ::: "memory");
    __syncthreads();
    if (threadIdx.x == 0) {
        unsigned* bar = b.bar;
        __builtin_amdgcn_s_waitcnt(0);
        unsigned nloc = b.st[0], nx = b.st[1];
        if (nloc == 0u) { xcd_barrier_complete(bar, b.x, nloc, nx); b.st[0] = nloc; b.st[1] = nx; }
        const unsigned old = xb_add(&bar[XB_XSUB(b.x)], 1u);
        const unsigned gen = old / nloc;
        if (old + 1u == (gen + 1u) * nloc) {
            __builtin_amdgcn_fence(__ATOMIC_RELEASE, "agent");
            asm volatile("s_waitcnt vmcnt(0)" ::: "memory");
            const unsigned og = xb_add(&bar[XB_TOP], 1u);
            const unsigned tg = og / nx;
            if (og + 1u == (tg + 1u) * nx) xb_add(&bar[XB_TOPGEN], 1u);
            else XB_SPIN(xb_ld(&bar[XB_TOPGEN]) == tg, bar);
            __builtin_amdgcn_fence(__ATOMIC_ACQUIRE, "agent");
            xb_add(&bar[XB_XGEN(b.x)], 1u);
            asm volatile("s_waitcnt vmcnt(0)" ::: "memory");
        } else {
            XB_SPIN(xb_ld(&bar[XB_XGEN(b.x)]) == gen, bar);
            __builtin_amdgcn_fence(__ATOMIC_ACQUIRE, "agent");
            asm volatile("s_waitcnt vmcnt(0)" ::: "memory");
        }
    }
    __syncthreads();
}

__device__ __forceinline__ void cvt_item(const float* W, int ld, int K, int k0, int n0, u16* WT, int drow0, LAS float* scr, int lane) {
    float tv[32];
#pragma unroll
    for (int i = 0; i < 32; ++i) { const int kk = 2 * i + (lane >> 5); tv[i] = __builtin_nontemporal_load(W + (size_t)(k0 + kk) * ld + n0 + (lane & 31)); }
#pragma unroll
    for (int i = 0; i < 32; ++i) { const int kk = 2 * i + (lane >> 5); scr[kk * 33 + (lane & 31)] = tv[i]; }
    LDS_WAIT(); asm volatile("" ::: "memory");
    const int c = lane & 7;
#pragma unroll
    for (int j = 0; j < 4; ++j) { const int n = (lane >> 3) + 8 * j; const LAS float* s = scr + (8 * c) * 33 + n;
        u32x4 o; o.x = pk2(s[0 * 33], s[1 * 33]); o.y = pk2(s[2 * 33], s[3 * 33]); o.z = pk2(s[4 * 33], s[5 * 33]); o.w = pk2(s[6 * 33], s[7 * 33]);
        *(u32x4*)(WT + (size_t)(drow0 + n) * K + k0 + 8 * c) = o; }
    LDS_WAIT(); asm volatile("" ::: "memory");
}
__device__ __forceinline__ void cvt_job(const float* W, int ld, int K, int N, u16* WT, int mode, int r, LAS float* scr, int lane) {
    const int nblk = N / 32, kb = r / nblk, nb = r % nblk, n0 = nb * 32;
    const int drow0 = mode == 0 ? n0 : (n0 + (n0 >> 7) * 128 + (mode == 2 ? 128 : 0));
    cvt_item(W, ld, K, kb * 64, n0, WT, drow0, scr, lane);
}

__device__ __forceinline__ void cvt8_item(const float* W, int ld, int n0, unsigned char* WT, float* inv, int drow0, LAS float* t, int tid) {
    const int lane = tid & 63, wave = tid >> 6;
#pragma unroll
    for (int half = 0; half < 2; ++half) {
        float tv[32];
#pragma unroll
        for (int i = 0; i < 32; ++i) { const int kk = (half * 32 + i) * 16 + wave * 2 + (lane >> 5); tv[i] = __builtin_nontemporal_load(W + (size_t)kk * ld + n0 + (lane & 31)); }
#pragma unroll
        for (int i = 0; i < 32; ++i) { const int kk = (half * 32 + i) * 16 + wave * 2 + (lane >> 5); t[(lane & 31) * 1028 + kk] = tv[i]; }
    }
    __syncthreads();
#pragma unroll 1
    for (int r = 0; r < 4; ++r) { const int n = wave * 4 + r; const LAS float* row = t + n * 1028;
        f32x4 v[4]; float mx = 0.f;
#pragma unroll
        for (int j = 0; j < 4; ++j) { v[j] = *(const LAS f32x4*)(row + 256 * j + 4 * lane); mx = __builtin_fmaxf(mx, __builtin_fmaxf(__builtin_fmaxf(__builtin_fabsf(v[j][0]), __builtin_fabsf(v[j][1])), __builtin_fmaxf(__builtin_fabsf(v[j][2]), __builtin_fabsf(v[j][3])))); }
#pragma unroll
        for (int o = 1; o < 64; o <<= 1) mx = __builtin_fmaxf(mx, __shfl_xor(mx, o));
        const int e = (int)((__float_as_uint(mx) >> 23) & 0xffu) - 127;
        const bool ok = mx > 1e-30f && mx < 1e30f;
        const float sc = ok ? __uint_as_float((unsigned)(127 + 7 - e) << 23) : 1.f, isc = ok ? __uint_as_float((unsigned)(127 - 7 + e) << 23) : 1.f;
#pragma unroll
        for (int j = 0; j < 4; ++j) *(unsigned*)(WT + (size_t)(drow0 + n) * 1024 + 256 * j + 4 * lane) = pk4_fp8(v[j][0] * sc, v[j][1] * sc, v[j][2] * sc, v[j][3] * sc);
        if (lane == 0) inv[drow0 + n] = isc;
    }
    __syncthreads();
}

__device__ __forceinline__ void cvt8d_item(const float* W, int n0, unsigned char* WT, float* inv, LAS float* t, int tid) {
    const int lane = tid & 63, wave = tid >> 6;
    LAS float* red = t + 32 * 1028;
    float mx = 0.f;
    for (int i0 = 0; i0 < 224; i0 += 32) { float tv[32];
#pragma unroll
        for (int i = 0; i < 32; ++i) { const int kk = (i0 + i) * 16 + wave * 2 + (lane >> 5); tv[i] = W[(size_t)kk * 1024 + n0 + (lane & 31)]; }
#pragma unroll
        for (int i = 0; i < 32; ++i) mx = __builtin_fmaxf(mx, __builtin_fabsf(tv[i])); }
    mx = __builtin_fmaxf(mx, __shfl_xor(mx, 32));
    if (lane < 32) red[wave * 32 + lane] = mx;
    __syncthreads();
    if (tid < 32) { float m8 = 0.f;
#pragma unroll
        for (int w8 = 0; w8 < 8; ++w8) m8 = __builtin_fmaxf(m8, red[w8 * 32 + tid]);
        const int e = (int)((__float_as_uint(m8) >> 23) & 0xffu) - 127; const bool ok = m8 > 1e-30f && m8 < 1e30f;
        red[256 + tid] = ok ? __uint_as_float((unsigned)(127 + 7 - e) << 23) : 1.f; inv[n0 + tid] = ok ? __uint_as_float((unsigned)(127 - 7 + e) << 23) : 1.f; }
    __syncthreads();
#pragma unroll 1
    for (int k0 = 0; k0 < 3584; k0 += 1024) { const int nh = (k0 + 1024 <= 3584) ? 2 : 1;
        for (int half = 0; half < nh; ++half) { float tv[32];
#pragma unroll
            for (int i = 0; i < 32; ++i) { const int kk = (half * 32 + i) * 16 + wave * 2 + (lane >> 5); tv[i] = __builtin_nontemporal_load(W + (size_t)(k0 + kk) * 1024 + n0 + (lane & 31)); }
#pragma unroll
            for (int i = 0; i < 32; ++i) { const int kk = (half * 32 + i) * 16 + wave * 2 + (lane >> 5); t[(lane & 31) * 1028 + kk] = tv[i]; } }
        __syncthreads();
#pragma unroll 1
        for (int r = 0; r < 4; ++r) { const int n = wave * 4 + r; const LAS float* row = t + n * 1028; const float sc = red[256 + n];
#pragma unroll
            for (int j = 0; j < 4; ++j) if (j < 2 * nh) { const f32x4 v = *(const LAS f32x4*)(row + 256 * j + 4 * lane);
                *(unsigned*)(WT + (size_t)(n0 + n) * 3584 + k0 + 256 * j + 4 * lane) = pk4_fp8(v[0] * sc, v[1] * sc, v[2] * sc, v[3] * sc); } }
        __syncthreads();
    }
}


namespace lru {
typedef short bf16x8 __attribute__((ext_vector_type(8)));
typedef float f32x2 __attribute__((ext_vector_type(2)));
constexpr int AP = 272;
constexpr int L_AS = 0, L_BS = 256 * AP, L_GB = L_BS + 64 * AP, L_YS = L_GB + 256 * 64, L_WA = L_YS + 256 * 64, L_CW = L_WA + 8 * 32 * 8, L_END = L_CW + 5 * 128 * 4;
static_assert(L_END <= 131072, "LDS");
__device__ __forceinline__ float bfl(unsigned short v) { return __uint_as_float(((unsigned)v) << 16); }
__device__ __forceinline__ float gelu_fast(float x) { const float u2 = 1.5957691216057308f * (x + 0.044715f * x * x * x); return x - x * __builtin_amdgcn_rcpf(1.f + __expf(u2)); }
__device__ __forceinline__ void seg_apply(float& h, float A, float H) { h = __expf(A) * h + H; }
__device__ __forceinline__ void phase(LAS unsigned char* lds, int job, const float* cw, const float* cb, const u16* P2, u16* YL, const u16* WLG, const float* tab) {
    const int tid = threadIdx.x, lane = tid & 63, w = tid >> 6, l15 = lane & 15, g = lane >> 4;
    const int b = job / 40, n = (job % 40) >> 2, q = job & 3;
    const size_t row0 = (size_t)b * 4096;
    { const int r = tid >> 3, pc = tid & 7;
        const u16* src = WLG + ((size_t)n * 256 + (r < 32 ? 32 * q + r : 128 + 32 * q + (r - 32))) * 128 + pc * 16;
        const u32x4 v0 = *(const u32x4*)src, v1 = *(const u32x4*)(src + 8);
        *(LAS u32x4*)(lds + L_BS + r * AP + pc * 32) = v0; *(LAS u32x4*)(lds + L_BS + r * AP + pc * 32 + 16) = v1; }
    float ba[2], bx[2], sp[2];
#pragma unroll
    for (int chn = 0; chn < 2; ++chn) { const int c = 128 * n + 32 * q + 16 * chn + l15; ba[chn] = tab[c]; bx[chn] = tab[1280 + c]; sp[chn] = tab[2560 + c]; }
    u32x4 areg[11], gbreg[2];
    if (tid < 128) { LAS float* cwl = (LAS float*)(lds + L_CW); const int c = 128 * n + tid; cwl[tid] = cw[c]; cwl[128 + tid] = cw[1280 + c]; cwl[256 + tid] = cw[2560 + c]; cwl[384 + tid] = cw[3840 + c]; cwl[512 + tid] = cb[c]; }
    __syncthreads();
    const u16* aptr = P2 + (row0 + (tid >> 4) * 8) * 2560 + 1280 + 128 * n + (tid & 15) * 8;
    const u16* gptr = P2 + (row0 + (tid >> 2)) * 2560 + 128 * n + 32 * q + (tid & 3) * 8;
#define LRU_LOAD(t) do { _Pragma("unroll") for (int i = 0; i < 11; ++i) areg[i] = ((t) * 256 + (tid >> 4) * 8 + i >= 3) ? *(const u32x4*)(aptr + ((long)(t) * 256 + i - 3) * 2560) : (u32x4){0u, 0u, 0u, 0u}; \
        _Pragma("unroll") for (int i = 0; i < 2; ++i) gbreg[i] = *(const u32x4*)(gptr + ((size_t)(t) * 256 + 128 * i) * 2560); } while (0)
#define LRU_STASH() do { float cwr[4][8], cbr[8]; { const LAS float* cwl_ = (const LAS float*)(lds + L_CW) + (tid & 15) * 8; \
            _Pragma("unroll") for (int e_ = 0; e_ < 8; ++e_) { cwr[0][e_] = cwl_[e_]; cwr[1][e_] = cwl_[128 + e_]; cwr[2][e_] = cwl_[256 + e_]; cwr[3][e_] = cwl_[384 + e_]; cbr[e_] = cwl_[512 + e_]; } } \
        _Pragma("unroll") for (int i = 0; i < 8; ++i) { u32x4 o_; \
            _Pragma("unroll") for (int q_ = 0; q_ < 4; ++q_) { \
                const float lo_ = cbr[2 * q_] + cwr[0][2 * q_] * __uint_as_float(areg[i][q_] << 16) + cwr[1][2 * q_] * __uint_as_float(areg[i + 1][q_] << 16) + cwr[2][2 * q_] * __uint_as_float(areg[i + 2][q_] << 16) + cwr[3][2 * q_] * __uint_as_float(areg[i + 3][q_] << 16); \
                const float hi_ = cbr[2 * q_ + 1] + cwr[0][2 * q_ + 1] * __uint_as_float(areg[i][q_] & 0xffff0000u) + cwr[1][2 * q_ + 1] * __uint_as_float(areg[i + 1][q_] & 0xffff0000u) + cwr[2][2 * q_ + 1] * __uint_as_float(areg[i + 2][q_] & 0xffff0000u) + cwr[3][2 * q_ + 1] * __uint_as_float(areg[i + 3][q_] & 0xffff0000u); \
                o_[q_] = pk2(lo_, hi_); } \
            *(LAS u32x4*)(lds + L_AS + ((tid >> 4) * 8 + i) * AP + (tid & 15) * 16) = o_; } \
        _Pragma("unroll") for (int i = 0; i < 2; ++i) *(LAS u32x4*)(lds + L_GB + ((tid >> 2) + 128 * i) * 64 + (tid & 3) * 16) = gbreg[i]; } while (0)
    LRU_LOAD(0); LRU_STASH();
    __syncthreads();
    float hrun[2] = {0.f, 0.f};
    const int aoff = L_AS + (32 * w + l15) * AP + 16 * g, boff = L_BS + l15 * AP + 16 * g;
    for (int t = 0; t < 16; ++t) {
        if (t + 1 < 16) LRU_LOAD(t + 1);
        f32x4 acc[2][4];
#pragma unroll
        for (int m = 0; m < 2; ++m)
#pragma unroll
            for (int nn = 0; nn < 4; ++nn) acc[m][nn] = (f32x4){0.f, 0.f, 0.f, 0.f};
#pragma unroll
        for (int ks = 0; ks < 4; ++ks) {
            bf16x8 af[2], bfr[4];
#pragma unroll
            for (int m = 0; m < 2; ++m) af[m] = *(const LAS bf16x8*)(lds + aoff + 16 * m * AP + 64 * ks);
#pragma unroll
            for (int nn = 0; nn < 4; ++nn) bfr[nn] = *(const LAS bf16x8*)(lds + boff + 16 * nn * AP + 64 * ks);
#pragma unroll
            for (int m = 0; m < 2; ++m)
#pragma unroll
                for (int nn = 0; nn < 4; ++nn) acc[m][nn] = __builtin_amdgcn_mfma_f32_16x16x32_bf16(af[m], bfr[nn], acc[m][nn], 0, 0, 0);
        }
        float E[2][2][4], hl[2][2][4];
#pragma unroll
        for (int chn = 0; chn < 2; ++chn)
#pragma unroll
            for (int m = 0; m < 2; ++m) { float pe = 1.f, hh = 0.f;
#pragma unroll
                for (int r = 0; r < 4; ++r) { const int rt = 32 * w + 16 * m + 4 * g + r;
                    const float cv = bfl(*(const LAS unsigned short*)(lds + L_AS + rt * AP + (32 * q + 16 * chn + l15) * 2));
                    const float la = sp[chn] * __builtin_amdgcn_rcpf(1.f + __expf(-(acc[m][chn][r] + ba[chn])));
                    const float ig = __builtin_amdgcn_rcpf(1.f + __expf(-(acc[m][chn + 2][r] + bx[chn])));
                    const float av = __expf(la), t2 = 2.f * la;
                    const float om = t2 > -0.02f ? -t2 * (1.f + t2 * (0.5f + t2 * (0.16666667f + t2 * 0.041666667f))) : 1.f - av * av;
                    const float xi = __builtin_amdgcn_sqrtf(om) * (ig * cv);
                    pe *= av; hh = av * hh + xi; E[chn][m][r] = pe; hl[chn][m][r] = hh; } }
        float gE[2][2][4], gH[2][2][4];
#pragma unroll
        for (int chn = 0; chn < 2; ++chn)
#pragma unroll
            for (int m = 0; m < 2; ++m)
#pragma unroll
                for (int gg = 0; gg < 4; ++gg) { gE[chn][m][gg] = __shfl(E[chn][m][3], l15 + 16 * gg); gH[chn][m][gg] = __shfl(hl[chn][m][3], l15 + 16 * gg); }
        if (g == 0) {
#pragma unroll
            for (int chn = 0; chn < 2; ++chn) { float Ew = 1.f, Hw = 0.f;
#pragma unroll
                for (int m = 0; m < 2; ++m)
#pragma unroll
                    for (int gg = 0; gg < 4; ++gg) { Hw = gE[chn][m][gg] * Hw + gH[chn][m][gg]; Ew *= gE[chn][m][gg]; }
                *(LAS f32x2*)(lds + L_WA + (w * 32 + 16 * chn + l15) * 8) = (f32x2){Ew, Hw}; }
        }
        __syncthreads();
#pragma unroll
        for (int chn = 0; chn < 2; ++chn) {
            float hw = hrun[chn], hall = hrun[chn];
#pragma unroll
            for (int ww = 0; ww < 8; ++ww) { const f32x2 sg = *(const LAS f32x2*)(lds + L_WA + (ww * 32 + 16 * chn + l15) * 8); hall = sg[0] * hall + sg[1]; if (ww < w) hw = hall; }
            hrun[chn] = hall;
            float h0 = hw;
#pragma unroll
            for (int gg = 0; gg < 3; ++gg) if (gg < g) h0 = gE[chn][0][gg] * h0 + gH[chn][0][gg];
            float h1 = hw;
#pragma unroll
            for (int gg = 0; gg < 4; ++gg) h1 = gE[chn][0][gg] * h1 + gH[chn][0][gg];
#pragma unroll
            for (int gg = 0; gg < 3; ++gg) if (gg < g) h1 = gE[chn][1][gg] * h1 + gH[chn][1][gg];
#pragma unroll
            for (int m = 0; m < 2; ++m)
#pragma unroll
                for (int r = 0; r < 4; ++r) { const int rt = 32 * w + 16 * m + 4 * g + r; const int cc = 16 * chn + l15;
                    const float h = E[chn][m][r] * (m == 0 ? h0 : h1) + hl[chn][m][r];
                    const float gb = bfl(*(const LAS unsigned short*)(lds + L_GB + rt * 64 + cc * 2));
                    *(LAS unsigned short*)(lds + L_YS + rt * 64 + cc * 2) = f2bf(gelu_fast(gb) * h); }
        }
        __syncthreads();
#pragma unroll
        for (int i = 0; i < 2; ++i) { const int rr = (tid >> 2) + 128 * i; const u32x4 v = *(const LAS u32x4*)(lds + L_YS + rr * 64 + (tid & 3) * 16);
            *(u32x4*)(YL + (row0 + (size_t)t * 256 + rr) * 1280 + 128 * n + 32 * q + (tid & 3) * 8) = v; }
        if (t + 1 < 16) LRU_STASH();
        __syncthreads();
    }
#undef LRU_LOAD
#undef LRU_STASH
}
}

struct Args { const float* in[25]; float* out; char* ws; int ph_lo, ph_hi, li, pad; };

#define PHASE_VARS char* ws = a.ws; \
    const float* x = a.in[0]; const float* norm_g = a.in[4]; float* mod = (float*)(ws + WS_MOD); const float* mod0 = mod; const float* mod1 = mod + 4 * MODW; \
    float* rope = (float*)(ws + WS_ROPE); float* logf = (float*)(ws + WS_LOGF); float* kbias = (float*)(ws + WS_KBIAS); float* agg = (float*)(ws + WS_AGG); \
    int* ltw = (int*)(ws + WS_LTW); float* lg = (float*)(ws + WS_LG); int* cnt = (int*)(ws + WS_CTL) + CW_CNT; float* ksum = (float*)(ws + WS_CTL) + CW_KSUM; \
    u16* HA = (u16*)(ws + WS_HA); float* Y = (float*)(ws + WS_Y); float* out = a.out; \
    (void)x; (void)norm_g; (void)mod0; (void)mod1; (void)rope; (void)logf; (void)kbias; (void)agg; (void)ltw; (void)lg; (void)cnt; (void)ksum; (void)HA; (void)Y; (void)out;

__device__ __forceinline__ void conv_drain(const float* wg, const float* wu, const float* wd, char* ws, LAS unsigned char* lds, int ng, int nd) {
    const int tid = threadIdx.x; volatile LAS int* qs_ = (volatile LAS int*)(lds + CTRL_OFF + 64);
    for (int n_ = 0; n_ < nd; ++n_) { __syncthreads(); if (tid == 0) qs_[0] = atomicAdd((int*)(ws + WS_CTL) + CW_CQD, 1); __syncthreads(); const int it_ = qs_[0]; if (it_ >= 8 * 32) break;
        { const int e_ = it_ >> 5, n0_ = (it_ & 31) * 32; cvt8d_item(wd + (size_t)e_ * DEXP * D, n0_, (unsigned char*)(ws + WS_WMDN) + (size_t)e_ * 1024 * 3584, (float*)(ws + WS_SBD) + (size_t)e_ * 1024, (LAS float*)lds, tid); } }
    for (int n_ = 0; n_ < ng; ++n_) { __syncthreads(); if (tid == 0) qs_[0] = atomicAdd((int*)(ws + WS_CTL) + CW_CQG, 1); __syncthreads(); const int it_ = qs_[0]; if (it_ >= 16 * 112) break;
        { const int j_ = it_ / 112, nb_ = it_ % 112, e_ = j_ >> 1, which_ = j_ & 1, n0_ = nb_ * 32;
          cvt8_item((which_ ? wu : wg) + (size_t)e_ * D * DEXP, DEXP, n0_, (unsigned char*)(ws + WS_WMGU) + (size_t)e_ * 7168 * 1024, (float*)(ws + WS_SB) + (size_t)e_ * 7168, n0_ + (n0_ >> 7) * 128 + which_ * 128, (LAS float*)lds, tid); } }
}
#define CONV_DRAIN(NG, ND) conv_drain(a.in[22], a.in[23], a.in[24], ws, lds, (NG), (ND))
__global__ void __launch_bounds__(NWAVES * 64, 2) mega(Args a) {
    extern __shared__ __attribute__((aligned(16))) unsigned char lds_raw[];
    LAS unsigned char* lds = (LAS unsigned char*)lds_raw;
    volatile LAS unsigned* MISC = (volatile LAS unsigned*)(lds + MISC_OFF);
    const int tid = threadIdx.x, lane = tid & 63, wave = __builtin_amdgcn_readfirstlane(tid >> 6);
    const int G = gridDim.x, bid = blockIdx.x;
    unsigned* ctl = (unsigned*)(a.ws + WS_CTL);
    for (int u = tid; u < (LDS_BYTES - CTRL_OFF) / 4; u += NWAVES * 64) ((LAS unsigned*)(lds + CTRL_OFF))[u] = 0u;
    __syncthreads();
    const int lo = a.ph_lo, hi = a.ph_hi;
    const bool multi = (hi - lo) > 1;
    XcdBarrier bar; bar.bar = ctl + CW_BAR + a.li * XCD_BAR_WORDS; bar.x = 0; bar.st = nullptr;
    if (multi) bar = xcd_barrier_post(ctl + CW_BAR + a.li * XCD_BAR_WORDS, MISC + 8);
#ifndef PHMASK
#define PHMASK 0x7ffff
#endif
#define IN(k) ((((PHMASK) >> (k)) & 1) && lo <= (k) && (k) < hi)
#define SEAM(k) do { if (IN(k) && IN((k) + 1)) xcd_barrier(bar); } while (0)
#ifndef REPEAT_MASK
#define REPEAT_MASK 0
#endif
#define NREP(k) ((((REPEAT_MASK) >> (k)) & 1) ? 2 : 1)
    const int gw = bid * NWAVES + wave, NGW = G * NWAVES;

    if (IN(0)) { PHASE_VARS
        {
            LAS float* scs = (LAS float*)lds; LAS float* part = (LAS float*)(lds + 16384);
            const float* c = a.in[1];
            for (int i = tid; i < NB * D; i += NWAVES * 64) { const float v = c[i]; scs[i] = v / (1.f + __expf(-v)); }
            __syncthreads();
            const int n = bid * 48 + (lane < 48 ? lane : 47), l = n / MODW, nn = n % MODW;
            const float* w = a.in[2] + (size_t)l * D * MODW + nn + (size_t)(wave * 128) * MODW;
            float a0 = 0.f, a1 = 0.f, a2 = 0.f, a3 = 0.f;
            for (int k0 = 0; k0 < 128; k0 += 32) { float wv[32];
#pragma unroll
                for (int k = 0; k < 32; ++k) wv[k] = __builtin_nontemporal_load(w + (size_t)(k0 + k) * MODW);
#pragma unroll
                for (int k = 0; k < 32; ++k) { const int kk = wave * 128 + k0 + k; a0 += scs[kk] * wv[k]; a1 += scs[D + kk] * wv[k]; a2 += scs[2 * D + kk] * wv[k]; a3 += scs[3 * D + kk] * wv[k]; } }
            part[(wave * 64 + lane) * 4 + 0] = a0; part[(wave * 64 + lane) * 4 + 1] = a1; part[(wave * 64 + lane) * 4 + 2] = a2; part[(wave * 64 + lane) * 4 + 3] = a3;
            __syncthreads();
            if (tid < 192) { const int col = tid >> 2, b = tid & 3; float s = 0.f;
#pragma unroll
                for (int w8 = 0; w8 < 8; ++w8) s += part[(w8 * 64 + col) * 4 + b];
                const int n2 = bid * 48 + col, l2 = n2 / MODW, nn2 = n2 % MODW;
                mod[(l2 * 4 + b) * MODW + nn2] = s + a.in[3][l2 * MODW + nn2]; }
            __syncthreads();
        }
        if (gw < 512) { const int i = gw * 64 + lane; const int pos = i >> 3, f = i & 7;
            const float inv = exp2f(-(float)f * 0.125f * 18.931568569324174f); const float ang = (float)pos * inv; float sn, cs; sincosf(ang, &sn, &cs);
            rope[2 * i] = cs; rope[2 * i + 1] = sn; }
        if (bid == 255) { for (int c = tid; c < DRNN; c += NWAVES * 64) { float* tb = (float*)(ws + WS_SP8); tb[c] = a.in[15][c]; tb[1280 + c] = a.in[17][c]; tb[2560 + c] = -8.f * log1pf(__expf(-a.in[18][c])); } }
        {
            LAS float* scr = (LAS float*)(lds + wave * 16384);
            constexpr int I_AIN = 16 * 96, I_AOUT = 16 * 32, I_FG = 16 * 88, I_FD = 44 * 32, I_LIN = 16 * 80, I_LOUT = 20 * 32, I_LG = 2 * 4, I_MG = 16 * 112, I_MD = 56 * 32;
            int cum = 0;
#define CVT_LOOP(NIT, CALL) do { for (int r = (gw + NGW - (cum % NGW)) % NGW; r < (NIT); r += NGW) { CALL; } cum += (NIT); } while (0)
            CVT_LOOP(I_AIN, cvt_job(a.in[5], NIN, D, 3072, (u16*)(ws + WS_WAIN), 0, r, scr, lane));
            CVT_LOOP(I_AOUT, cvt_job(a.in[7], D, D, D, (u16*)(ws + WS_WAOUT), 0, r, scr, lane));
            CVT_LOOP(I_FG, cvt_job(a.in[8], DFF, D, DFF, (u16*)(ws + WS_WFGU), 1, r, scr, lane));
            CVT_LOOP(I_FG, cvt_job(a.in[9], DFF, D, DFF, (u16*)(ws + WS_WFGU), 2, r, scr, lane));
            CVT_LOOP(I_FD, cvt_job(a.in[10], D, DFF, D, (u16*)(ws + WS_WFDN), 0, r, scr, lane));
            CVT_LOOP(I_LIN, cvt_job(a.in[11], 2560, D, 2560, (u16*)(ws + WS_WLIN), 0, r, scr, lane));
            CVT_LOOP(I_LOUT, cvt_job(a.in[19], D, DRNN, D, (u16*)(ws + WS_WLOUT), 0, r, scr, lane));
            CVT_LOOP(10 * I_LG, cvt_job(a.in[14] + (size_t)(r / I_LG) * 16384, 128, 128, 128, (u16*)(ws + WS_WLG) + (size_t)(r / I_LG) * 256 * 128, 0, r % I_LG, scr, lane));
            CVT_LOOP(10 * I_LG, cvt_job(a.in[16] + (size_t)(r / I_LG) * 16384, 128, 128, 128, (u16*)(ws + WS_WLG) + (size_t)(r / I_LG) * 256 * 128 + 128 * 128, 0, r % I_LG, scr, lane));
#undef CVT_LOOP
            __syncthreads();
        }
    }
    SEAM(0);
    _Pragma("unroll") for (int rep_ = 0; rep_ < NREP(1); ++rep_) { if (rep_) xcd_barrier(bar);
    if (IN(1)) { PHASE_VARS RowP p{}; p.xres = x; p.y_mode = 0; p.g_pre = norm_g + 0 * D; p.sh = mod0 + 0 * D; p.sc = mod0 + 1 * D; p.hout = HA;
        p.extra = 1; p.wex = a.in[5]; p.wex_ld = NIN; p.wex_off = 3072; p.bex = a.in[6]; p.logf = logf; row_pass(p, bid, G, (LAS float*)lds); }
    }
    SEAM(1);
    _Pragma("unroll") for (int rep_ = 0; rep_ < NREP(2); ++rep_) { if (rep_) xcd_barrier(bar);
    if (IN(2)) { PHASE_VARS
        if (bid < 32) { LAS float* tot = (LAS float*)(lds + CTRL_OFF + 1024);
            const float* src = logf + (size_t)bid * S + tid * 8; float v[8]; float s = 0.f;
#pragma unroll
            for (int i = 0; i < 8; ++i) { s += src[i]; v[i] = s; }
            float inc = s;
#pragma unroll
            for (int o = 1; o < 64; o <<= 1) { const float up = __shfl_up(inc, o); if (lane >= o) inc += up; }
            if (lane == 63) tot[wave] = inc;
            __syncthreads();
            float base = inc - s;
#pragma unroll
            for (int w8 = 0; w8 < 8; ++w8) if (w8 < wave) base += tot[w8];
#pragma unroll
            for (int i = 0; i < 8; ++i) kbias[(size_t)bid * S + tid * 8 + i] = -(base + v[i]) * LOG2E;
            __syncthreads(); }
        pg8::DenseOrder So; So.init(HA, D, ws + WS_WAIN, M, 3072, D, G, bid);
        pg8::EpiQKV E{(u16*)(ws + WS_Q), (u16*)(ws + WS_K), (u16*)(ws + WS_V), rope, ksum, (unsigned*)(ws + WS_CTL) + CW_KN2};
        pg8::gemm_phase<pg8::EpiQKV, pg8::DenseOrder, false, true>(lds, D, D, So, E);
    }
    }
    SEAM(2);
    _Pragma("unroll") for (int rep_ = 0; rep_ < NREP(3); ++rep_) { if (rep_) xcd_barrier(bar);
    if (IN(3)) { PHASE_VARS
        const attn_body::AttnTensors AT{(const attn_body::bf16*)(ws + WS_Q), (const attn_body::bf16*)(ws + WS_K), (const attn_body::bf16*)(ws + WS_V), (attn_body::bf16*)(ws + WS_O)};
        attn_body::attn_phase<8>((char*)lds_raw, AT, ksum, kbias, (const unsigned*)(ws + WS_CTL) + CW_KN2, (int*)(ws + WS_CTL) + CW_AQ, (volatile LAS int*)(lds + CTRL_OFF + 64)); }
    }
    SEAM(3);
    _Pragma("unroll") for (int rep_ = 0; rep_ < NREP(4); ++rep_) { if (rep_) xcd_barrier(bar);
    if (IN(4)) { PHASE_VARS pg8::DenseOrder So; So.init(ws + WS_O, D, ws + WS_WAOUT, M, D, D, G, bid); pg8::EpiBf16 E{(u16*)Y, D};
        pg8::gemm_phase<pg8::EpiBf16, pg8::DenseOrder, false, false>(lds, D, D, So, E); }
    }
    SEAM(4);
    _Pragma("unroll") for (int rep_ = 0; rep_ < NREP(5); ++rep_) { if (rep_) xcd_barrier(bar);
    if (IN(5)) { PHASE_VARS RowP p{}; p.xres = x; p.y = Y; p.y_mode = 1; p.g_post = norm_g + 1 * D; p.gate = mod0 + 2 * D; p.xout = out;
        p.g_pre = norm_g + 2 * D; p.sh = mod0 + 3 * D; p.sc = mod0 + 4 * D; p.hout = HA; row_pass(p, bid, G, (LAS float*)lds); }
    }
    SEAM(5);
    _Pragma("unroll") for (int rep_ = 0; rep_ < NREP(6); ++rep_) { if (rep_) xcd_barrier(bar);
    if (IN(6)) { PHASE_VARS pg8::DenseOrder So; So.init(HA, D, ws + WS_WFGU, M, 2 * DFF, D, G, bid); pg8::EpiSwiglu E{(u16*)(ws + WS_HM), DFF};
        pg8::gemm_phase<pg8::EpiSwiglu, pg8::DenseOrder, false, true>(lds, D, D, So, E);
        if (bid >= 1408 - 5 * G) CONV_DRAIN(2, 0); }
    }
    SEAM(6);
    _Pragma("unroll") for (int rep_ = 0; rep_ < NREP(7); ++rep_) { if (rep_) xcd_barrier(bar);
    if (IN(7)) { PHASE_VARS pg8::DenseOrder So; So.init(ws + WS_HM, DFF, ws + WS_WFDN, M, D, DFF, G, bid); pg8::EpiBf16 E{(u16*)Y, D};
        pg8::gemm_phase<pg8::EpiBf16, pg8::DenseOrder, false, false>(lds, DFF, DFF, So, E); }
    }
    SEAM(7);
    if (IN(8)) { PHASE_VARS RowP p{}; p.xres = out; p.y = Y; p.y_mode = 1; p.g_post = norm_g + 3 * D; p.gate = mod0 + 5 * D; p.xout = out;
        p.g_pre = norm_g + 4 * D; p.sh = mod1 + 0 * D; p.sc = mod1 + 1 * D; p.hout = HA; row_pass(p, bid, G, (LAS float*)lds); }
    SEAM(8);
    _Pragma("unroll") for (int rep_ = 0; rep_ < NREP(9); ++rep_) { if (rep_) xcd_barrier(bar);
    if (IN(9)) { PHASE_VARS pg8::DenseOrder So; So.init(HA, D, ws + WS_WLIN, M, 2560, D, G, bid); pg8::EpiBf16 E{(u16*)(ws + WS_P2), 2560};
        pg8::gemm_phase<pg8::EpiBf16, pg8::DenseOrder, false, true>(lds, D, D, So, E);
        if (bid >= 640 - 2 * G) CONV_DRAIN(3, 0); }
    }
    SEAM(9);
    _Pragma("unroll") for (int rep_ = 0; rep_ < NREP(11); ++rep_) { if (rep_) xcd_barrier(bar);
    if (IN(11)) { PHASE_VARS
        if (bid < 160) lru::phase(lds, bid, a.in[12], a.in[13], (const u16*)(ws + WS_P2), (u16*)(ws + WS_YL), (const u16*)(ws + WS_WLG), (const float*)(ws + WS_SP8));
        else CONV_DRAIN(1, 3);
    }
    }
    SEAM(11);
    _Pragma("unroll") for (int rep_ = 0; rep_ < NREP(14); ++rep_) { if (rep_) xcd_barrier(bar);
    if (IN(14)) { PHASE_VARS pg8::DenseOrder So; So.init(ws + WS_YL, DRNN, ws + WS_WLOUT, M, D, DRNN, G, bid); pg8::EpiBf16 E{(u16*)Y, D};
        pg8::gemm_phase<pg8::EpiBf16, pg8::DenseOrder, false, false>(lds, DRNN, DRNN, So, E); }
    }
    SEAM(14);
    if (IN(15)) { PHASE_VARS RowP p{}; p.xres = out; p.y = Y; p.y_mode = 1; p.g_post = norm_g + 5 * D; p.gate = mod1 + 2 * D; p.xout = out;
        p.g_pre = norm_g + 6 * D; p.sh = mod1 + 3 * D; p.sc = mod1 + 4 * D; p.hout = HA;
        p.h8 = (unsigned char*)HA;
        p.extra = 2; p.wex = a.in[20]; p.wex_ld = 8; p.wex_off = 0; p.bex = a.in[21]; p.cnt = cnt; p.list_tw = ltw; p.list_g = lg; row_pass(p, bid, G, (LAS float*)lds);
        CONV_DRAIN(1 << 20, 1 << 20); }
    SEAM(15);
    _Pragma("unroll") for (int rep_ = 0; rep_ < NREP(16); ++rep_) { if (rep_) xcd_barrier(bar);
    if (IN(16)) { PHASE_VARS pg8::MoeOrder So; So.init(cnt, HA, ws + WS_WMGU, (size_t)7168 * 1024, 2 * DEXP, D / 2, G, bid, ltw, 1); pg8::EpiSwiglu8 E{(unsigned char*)(ws + WS_HMID), DEXP, (const float*)(ws + WS_SB)};
        pg8::gemm_phase<pg8::EpiSwiglu8, pg8::MoeOrder, true, true, true>(lds, D / 2, D / 2, So, E); }
    }
    SEAM(16);
    _Pragma("unroll") for (int rep_ = 0; rep_ < NREP(17); ++rep_) { if (rep_) xcd_barrier(bar);
    if (IN(17)) { PHASE_VARS pg8::MoeOrder So; So.init(cnt, ws + WS_HMID, ws + WS_WMDN, (size_t)1024 * 3584, D, DEXP / 2, G, bid, ltw, 0); pg8::EpiMoeDown E{(u16*)(ws + WS_YBUF), ltw, lg, (const float*)(ws + WS_SBD)};
        pg8::gemm_phase<pg8::EpiMoeDown, pg8::MoeOrder, false, true, true>(lds, DEXP / 2, DEXP / 2, So, E); }
    }
    SEAM(17);
    if (IN(18)) { PHASE_VARS RowP p{}; p.xres = out; p.y = (const float*)(ws + WS_YBUF); p.y_mode = 2; p.g_post = norm_g + 7 * D; p.gate = mod1 + 5 * D; p.xout = out; row_pass(p, bid, G, (LAS float*)lds); }
#undef IN
#undef SEAM
}

extern "C" void kernel_launch(void* const* d_in, const int* in_sizes, int n_in, void* d_out, int out_size, void* d_ws, size_t ws_size, hipStream_t stream) {
    static int grid = 0;
    if (grid == 0) {
        if (n_in != 25 || out_size != M * D || ws_size < WS_END) { fprintf(stderr, "kernel_launch: unexpected sizes (n_in %d out %d ws %zu)\n", n_in, out_size, ws_size); grid = -1; return; }
        int dev = 0, cus = 0;
        if (hipGetDevice(&dev) != hipSuccess || hipDeviceGetAttribute(&cus, hipDeviceAttributeMultiprocessorCount, dev) != hipSuccess) { grid = -1; return; }
        if (hipFuncSetAttribute((const void*)mega, hipFuncAttributeMaxDynamicSharedMemorySize, LDS_BYTES) != hipSuccess) { fprintf(stderr, "kernel_launch: hipFuncSetAttribute failed\n"); grid = -1; return; }
        (void)hipGetLastError();
        grid = cus;
    }
    if (grid < 0) return;
    char* ws = (char*)d_ws;
    (void)hipMemsetAsync(ws + WS_CTL, 0, 1 * MiB, stream);
    Args a{};
    for (int i = 0; i < 25; ++i) a.in[i] = (const float*)d_in[i];
    a.out = (float*)d_out; a.ws = ws;
#if defined(MK_PER_PHASE)
    for (int ph = 0; ph <= 18; ++ph) { a.ph_lo = ph; a.ph_hi = ph + 1; hipLaunchKernelGGL(mega, dim3(grid), dim3(NWAVES * 64), LDS_BYTES, stream, a); }
#else
    a.ph_lo = 0; a.ph_hi = 19;
    hipLaunchKernelGGL(mega, dim3(grid), dim3(NWAVES * 64), LDS_BYTES, stream, a);
#if defined(PROBE_PH)
    a.ph_lo = PROBE_PH; a.ph_hi = PROBE_PH + PROBE_N; a.li = 1;
    hipLaunchKernelGGL(mega, dim3(grid), dim3(NWAVES * 64), LDS_BYTES, stream, a);
#endif
#endif
}
```
